# Optimizing an MI355X kernel written in HIP

```python
import jax, jax.numpy as jnp
from jax import lax
import numpy as np

D_MODEL = 1024
BATCH = 4
SEQ = 8192
DEPTH = 4

N_MIXERS = 2
N_EVEN = (DEPTH + 1) // 2
N_ODD = DEPTH // 2
POOL_WINDOWS = (2, 4, 8, 16)
N_POOL_GROUPS = len(POOL_WINDOWS)
POOL_GROUP_DIM = D_MODEL // N_POOL_GROUPS
DIL_PATTERNS = ((128, 1), (512, 4), (2048, 16))
N_DIL_GROUPS = len(DIL_PATTERNS)
HEADS_PER_GROUP = 8
HEAD_DIM = D_MODEL // HEADS_PER_GROUP
GROUP_WIDTH = HEADS_PER_GROUP * HEAD_DIM
QKV_WIDTH = N_DIL_GROUPS * 3 * GROUP_WIDTH
ROPE_DIM = HEAD_DIM // 4
ROPE_THETA = 500000.0
D_FF = 2816
N_EXPERTS = 8
TOP_K = 2
D_FF_EXPERT = 3584
NORM_EPS = 1e-6

kernel_name = "hybrid_pool_dilated_attn_moe_adaln"


def _rmsnorm(t, g):
    t32 = t.astype(jnp.float32)
    y = t32 * lax.rsqrt(jnp.mean(t32 * t32, axis=-1, keepdims=True) + NORM_EPS)
    return (y * g.astype(jnp.float32)).astype(t.dtype)


def _rope_tables(positions):
    half = ROPE_DIM // 2
    inv_freq = ROPE_THETA ** (-jnp.arange(half, dtype=jnp.float32) * 2.0 / ROPE_DIM)
    ang = positions.astype(jnp.float32)[..., None] * inv_freq
    return jnp.cos(ang)[:, :, None, :], jnp.sin(ang)[:, :, None, :]


def _partial_rope(t, cos, sin):
    t32 = t.astype(jnp.float32)
    half = ROPE_DIM // 2
    x1, x2, rest = t32[..., :half], t32[..., half:ROPE_DIM], t32[..., ROPE_DIM:]
    out = jnp.concatenate([x1 * cos - x2 * sin, x2 * cos + x1 * sin, rest], axis=-1)
    return out.astype(t.dtype)


def _pool_mixer(h, w_pool, scale):
    B, S, D = h.shape
    hg = h.astype(jnp.float32).reshape(B, S, N_POOL_GROUPS, POOL_GROUP_DIM)
    cs = jnp.cumsum(hg, axis=1)
    t = jnp.arange(S)
    pooled = []
    for gi, w in enumerate(POOL_WINDOWS):
        c = cs[:, :, gi]
        lag = jnp.pad(c[:, :S - w], ((0, 0), (w, 0), (0, 0)))
        cnt = jnp.minimum(t + 1, w).astype(jnp.float32)[None, :, None]
        pooled.append((c - lag) / cnt)
    pooled = jnp.stack(pooled, axis=2) - hg
    y = jnp.einsum('bsgc,gcd->bsgd', pooled.astype(h.dtype), w_pool).reshape(B, S, D)
    return y * scale


def _dilated_window_attention(q, k, v, window, dilation):
    B, S, H, Dh = q.shape
    span = window // dilation
    L = S // dilation
    nb = -(-L // span)
    Lp = nb * span

    def to_strided_blocks(t):
        t = t.reshape(B, L, dilation, H, Dh).transpose(0, 2, 3, 1, 4)
        t = jnp.pad(t, ((0, 0), (0, 0), (0, 0), (0, Lp - L), (0, 0)))
        return t.reshape(B, dilation, H, nb, span, Dh)

    def with_prev_block(t):
        prev = jnp.pad(t[:, :, :, :-1], ((0, 0), (0, 0), (0, 0), (1, 0), (0, 0), (0, 0)))
        return jnp.concatenate([prev, t], axis=4)

    qb = to_strided_blocks(q)
    kk = with_prev_block(to_strided_blocks(k))
    vv = with_prev_block(to_strided_blocks(v))
    s = jnp.einsum('brhnqe,brhnke->brhnqk', qb, kk,
                   preferred_element_type=jnp.float32) * (HEAD_DIM ** -0.5)
    blk = jnp.arange(nb)[:, None, None]
    qpos = blk * span + jnp.arange(span)[None, :, None]
    kpos = (blk - 1) * span + jnp.arange(2 * span)[None, None, :]
    allowed = (kpos <= qpos) & (kpos >= qpos - span) & (kpos >= 0)
    s = jnp.where(allowed, s, -jnp.inf)
    m = jnp.max(s, axis=-1, keepdims=True)
    p = jnp.exp(s - m)
    den = jnp.sum(p, axis=-1, keepdims=True)
    o = jnp.einsum('brhnqk,brhnke->brhnqe', p, vv.astype(jnp.float32)) / den
    lse = (m + jnp.log(den))[..., 0]
    o = o.reshape(B, dilation, H, Lp, Dh)[:, :, :, :L].transpose(0, 3, 1, 2, 4).reshape(B, S, H, Dh)
    lse = lse.reshape(B, dilation, H, Lp)[..., :L].transpose(0, 3, 1, 2).reshape(B, S, H)
    return o, lse


def _dilated_attention_mixer(h, cos, sin, w_qkv, w_o, q_gain, k_gain):
    B, S, D = h.shape
    qkv = (h @ w_qkv).reshape(B, S, N_DIL_GROUPS, 3, HEADS_PER_GROUP, HEAD_DIM)
    outs, lses = [], []
    for g, (window, dilation) in enumerate(DIL_PATTERNS):
        q = _partial_rope(_rmsnorm(qkv[:, :, g, 0], q_gain[g]), cos, sin)
        k = _partial_rope(_rmsnorm(qkv[:, :, g, 1], k_gain[g]), cos, sin)
        v = qkv[:, :, g, 2]
        o, lse = _dilated_window_attention(q, k, v, window, dilation)
        outs.append(o)
        lses.append(lse)
    alpha = jax.nn.softmax(jnp.stack(lses, axis=0), axis=0)
    o = jnp.einsum('gbsh,gbshe->bshe', alpha, jnp.stack(outs, axis=0))
    return o.reshape(B, S, GROUP_WIDTH).astype(h.dtype) @ w_o


def _swiglu(h, w_gu, w_down):
    g, u = jnp.split(h @ w_gu, 2, axis=-1)
    return (jax.nn.silu(g) * u) @ w_down


def _moe_swiglu(h, w_router, b_router, w_gu, w_down):
    B, S, D = h.shape
    t = h.reshape(B * S, D)
    logits = (t @ w_router).astype(jnp.float32) + b_router.astype(jnp.float32)
    top_val, top_idx = lax.top_k(logits, TOP_K)
    gates = jax.nn.softmax(top_val, axis=-1)
    combine = jnp.sum(jax.nn.one_hot(top_idx, N_EXPERTS, dtype=jnp.float32) * gates[..., None], axis=1)
    y = jnp.zeros((B * S, D), jnp.float32)
    for e in range(N_EXPERTS):
        y = y + combine[:, e:e + 1] * _swiglu(t, w_gu[e], w_down[e]).astype(jnp.float32)
    return y.reshape(B, S, D).astype(h.dtype)


def setup_inputs(seed: int = 0) -> dict:
    key = jax.random.key(seed)
    ks = jax.random.split(key, 20)
    f32 = jnp.float32
    nrm = lambda k, shape, fan_in, gain=1.0: jax.random.normal(k, shape, f32) * (gain * fan_in ** -0.5)
    x = jax.random.normal(ks[0], (BATCH, SEQ, D_MODEL), f32)
    c = jax.random.normal(ks[1], (BATCH, D_MODEL), f32)
    offset = jax.random.randint(ks[2], (BATCH, 1), 0, 4096, dtype=jnp.int32)
    positions = offset + jnp.arange(SEQ, dtype=jnp.int32)[None, :]
    return {
        "x": x,
        "c": c,
        "positions": positions,
        "norm1_g": 1.0 + 0.05 * jax.random.normal(ks[3], (DEPTH, D_MODEL), f32),
        "norm2_g": 1.0 + 0.05 * jax.random.normal(ks[4], (DEPTH, D_MODEL), f32),
        "ada_w": nrm(ks[5], (DEPTH, D_MODEL, 6 * D_MODEL), D_MODEL, 0.5),
        "ada_b": 0.02 * jax.random.normal(ks[6], (DEPTH, 6 * D_MODEL), f32),
        "pool_w": nrm(ks[7], (N_EVEN, N_POOL_GROUPS, POOL_GROUP_DIM, POOL_GROUP_DIM), POOL_GROUP_DIM),
        "pool_scale": 1.0 + 0.1 * jax.random.normal(ks[8], (N_EVEN, D_MODEL), f32),
        "attn_w_qkv": nrm(ks[9], (N_ODD, D_MODEL, QKV_WIDTH), D_MODEL),
        "attn_w_o": nrm(ks[10], (N_ODD, GROUP_WIDTH, D_MODEL), GROUP_WIDTH),
        "q_norm_g": 1.0 + 0.05 * jax.random.normal(ks[11], (N_ODD, N_DIL_GROUPS, HEAD_DIM), f32),
        "k_norm_g": 1.0 + 0.05 * jax.random.normal(ks[12], (N_ODD, N_DIL_GROUPS, HEAD_DIM), f32),
        "ffn_w_gu": nrm(ks[13], (N_EVEN, D_MODEL, 2 * D_FF), D_MODEL),
        "ffn_w_down": nrm(ks[14], (N_EVEN, D_FF, D_MODEL), D_FF),
        "router_w": nrm(ks[15], (N_ODD, D_MODEL, N_EXPERTS), D_MODEL),
        "router_b": 0.01 * jax.random.normal(ks[16], (N_ODD, N_EXPERTS), f32),
        "moe_w_gu": nrm(ks[17], (N_ODD, N_EXPERTS, D_MODEL, 2 * D_FF_EXPERT), D_MODEL),
        "moe_w_down": nrm(ks[18], (N_ODD, N_EXPERTS, D_FF_EXPERT, D_MODEL), D_FF_EXPERT),
    }


def reference(x, c, positions, norm1_g, norm2_g, ada_w, ada_b, pool_w, pool_scale,
              attn_w_qkv, attn_w_o, q_norm_g, k_norm_g, ffn_w_gu, ffn_w_down,
              router_w, router_b, moe_w_gu, moe_w_down):
    cos, sin = _rope_tables(positions)
    c_act = jax.nn.silu(c)
    for i in range(DEPTH):
        j = i // 2
        mod = (c_act @ ada_w[i] + ada_b[i])[:, None, :]
        sh1, sc1, g1, sh2, sc2, g2 = jnp.split(mod, 6, axis=-1)
        h = _rmsnorm(x, norm1_g[i]) * (1.0 + sc1) + sh1
        if i % N_MIXERS == 0:
            y = _pool_mixer(h, pool_w[j], pool_scale[j])
        else:
            y = _dilated_attention_mixer(h, cos, sin, attn_w_qkv[j], attn_w_o[j],
                                         q_norm_g[j], k_norm_g[j])
        x = x + g1 * y
        h = _rmsnorm(x, norm2_g[i]) * (1.0 + sc2) + sh2
        if i % 2 == 0:
            y = _swiglu(h, ffn_w_gu[j], ffn_w_down[j])
        else:
            y = _moe_swiglu(h, router_w[j], router_b[j], moe_w_gu[j], moe_w_down[j])
        x = x + g2 * y
    return x
```

```cpp
#define MK_PER_PHASE 1
#include <hip/hip_runtime.h>
#include <hip/hip_bf16.h>
#include <cstdio>
#include <cstdint>

constexpr int D_MODEL = 1024, BATCH = 4, SEQ = 8192, DEPTH = 4, M_TOK = BATCH * SEQ;
constexpr int QKV_W = 9216, D_FF = 2816, N_EXP = 8, D_FFE = 3584, HEAD_DIM = 128, NHEAD = 8;
constexpr float NORM_EPS = 1e-6f;

namespace pg8 {
#define PG8_LAS __attribute__((address_space(3)))
typedef unsigned short bf16_t;
typedef short bf16x8 __attribute__((ext_vector_type(8)));
typedef float f32x4 __attribute__((ext_vector_type(4)));
typedef float f32x2 __attribute__((ext_vector_type(2)));
typedef unsigned u32x4 __attribute__((ext_vector_type(4)));
typedef unsigned u32x2 __attribute__((ext_vector_type(2)));
constexpr int BM = 256, BK = 64, HALF = 128, HTB = HALF * BK * 2  , STAGE_BYTES = 8 * HTB, NXCD = 8, WGM = 8;

__host__ __device__ __forceinline__ int lds_byte(int r, int c) { const int st = (r >> 4) * 2 + (c >> 5), rr = r & 15, cc = c & 31, ob = rr * 64 + cc * 2; return st * 1024 + (ob ^ (((ob >> 9) & 1) << 5)); }
__host__ __device__ __forceinline__ void stage_rc(int b, int& R, int& C) { const int st = b / 1024, sb = b % 1024, swz = sb ^ (((sb >> 9) & 1) << 5); R = (st >> 1) * 16 + swz / 64; C = (st & 1) * 32 + (swz % 64) / 2; }
__host__ __device__ __forceinline__ int perm32(int rho) { const int n = rho >> 4, i = rho & 15; return 8 * (i >> 2) + 4 * n + (i & 3); }
__device__ __forceinline__ unsigned cvt_pk_bf16(float lo, float hi) { unsigned r; asm volatile("v_cvt_pk_bf16_f32 %0, %1, %2" : "=v"(r) : "v"(lo), "v"(hi)); return r; }

struct Unit { int pm, pn; };

struct OrderBase {
    int nM, nN, nwg, G, c;
    __device__ __forceinline__ void init_order(int nM_, int nN_, int G_, int c_) { nM = nM_; nN = nN_; nwg = nM * nN; G = G_; c = c_; }
    __device__ __forceinline__ bool next(int i, Unit& u) const {
        const long L = (long)i * G + c; if (L >= nwg) return false;
        int wgid = (int)L; { const int q = nwg / NXCD, r = nwg % NXCD, xcd = wgid % NXCD, off = wgid / NXCD; wgid = (xcd < r ? xcd * (q + 1) : r * (q + 1) + (xcd - r) * q) + off; }
        const int nig = WGM * nN, gid = wgid / nig, fm = gid * WGM, gsz = (nM - fm) < WGM ? (nM - fm) : WGM;
        u.pm = fm + ((wgid % nig) % gsz); u.pn = (wgid % nig) / gsz; return true;
    }
};
struct SchedPlain : OrderBase {
    const char* A; const char* B; int lda; int a_pn_step; size_t a_tile, b_tile;
    __device__ __forceinline__ void init(const void* A_, const void* B_, int M, int N, int K, int lda_, int a_pn_step_, int G_, int c_) {
        init_order(M / BM, N / BM, G_, c_); A = (const char*)A_; B = (const char*)B_; lda = lda_; a_pn_step = a_pn_step_; a_tile = (size_t)BM * lda_ * 2; b_tile = (size_t)BM * K * 2; }
    __device__ __forceinline__ const char* a_base(const Unit& u) const { return A + (size_t)u.pm * a_tile + (size_t)u.pn * a_pn_step; }
    __device__ __forceinline__ const char* b_base(const Unit& u) const { return B + (size_t)u.pn * b_tile; }
    __device__ __forceinline__ void a_offs(const Unit&, const int (&R)[2], const int (&C)[2], unsigned (&v)[2][2]) const {
#pragma unroll
        for (int h = 0; h < 2; ++h)
#pragma unroll
            for (int i = 0; i < 2; ++i) v[h][i] = (unsigned)((h * HALF + R[i]) * lda + C[i]) * 2u; }
};
template <bool GATHER> struct SchedMoE : OrderBase {
    int tb[9]; const char* A; const char* B; int lda; size_t b_exp, b_tile; const int* tok;
    __device__ __forceinline__ int expert(int pm) const { int e = 0;
#pragma unroll
        for (int j = 1; j < 8; ++j) e += (pm >= tb[j]) ? 1 : 0; return e; }
    __device__ __forceinline__ const char* a_base(const Unit& u) const { return GATHER ? A : A + (size_t)u.pm * BM * lda * 2; }
    __device__ __forceinline__ const char* b_base(const Unit& u) const { return B + (size_t)expert(u.pm) * b_exp + (size_t)u.pn * b_tile; }
    __device__ __forceinline__ void a_offs(const Unit& u, const int (&R)[2], const int (&C)[2], unsigned (&v)[2][2]) const {
#pragma unroll
        for (int h = 0; h < 2; ++h)
#pragma unroll
            for (int i = 0; i < 2; ++i) { const int row = GATHER ? tok[u.pm * BM + h * HALF + R[i]] : (h * HALF + R[i]); v[h][i] = (unsigned)(row * lda + C[i]) * 2u; } }
};

template <class Epi, class Sched, bool ALIGN_EPI>
__device__ __forceinline__ void gemm_phase(PG8_LAS unsigned char* lds, const int K, const Sched& S, const Epi& E) {
    int tid = threadIdx.x; asm volatile("" : "+v"(tid));
    const int wid = __builtin_amdgcn_readfirstlane(tid >> 6), lane = tid & 63, wr = wid >> 2, wc = wid & 3, fr = lane & 15, fq = lane >> 4;
    const int nt = K / BK;
    int RA[2], CA[2]; unsigned voffB[2];
#pragma unroll
    for (int i = 0; i < 2; ++i) { int R, C; stage_rc(tid * 16 + i * 8192, R, C); const int Rb = Epi::PERM ? ((R & ~31) + perm32(R & 31)) : R; RA[i] = R; CA[i] = C; voffB[i] = (unsigned)(Rb * K + C) * 2u; }
    const size_t kstep = (size_t)(BK * 2);
    const size_t hstep = (size_t)HALF * K * 2;
    const unsigned ldsw = (unsigned)wid * 1024u;
    const int aoff = lds_byte(wr * 64 + fr, fq * 8), boff = lds_byte(wc * 32 + fr, fq * 8);
#define PG8_SA(b, h) (((b) * 2 + (h)) * HTB)
#define PG8_SB(b, h) ((4 + (b) * 2 + (h)) * HTB)
#define PG8_STAGE2(bufoff, gbase, v0, v1) do { \
        __builtin_amdgcn_global_load_lds((const unsigned*)((const char*)(gbase) + (v0)), (PG8_LAS unsigned*)(lds + (bufoff) + ldsw), 16, 0, 0); \
        __builtin_amdgcn_global_load_lds((const unsigned*)((const char*)(gbase) + (v1)), (PG8_LAS unsigned*)(lds + (bufoff) + ldsw + 8192), 16, 0, 0); } while (0)
#define PG8_STAGEB(bufoff, gbase) PG8_STAGE2(bufoff, gbase, voffB[0], voffB[1])
#define PG8_LDA(dst, b, h) do { _Pragma("unroll") for (int m = 0; m < 4; ++m) _Pragma("unroll") for (int k = 0; k < 2; ++k) dst[m][k] = *(const PG8_LAS bf16x8*)(lds + PG8_SA(b, h) + aoff + m * 2048 + k * 1024); } while (0)
#define PG8_LDB(dst, b, h) do { _Pragma("unroll") for (int n = 0; n < 2; ++n) _Pragma("unroll") for (int k = 0; k < 2; ++k) dst[n][k] = *(const PG8_LAS bf16x8*)(lds + PG8_SB(b, h) + boff + n * 2048 + k * 1024); } while (0)
#define PG8_MMA(ai, bj, At, Bt) do { __builtin_amdgcn_s_setprio(1); _Pragma("unroll") for (int m = 0; m < 4; ++m) _Pragma("unroll") for (int n = 0; n < 2; ++n) _Pragma("unroll") for (int k = 0; k < 2; ++k) \
        acc[ai][bj][m][n] = __builtin_amdgcn_mfma_f32_16x16x32_bf16(Bt[n][k], At[m][k], acc[ai][bj][m][n], 0, 0, 0); __builtin_amdgcn_s_setprio(0); } while (0)
#define PG8_WAIT_V(n) asm volatile("s_waitcnt vmcnt(" #n ")" ::: "memory")
#define PG8_WAIT_L(n) asm volatile("s_waitcnt lgkmcnt(" #n ")" ::: "memory")
#define PG8_BAR __builtin_amdgcn_s_barrier()
#define PG8_SCHED __builtin_amdgcn_sched_barrier(0)
    Unit cur, nxt; int ui = 0;
    if (!S.next(0, cur)) return;
    f32x4 acc[2][2][4][2];
#pragma unroll
    for (int a = 0; a < 2; ++a)
#pragma unroll
        for (int b = 0; b < 2; ++b)
#pragma unroll
            for (int m = 0; m < 4; ++m)
#pragma unroll
                for (int n = 0; n < 2; ++n) acc[a][b][m][n] = (f32x4){0.f, 0.f, 0.f, 0.f};
    bf16x8 At[4][2], B0[2][2], B1[2][2];
    unsigned vA[2][2], vN[2][2];
    const char* cA = S.a_base(cur); const char* cB = S.b_base(cur);
    S.a_offs(cur, RA, CA, vA);
#pragma unroll
    for (int h = 0; h < 2; ++h)
#pragma unroll
        for (int i = 0; i < 2; ++i) vN[h][i] = vA[h][i];
    PG8_STAGEB(PG8_SB(0, 0), cB); PG8_STAGEB(PG8_SB(0, 1), cB + hstep); PG8_STAGE2(PG8_SA(0, 0), cA, vA[0][0], vA[0][1]); PG8_STAGE2(PG8_SA(0, 1), cA, vA[1][0], vA[1][1]);
    if (wr == 1) PG8_BAR;
    PG8_WAIT_V(2); PG8_BAR;
    PG8_STAGEB(PG8_SB(1, 0), cB + kstep); PG8_STAGE2(PG8_SA(1, 0), cA + kstep, vA[0][0], vA[0][1]); PG8_STAGEB(PG8_SB(1, 1), cB + hstep + kstep);
    PG8_WAIT_V(6); PG8_BAR;
    for (;;) {
        const bool has_next = S.next(ui + 1, nxt);
        const char* nA = has_next ? S.a_base(nxt) : cA; const char* nB = has_next ? S.b_base(nxt) : cB;
#pragma nounroll
        for (int t = 0; t < nt; t += 2) {
            const bool last = (t == nt - 2);
            const char* a1 = cA + (size_t)(t + 1) * kstep;
            if (last && has_next) S.a_offs(nxt, RA, CA, vN);
            const char* a2 = last ? nA : cA + (size_t)(t + 2) * kstep; const char* b2 = last ? nB : cB + (size_t)(t + 2) * kstep;
            const char* a3 = a2 + kstep; const char* b3 = b2 + kstep;
            const unsigned u00 = last ? vN[0][0] : vA[0][0], u01 = last ? vN[0][1] : vA[0][1], u10 = last ? vN[1][0] : vA[1][0], u11 = last ? vN[1][1] : vA[1][1];
            PG8_LDB(B0, 0, 0); PG8_LDB(B1, 0, 1); PG8_SCHED; PG8_LDA(At, 0, 0); PG8_STAGE2(PG8_SA(1, 1), a1, vA[1][0], vA[1][1]);
            PG8_WAIT_V(8); PG8_WAIT_L(0); PG8_BAR; PG8_MMA(0, 0, At, B0); PG8_MMA(0, 1, At, B1); PG8_BAR; PG8_SCHED;
            PG8_LDA(At, 0, 1); PG8_STAGEB(PG8_SB(0, 0), b2); PG8_STAGEB(PG8_SB(0, 1), b2 + hstep); PG8_STAGE2(PG8_SA(0, 0), a2, u00, u01);
            PG8_WAIT_V(8); PG8_WAIT_L(0); PG8_BAR; PG8_MMA(1, 0, At, B0); PG8_MMA(1, 1, At, B1); PG8_BAR; PG8_SCHED;
            PG8_LDB(B0, 1, 0); PG8_LDB(B1, 1, 1); PG8_SCHED; PG8_LDA(At, 1, 0); PG8_STAGE2(PG8_SA(0, 1), a2, u10, u11);
            PG8_WAIT_V(8); PG8_WAIT_L(0); PG8_BAR; PG8_MMA(0, 0, At, B0); PG8_MMA(0, 1, At, B1); PG8_BAR; PG8_SCHED;
            PG8_LDA(At, 1, 1); PG8_STAGEB(PG8_SB(1, 0), b3); PG8_STAGEB(PG8_SB(1, 1), b3 + hstep); PG8_STAGE2(PG8_SA(1, 0), a3, u00, u01);
            PG8_WAIT_V(8); PG8_WAIT_L(0); PG8_BAR; PG8_MMA(1, 0, At, B0); PG8_MMA(1, 1, At, B1); PG8_BAR; PG8_SCHED;
        }
        if constexpr (ALIGN_EPI) { if (wr == 0) PG8_BAR; }
        E(acc, cur, wr, wc, fr, fq);
        if (!has_next) break;
#pragma unroll
        for (int a = 0; a < 2; ++a)
#pragma unroll
            for (int b = 0; b < 2; ++b)
#pragma unroll
                for (int m = 0; m < 4; ++m)
#pragma unroll
                    for (int n = 0; n < 2; ++n) acc[a][b][m][n] = (f32x4){0.f, 0.f, 0.f, 0.f};
        cur = nxt; cA = nA; cB = nB; ++ui;
#pragma unroll
        for (int h = 0; h < 2; ++h)
#pragma unroll
            for (int i = 0; i < 2; ++i) vA[h][i] = vN[h][i];
        if constexpr (ALIGN_EPI) { if (wr == 1) PG8_BAR; }
    }
    PG8_WAIT_V(0);
    if constexpr (!ALIGN_EPI) { if (wr == 0) PG8_BAR; }
    PG8_BAR;
#undef PG8_SA
#undef PG8_SB
#undef PG8_STAGE2
#undef PG8_STAGEB
#undef PG8_LDA
#undef PG8_LDB
#undef PG8_MMA
#undef PG8_WAIT_V
#undef PG8_WAIT_L
#undef PG8_BAR
#undef PG8_SCHED
}
}
namespace pg8 {
constexpr int MOD_SZ = DEPTH * BATCH * 6 * D_MODEL;
__device__ __forceinline__ f32x4 mod4(const float* modp, const float* ada_b, int layer, int b, int part, int col) {
    const int o = part * D_MODEL + col; const float* p = modp + (size_t)(layer * BATCH + b) * (6 * D_MODEL) + o;
    f32x4 v = *(const f32x4*)(ada_b + layer * (6 * D_MODEL) + o);
#pragma unroll
    for (int ks = 0; ks < 4; ++ks) v += *(const f32x4*)(p + (size_t)ks * MOD_SZ);
    return v;
}
struct EpiResid {
    static constexpr bool PERM = false;
    const float* xin; float* xout; const float* modp; const float* ada_b; const float* colscale; int layer, part;
    __device__ __forceinline__ void operator()(const f32x4 (&acc)[2][2][4][2], const Unit& u, int wr, int wc, int fr, int fq) const {
        const int row0 = u.pm * BM + wr * 64 + fr, col0 = u.pn * BM + wc * 32 + 4 * fq, b = (u.pm * BM) / SEQ;
        f32x4 gs[2][2];
#pragma unroll
        for (int bj = 0; bj < 2; ++bj)
#pragma unroll
            for (int n = 0; n < 2; ++n) { const int c = col0 + bj * HALF + n * 16; gs[bj][n] = mod4(modp, ada_b, layer, b, part, c); if (colscale) gs[bj][n] *= *(const f32x4*)(colscale + c); }
#pragma unroll
        for (int ai = 0; ai < 2; ++ai)
#pragma unroll
            for (int m = 0; m < 4; ++m) { const size_t off = (size_t)(row0 + ai * HALF + m * 16) * D_MODEL + col0;
#pragma unroll
                for (int bj = 0; bj < 2; ++bj)
#pragma unroll
                    for (int n = 0; n < 2; ++n) { const f32x4 xv = *(const f32x4*)(xin + off + bj * HALF + n * 16); *(f32x4*)(xout + off + bj * HALF + n * 16) = xv + gs[bj][n] * acc[ai][bj][m][n]; }
                asm volatile("" ::: "memory"); }
    }
};
struct EpiSwiglu {
    static constexpr bool PERM = true;
    bf16_t* O; int ldo;
    __device__ __forceinline__ void operator()(const f32x4 (&acc)[2][2][4][2], const Unit& u, int wr, int wc, int fr, int fq) const {
        const int row0 = u.pm * BM + wr * 64 + fr, col0 = u.pn * HALF + wc * 32 + 8 * fq;
#pragma unroll
        for (int ai = 0; ai < 2; ++ai)
#pragma unroll
            for (int m = 0; m < 4; ++m) { bf16_t* rowp = O + (size_t)(row0 + ai * HALF + m * 16) * ldo + col0; float v[8];
#pragma unroll
                for (int n = 0; n < 2; ++n)
#pragma unroll
                    for (int j = 0; j < 4; ++j) { const float g = acc[ai][0][m][n][j], uu = acc[ai][1][m][n][j]; v[n * 4 + j] = g * uu * __builtin_amdgcn_rcpf(1.0f + __expf(-g)); }
                u32x4 w; w.x = cvt_pk_bf16(v[0], v[1]); w.y = cvt_pk_bf16(v[2], v[3]); w.z = cvt_pk_bf16(v[4], v[5]); w.w = cvt_pk_bf16(v[6], v[7]);
                *(u32x4*)rowp = w; }
    }
};
struct EpiBf16 {
    static constexpr bool PERM = true;
    bf16_t* O; int ldo;
    __device__ __forceinline__ void operator()(const f32x4 (&acc)[2][2][4][2], const Unit& u, int wr, int wc, int fr, int fq) const {
        const int row0 = u.pm * BM + wr * 64 + fr, col0 = u.pn * BM + wc * 32 + 8 * fq;
#pragma unroll
        for (int ai = 0; ai < 2; ++ai)
#pragma unroll
            for (int m = 0; m < 4; ++m) { bf16_t* rowp = O + (size_t)(row0 + ai * HALF + m * 16) * ldo + col0;
#pragma unroll
                for (int bj = 0; bj < 2; ++bj) { const f32x4 v0 = acc[ai][bj][m][0], v1 = acc[ai][bj][m][1];
                    u32x4 w; w.x = cvt_pk_bf16(v0[0], v0[1]); w.y = cvt_pk_bf16(v0[2], v0[3]); w.z = cvt_pk_bf16(v1[0], v1[1]); w.w = cvt_pk_bf16(v1[2], v1[3]);
                    *(u32x4*)(rowp + bj * HALF) = w; } }
    }
};
struct EpiQKV {
    static constexpr bool PERM = true;
    bf16_t* qkvc; const float* qg; const float* kg; const float* cosT; const float* sinT; PG8_LAS float* tab;
    __device__ __forceinline__ void operator()(f32x4 (&acc)[2][2][4][2], const Unit& u, int wr, int wc, int fr, int fq) const {
        const int g = u.pn / 12, which = (u.pn % 12) >> 2, hp = u.pn & 3, sh = 2 * g, d = 1 << sh;
        const int b = (u.pm * BM) / SEQ, p0 = (u.pm * BM) % SEQ + wr * 64 + fr;
        if (which < 2) {
#pragma unroll
            for (int ai = 0; ai < 2; ++ai)
#pragma unroll
                for (int bj = 0; bj < 2; ++bj)
#pragma unroll
                    for (int m = 0; m < 4; ++m) { const f32x4 a = acc[ai][bj][m][0], c = acc[ai][bj][m][1];
                        float s = (a[0] * a[0] + a[1] * a[1]) + (a[2] * a[2] + a[3] * a[3]) + (c[0] * c[0] + c[1] * c[1]) + (c[2] * c[2] + c[3] * c[3]);
                        s += __shfl_xor(s, 16); s += __shfl_xor(s, 32);
                        if (fq == 0) tab[((((ai * 2 + bj) * 4 + m) * 2 + wr) * 16 + fr) * 4 + wc] = s; }
            asm volatile("s_waitcnt lgkmcnt(0)" ::: "memory"); __builtin_amdgcn_s_barrier(); asm volatile("" ::: "memory");
            const float* gain = (which == 0 ? qg : kg) + g * HEAD_DIM + wc * 32 + 8 * fq;
            const f32x4 g0 = *(const f32x4*)gain, g1 = *(const f32x4*)(gain + 4);
#pragma unroll
            for (int ai = 0; ai < 2; ++ai)
#pragma unroll
                for (int m = 0; m < 4; ++m) {
                    f32x4 cs0, cs1, sn0, sn1;
                    if (wc == 0) { const size_t ti = (size_t)(b * SEQ + p0 + ai * HALF + m * 16) * 16 + 8 * (fq & 1);
                        cs0 = *(const f32x4*)(cosT + ti); cs1 = *(const f32x4*)(cosT + ti + 4); sn0 = *(const f32x4*)(sinT + ti); sn1 = *(const f32x4*)(sinT + ti + 4); }
#pragma unroll
                    for (int bj = 0; bj < 2; ++bj) { const f32x4 t = *(const PG8_LAS f32x4*)(tab + ((((ai * 2 + bj) * 4 + m) * 2 + wr) * 16 + fr) * 4);
                        const float rstd = rsqrtf(((t[0] + t[1]) + (t[2] + t[3])) * (1.0f / HEAD_DIM) + NORM_EPS);
                        f32x4 v0 = acc[ai][bj][m][0] * rstd * g0, v1 = acc[ai][bj][m][1] * rstd * g1;
                        if (wc == 0) {
                            f32x4 o0, o1;
#pragma unroll
                            for (int j = 0; j < 4; ++j) { const float pa = __shfl_xor(v0[j], 32), pb = __shfl_xor(v1[j], 32);
                                o0[j] = (fq < 2) ? v0[j] * cs0[j] - pa * sn0[j] : v0[j] * cs0[j] + pa * sn0[j];
                                o1[j] = (fq < 2) ? v1[j] * cs1[j] - pb * sn1[j] : v1[j] * cs1[j] + pb * sn1[j]; }
                            v0 = o0; v1 = o1; }
                        acc[ai][bj][m][0] = v0; acc[ai][bj][m][1] = v1; } }
        }
        bf16_t* base = qkvc + (size_t)(g * 3 + which) * ((size_t)M_TOK * D_MODEL) + wc * 32 + 8 * fq;
        const int Lg = SEQ >> sh;
#pragma unroll
        for (int ai = 0; ai < 2; ++ai)
#pragma unroll
            for (int m = 0; m < 4; ++m) { const int p = p0 + ai * HALF + m * 16, j = p >> sh, r = p & (d - 1);
#pragma unroll
                for (int bj = 0; bj < 2; ++bj) { const int h = 2 * hp + bj; const f32x4 v0 = acc[ai][bj][m][0], v1 = acc[ai][bj][m][1];
                    u32x4 w; w.x = cvt_pk_bf16(v0[0], v0[1]); w.y = cvt_pk_bf16(v0[2], v0[3]); w.z = cvt_pk_bf16(v1[0], v1[1]); w.w = cvt_pk_bf16(v1[2], v1[3]);
                    *(u32x4*)(base + ((size_t)(((b << sh) | r) * NHEAD + h) * Lg + j) * HEAD_DIM) = w; } }
    }
};
}
namespace swa {
constexpr int D = 128;
constexpr float THR = 8.f;
constexpr bool WSKIP = true;
constexpr float SCALE = 0.08838834764831845f;
constexpr int NW = 8, QBLK = 32, KVBLK = 64, QB = NW * QBLK;
constexpr int SHM_V = KVBLK * D * 2, SHM_K = KVBLK * D * 2;
constexpr int LDS_BYTES = 2 * SHM_V + 2 * SHM_K + NW * 64 * 4;
using bf16 = __hip_bfloat16;
typedef short bf16x8 __attribute__((ext_vector_type(8)));
typedef short s16x4 __attribute__((ext_vector_type(4)));
typedef float f32x16 __attribute__((ext_vector_type(16)));
typedef float f32x4 __attribute__((ext_vector_type(4)));
typedef unsigned u32x4 __attribute__((ext_vector_type(4)));
template <class A, class Bt> struct same_t { static constexpr bool v = false; };
template <class A> struct same_t<A, A> { static constexpr bool v = true; };

#define KSWZ(row, colB) ((row) * 256 + ((colB) ^ (((row) & 7) << 4)))
#define SBAR() __builtin_amdgcn_sched_barrier(0)
__device__ __forceinline__ int v_st(int k, int c) { const int kk = (k & ~0xC) | ((k & 4) << 1) | ((k & 8) >> 1); return ((kk >> 3) * 4 + (c >> 5)) * 512 + ((kk & 7) * 32 + (c & 31)) * 2; }
__device__ __forceinline__ int v_rd_base(int lane) { return ((lane & 3) << 3) | (((lane >> 2) & 3) << 6) | (((lane >> 4) & 1) << 5) | (((lane >> 5) & 1) << 8); }
constexpr int v_rd_off(int d0, int ks, int half) { return d0 * 512 + ks * 4096 + half * 2048; }
__device__ __forceinline__ int crow(int r, int hi) { return (r & 3) + 8 * (r >> 2) + 4 * hi; }
__device__ __forceinline__ unsigned cvtpk(float lo, float hi) {
    unsigned r; asm volatile("v_cvt_pk_bf16_f32 %0, %1, %2" : "=v"(r) : "v"(lo), "v"(hi)); return r;
}
__device__ __forceinline__ bf16x8 pack8(f32x4 a, f32x4 b) {
    u32x4 w = {cvtpk(a[0], a[1]), cvtpk(a[2], a[3]), cvtpk(b[0], b[1]), cvtpk(b[2], b[3])};
    return *reinterpret_cast<bf16x8*>(&w);
}
template <class T> __device__ __forceinline__ bf16x8 load8(const T* p) {
    if constexpr (same_t<T, float>::v) { return pack8(*(const f32x4*)p, *(const f32x4*)(p + 4)); }
    else { return *reinterpret_cast<const bf16x8*>(p); }
}
__device__ __forceinline__ void mask_tile(f32x16& p0, f32x16& p1, int dq, unsigned W) {
    const float NEG = -__builtin_inff();
#pragma unroll
    for (int r = 0; r < 16; ++r) {
        const int c = (r & 3) + 8 * (r >> 2);
        if ((unsigned)(dq - c) >= W) p0[r] = NEG;
        if ((unsigned)(dq - c - 32) >= W) p1[r] = NEG;
    }
}
__device__ __forceinline__ void partialSM(f32x16& p0, f32x16& p1, float& m_reg, float& mn, float& alpha) {
    float pmax = p0[0]; for (int r = 1; r < 16; ++r) pmax = fmaxf(pmax, p0[r]); for (int r = 0; r < 16; ++r) pmax = fmaxf(pmax, p1[r]);
    { auto rr = __builtin_amdgcn_permlane32_swap(__float_as_uint(pmax), __float_as_uint(pmax), false, false);
      pmax = fmaxf(__uint_as_float(rr[0]), __uint_as_float(rr[1])); }
    constexpr float C2 = 1.4426950408889634f * SCALE;
    if (__builtin_expect(__all((pmax - m_reg) * SCALE <= THR), 1)) { mn = m_reg; alpha = 1.f; }
    else { mn = fmaxf(m_reg, pmax); alpha = __builtin_amdgcn_exp2f((m_reg - mn) * C2); m_reg = mn; }
    const float mnL = -mn * C2;
    for (int r = 0; r < 16; ++r) p0[r] = fmaf(p0[r], C2, mnL); for (int r = 0; r < 16; ++r) p1[r] = fmaf(p1[r], C2, mnL);
    for (int r = 0; r < 16; ++r) p0[r] = __builtin_amdgcn_exp2f(p0[r]);
}
__device__ __forceinline__ void finishSM(f32x16& p0, f32x16& p1, float alpha, float& l_reg, bf16x8& pa0, bf16x8& pa1, bf16x8& pa2, bf16x8& pa3) {
    for (int r = 0; r < 16; ++r) p1[r] = __builtin_amdgcn_exp2f(p1[r]);
    float ps = 0; for (int r = 0; r < 16; ++r) ps += p0[r]; for (int r = 0; r < 16; ++r) ps += p1[r];
    { auto rr = __builtin_amdgcn_permlane32_swap(__float_as_uint(ps), __float_as_uint(ps), false, false);
      ps = __uint_as_float(rr[0]) + __uint_as_float(rr[1]); }
    l_reg = l_reg * alpha + ps;
#define PK4(P, B_, OUT) do { unsigned a0 = cvtpk(P[B_+0], P[B_+1]), a1 = cvtpk(P[B_+2], P[B_+3]);                          \
        unsigned b0 = cvtpk(P[B_+4], P[B_+5]), b1 = cvtpk(P[B_+6], P[B_+7]);                                             \
        auto r0 = __builtin_amdgcn_permlane32_swap(a0, b0, false, false); auto r1 = __builtin_amdgcn_permlane32_swap(a1, b1, false, false); \
        u32x4 w = {r0[0], r1[0], r0[1], r1[1]}; OUT = *reinterpret_cast<bf16x8*>(&w); } while (0)
    PK4(p0, 0, pa0); PK4(p0, 8, pa1); PK4(p1, 0, pa2); PK4(p1, 8, pa3);
#undef PK4
}
template <int KB, bool SK>
__device__ __forceinline__ void qkt(f32x16& p0, f32x16& p1, const char* K_lds, int r32, int hi, const bf16x8* qr, bool act) {
    if (SK && !act) { const float NEG = -__builtin_inff();
#pragma unroll
        for (int r = 0; r < 16; ++r) { p0[r] = NEG; p1[r] = NEG; } return; }
    p0 = f32x16{}; p1 = f32x16{};
    const char* kb[4];
#pragma unroll
    for (int dd = 0; dd < 4; ++dd) kb[dd] = K_lds + KB * SHM_K + KSWZ(r32, (dd * 16 + hi * 8) * 2);
#pragma unroll
    for (int d0 = 0; d0 < 8; ++d0) { const char* a = kb[d0 & 3] + (d0 >> 2) * 128;
        bf16x8 b0 = *reinterpret_cast<const bf16x8*>(a);
        bf16x8 b1 = *reinterpret_cast<const bf16x8*>(a + 32 * 256);
        p0 = __builtin_amdgcn_mfma_f32_32x32x16_bf16(b0, qr[d0], p0, 0, 0, 0);
        p1 = __builtin_amdgcn_mfma_f32_32x32x16_bf16(b1, qr[d0], p1, 0, 0, 0); }
}
template <int VB, bool SK>
__device__ __forceinline__ void pv_tile(f32x16* o, int vb0, bf16x8 pa0, bf16x8 pa1, bf16x8 pa2, bf16x8 pa3, bool act) {
    if (SK && !act) return;
#define TRRD(dst, off) asm volatile("ds_read_b64_tr_b16 %0, %1 offset:%2" : "=&v"(dst) : "v"(vb0), "i"(off) : "memory")
#define PV_D0(d0) do { s16x4 l0, l1, l2, l3, h0, h1, h2, h3; constexpr int b_ = VB * SHM_V + v_rd_off(d0, 0, 0);     \
        TRRD(l0, b_); TRRD(h0, b_ + 2048); TRRD(l1, b_ + 4096); TRRD(h1, b_ + 6144); TRRD(l2, b_ + 8192); TRRD(h2, b_ + 10240); TRRD(l3, b_ + 12288); TRRD(h3, b_ + 14336); \
        asm volatile("s_waitcnt lgkmcnt(0)" ::: "memory"); SBAR();                 \
        o[d0] = __builtin_amdgcn_mfma_f32_32x32x16_bf16(pa0, (bf16x8){l0[0], l0[1], l0[2], l0[3], h0[0], h0[1], h0[2], h0[3]}, o[d0], 0, 0, 0);   \
        o[d0] = __builtin_amdgcn_mfma_f32_32x32x16_bf16(pa1, (bf16x8){l1[0], l1[1], l1[2], l1[3], h1[0], h1[1], h1[2], h1[3]}, o[d0], 0, 0, 0);   \
        o[d0] = __builtin_amdgcn_mfma_f32_32x32x16_bf16(pa2, (bf16x8){l2[0], l2[1], l2[2], l2[3], h2[0], h2[1], h2[2], h2[3]}, o[d0], 0, 0, 0);   \
        o[d0] = __builtin_amdgcn_mfma_f32_32x32x16_bf16(pa3, (bf16x8){l3[0], l3[1], l3[2], l3[3], h3[0], h3[1], h3[2], h3[3]}, o[d0], 0, 0, 0); } while (0)
    PV_D0(0); PV_D0(1); PV_D0(2); PV_D0(3);
#undef PV_D0
#undef TRRD
}

template <class TIn, class TOut> struct BlockRef { const TIn* Q; const TIn* K; const TIn* V; TOut* O; int P0; };
template <class TIn> struct Seam {
    bf16x8 qr[8];
    bf16x8 st_v0, st_v1, st_k0, st_k1; f32x4 sf0, sf1, sf2, sf3;
    f32x4 tq[16];
};
__device__ __forceinline__ int swa_jlo(int P0, int W) { const int lowk = P0 - W + 1; return lowk > 0 ? lowk / KVBLK : 0; }
#define ROW(p, k0, rr) ((p) + (size_t)((k0) + (rr)) * D + sc)
#define VMW() asm volatile("s_waitcnt vmcnt(0)" ::: "memory")
#define VMWN(n) asm volatile("s_waitcnt vmcnt(%0)" :: "i"(n) : "memory")
#define SLOAD_H(Kp, Vp, k0) do { S.st_v0 = load8<TIn>(ROW(Vp, k0, sr)); S.st_v1 = load8<TIn>(ROW(Vp, k0, 32 + sr));              \
                         S.st_k0 = load8<TIn>(ROW(Kp, k0, sr)); S.st_k1 = load8<TIn>(ROW(Kp, k0, 32 + sr)); } while (0)
#define SWRITE_HK(bf) do { *(bf16x8*)(K_lds + (bf) * SHM_K + kws) = S.st_k0; *(bf16x8*)(K_lds + (bf) * SHM_K + kws + 32 * 256) = S.st_k1; } while (0)
#define SWRITE_HV(bf) do { *(bf16x8*)(V_lds + (bf) * SHM_V + vst0) = S.st_v0; *(bf16x8*)(V_lds + (bf) * SHM_V + vst1) = S.st_v1; } while (0)
#define SWRITE_H(bf) do { SWRITE_HV(bf); SWRITE_HK(bf); } while (0)
#define SLOAD_F(p, k0) do { S.sf0 = *(const f32x4*)ROW(p, k0, sr); S.sf1 = *(const f32x4*)(ROW(p, k0, sr) + 4);                \
                            S.sf2 = *(const f32x4*)ROW(p, k0, 32 + sr); S.sf3 = *(const f32x4*)(ROW(p, k0, 32 + sr) + 4); } while (0)
#define SWRITE_KF(bf) do { *(bf16x8*)(K_lds + (bf) * SHM_K + kws) = pack8(S.sf0, S.sf1); *(bf16x8*)(K_lds + (bf) * SHM_K + kws + 32 * 256) = pack8(S.sf2, S.sf3); } while (0)
#define SWRITE_VF(bf) do { *(bf16x8*)(V_lds + (bf) * SHM_V + vst0) = pack8(S.sf0, S.sf1); *(bf16x8*)(V_lds + (bf) * SHM_V + vst1) = pack8(S.sf2, S.sf3); } while (0)
template <class TIn, class TOut>
__device__ __forceinline__ void causal_swa_prime(const BlockRef<TIn, TOut>& cur, int W, char* lds, Seam<TIn>& S) {
    constexpr bool F32 = same_t<TIn, float>::v;
    int tid = threadIdx.x; asm volatile("" : "+v"(tid));
    const int wid = __builtin_amdgcn_readfirstlane(tid >> 6), lane = tid & 63, r32 = lane & 31, hi = lane >> 5;
    const int sr = tid >> 4, sc = (tid & 15) * 8, kws = KSWZ(sr, sc * 2); char* K_lds = lds + 2 * SHM_V;
    const int kb0 = swa_jlo(cur.P0, W) * KVBLK;
    for (int d0 = 0; d0 < 8; ++d0) S.qr[d0] = load8<TIn>(cur.Q + (size_t)(wid * QBLK + r32) * D + d0 * 16 + hi * 8);
    if constexpr (F32) { SLOAD_F((const float*)cur.K, kb0); VMW(); SWRITE_KF(0); SBAR(); SLOAD_F((const float*)cur.V, kb0); }
    else { SLOAD_H(cur.K, cur.V, kb0); VMW(); SWRITE_HK(0); }
    __syncthreads();
}
template <class TIn, class TOut>
__device__ __forceinline__ void causal_swa_block(const BlockRef<TIn, TOut>& cur, const BlockRef<TIn, TOut>& nxt, int skv, int W, char* lds, Seam<TIn>& S, const char* og_base, char* lse_base) {
    constexpr bool F32 = same_t<TIn, float>::v;
    int tid = threadIdx.x; asm volatile("" : "+v"(tid));
    const int wid = __builtin_amdgcn_readfirstlane(tid >> 6), lane = tid & 63, r32 = lane & 31, hi = lane >> 5;
    const int j_lo = swa_jlo(cur.P0, W);
    int j_hi = (cur.P0 + QB - 1) / KVBLK + 1; if (j_hi > skv / KVBLK) j_hi = skv / KVBLK;
    const int NT = j_hi - j_lo;
    const int kbn = swa_jlo(nxt.P0, W) * KVBLK;
    const int qlo = cur.P0 + wid * QBLK, qm = qlo + r32 - 4 * hi;
    char* V_lds = lds; char* K_lds = lds + 2 * SHM_V;
    float* ws = (float*)(lds + 2 * SHM_V + 2 * SHM_K) + wid * 64; float* li_l = ws, * al_l = ws + 32;
    float m_reg = -1e30f, l_reg = 0; f32x16 o[4] = {};
    const int sr = tid >> 4, sc = (tid & 15) * 8, vst0 = v_st(sr, sc), vst1 = v_st(32 + sr, sc), kws = KSWZ(sr, sc * 2);
    const int vb0 = (int)(uintptr_t)V_lds + v_rd_base(lane);
    const TIn* Kh = cur.K; const TIn* Vh = cur.V;
#define RESC(a) do { if (__any((a) < 1.f)) { if (hi == 0) al_l[r32] = (a); asm volatile("s_waitcnt lgkmcnt(0)" ::: "memory");              \
                     for (int d_ = 0; d_ < 4; ++d_) for (int r = 0; r < 16; ++r) o[d_][r] *= al_l[crow(r, hi)]; } } while (0)
#define KBASE(t) ((j_lo + (t)) * KVBLK)
#define ACT(t) (KBASE(t) <= qlo + QBLK - 1 && KBASE(t) + KVBLK - 1 >= qlo - W + 1)
#define MASKT(P0_, P1_, t) do { const int kb_ = KBASE(t); if ((!SK || ACT(t)) && (kb_ + KVBLK - 1 > qlo || kb_ <= qlo + QBLK - 1 - W)) mask_tile(P0_, P1_, qm - kb_, (unsigned)W); } while (0)
    constexpr int NQL = F32 ? 16 : 8;
    constexpr bool SK = WSKIP && !F32;
#define SEAM_K0() do { VMWN(NQL); if constexpr (F32) { SWRITE_KF(0); SBAR(); SLOAD_F((const float*)nxt.V, kbn); } else { SWRITE_HK(0); } SBAR(); } while (0)
    f32x16 pA0, pA1, pB0, pB1; float mnA, mnB, alA, alB; bf16x8 pa0, pa1, pa2, pa3;
    if constexpr (F32) { VMW(); SWRITE_VF(0); SBAR(); } else { SWRITE_HV(0); SBAR(); }
    if (NT > 1) { if constexpr (F32) SLOAD_F((const float*)Kh, KBASE(1)); else SLOAD_H(Kh, Vh, KBASE(1)); }
    SBAR(); qkt<0, SK>(pA0, pA1, K_lds, r32, hi, S.qr, ACT(0));
    if constexpr (F32) { if (NT > 1) { VMW(); SWRITE_KF(1); SBAR(); SLOAD_F((const float*)Vh, KBASE(1)); } }
    MASKT(pA0, pA1, 0); partialSM(pA0, pA1, m_reg, mnA, alA);
    if (NT > 1) { VMW(); if constexpr (F32) { SWRITE_VF(1); SBAR(); if (NT > 2) SLOAD_F((const float*)Kh, KBASE(2)); } else SWRITE_H(1); }
    __syncthreads();
#define HALF_STEP(PX0, PX1, mnX, alX, PY0, PY1, alY, t, KB, VB, SB) do {                                                      \
        SBAR(); qkt<KB, SK>(PX0, PX1, K_lds, r32, hi, S.qr, ACT(t));                                             \
        finishSM(PY0, PY1, alY, l_reg, pa0, pa1, pa2, pa3); SBAR();                                                           \
        if ((t) + 1 < NT) { if constexpr (F32) { VMW(); SWRITE_KF(SB); SBAR(); SLOAD_F((const float*)Vh, KBASE((t) + 1)); }  \
                            else { SLOAD_H(Kh, Vh, KBASE((t) + 1)); } SBAR(); }                                               \
        pv_tile<VB, SK>(o, vb0, pa0, pa1, pa2, pa3, ACT((t) - 1)); MASKT(PX0, PX1, (t)); partialSM(PX0, PX1, m_reg, mnX, alX);                                        \
        __syncthreads();                                                                                                      \
        if ((t) + 1 < NT) { VMW(); if constexpr (F32) { SWRITE_VF(SB); SBAR(); if ((t) + 2 < NT) SLOAD_F((const float*)Kh, KBASE((t) + 2)); } \
                            else { SWRITE_H(SB); } }                                                                          \
        RESC(alX); __syncthreads(); } while (0)
    for (int t = 1; t + 1 < NT; t += 2) {
        HALF_STEP(pB0, pB1, mnB, alB, pA0, pA1, alA, t, 1, 0, 0);
        HALF_STEP(pA0, pA1, mnA, alA, pB0, pB1, alB, t + 1, 0, 1, 1);
    }
    const bool even = (NT & 1) == 0;
    if (even) { SBAR(); qkt<1, SK>(pB0, pB1, K_lds, r32, hi, S.qr, ACT(NT - 1)); SBAR(); }
#define QROW(e) (nxt.Q + (size_t)(wid * QBLK + r32) * D + ((e) >> 1) * 16 + hi * 8 + ((e) & 1) * 4)
    if constexpr (F32) { SLOAD_F((const float*)nxt.K, kbn); SBAR();
#pragma unroll
        for (int e = 0; e < 8; ++e) S.tq[e] = *(const f32x4*)QROW(e); }
    else { SLOAD_H(nxt.K, nxt.V, kbn); SBAR();
#pragma unroll
        for (int d0 = 0; d0 < 8; ++d0) S.qr[d0] = load8<TIn>(nxt.Q + (size_t)(wid * QBLK + r32) * D + d0 * 16 + hi * 8); }
    SBAR();
    finishSM(pA0, pA1, alA, l_reg, pa0, pa1, pa2, pa3); SBAR();
    if constexpr (F32) {
#pragma unroll
        for (int e = 8; e < 16; ++e) S.tq[e] = *(const f32x4*)QROW(e); SBAR(); }
#undef QROW
    pv_tile<0, SK>(o, vb0, pa0, pa1, pa2, pa3, ACT(even ? NT - 2 : NT - 1));
    if (even) { MASKT(pB0, pB1, NT - 1); partialSM(pB0, pB1, m_reg, mnB, alB); __syncthreads(); RESC(alB);
        finishSM(pB0, pB1, alB, l_reg, pa0, pa1, pa2, pa3); SBAR(); pv_tile<1, SK>(o, vb0, pa0, pa1, pa2, pa3, ACT(NT - 1)); }
    SBAR(); SEAM_K0();
    if (hi == 0) { li_l[r32] = l_reg; ((float*)(lse_base + (((const char*)cur.O - og_base) >> 6)))[wid * QBLK + r32] = m_reg * SCALE + __logf(l_reg); } asm volatile("s_waitcnt lgkmcnt(0)" ::: "memory");
    float rli[16];
#pragma unroll
    for (int r = 0; r < 16; ++r) rli[r] = __builtin_amdgcn_rcpf(li_l[crow(r, hi)]);
    TOut* Ow = cur.O + (size_t)(wid * QBLK) * D;
#pragma unroll
    for (int r = 0; r < 16; ++r) { const int orow = crow(r, hi);
#pragma unroll
        for (int d0 = 0; d0 < 4; ++d0) { const float v = o[d0][r] * rli[r];
            if constexpr (same_t<TOut, float>::v) { Ow[(size_t)orow * D + d0 * 32 + r32] = v; }
            else { const float vn = __shfl_xor(v, 1);
                   if ((r32 & 1) == 0) *(unsigned*)(Ow + (size_t)orow * D + d0 * 32 + r32) = cvtpk(v, vn); } } }
    if constexpr (F32) {
#pragma unroll
        for (int d0 = 0; d0 < 8; ++d0) S.qr[d0] = pack8(S.tq[2 * d0], S.tq[2 * d0 + 1]); }
    __syncthreads();
#undef RESC
#undef KBASE
#undef ACT
#undef MASKT
#undef SEAM_K0
#undef HALF_STEP
}
#undef ROW
#undef VMW
#undef VMWN
#undef SLOAD_H
#undef SWRITE_HK
#undef SWRITE_HV
#undef SWRITE_H
#undef SLOAD_F
#undef SWRITE_KF
#undef SWRITE_VF


}
constexpr int NWAVES = 8;
#ifndef MK_PER_PHASE
#define MK_PER_PHASE 0
#endif
constexpr int PH_PER_PAIR = 14, NPHASES = 2 + 2 * PH_PER_PAIR;

constexpr size_t MiB = 1u << 20;
constexpr size_t WS_CTL = 0, CTL_ZERO_BYTES = 1 * MiB;
constexpr size_t WS_MODP = 1 * MiB;
constexpr size_t WS_COS = 3 * MiB, WS_SIN = 5 * MiB;
constexpr size_t WS_EIDX = 7 * MiB, WS_GATE = 7 * MiB + 256 * 1024, WS_SLOTOF = 7 * MiB + 512 * 1024, WS_STOK = 8 * MiB;
constexpr size_t WS_LSE = 9 * MiB;
constexpr size_t WS_WQKV = 16 * MiB, WS_WO = 52 * MiB, WS_WGU = 56 * MiB, WS_WDN = 78 * MiB, WS_WPOOL = 89 * MiB, WS_WMGU = 90 * MiB, WS_WMDN = 314 * MiB;
constexpr size_t WS_XB = 432 * MiB;
constexpr size_t WS_H = 560 * MiB;
constexpr size_t WS_BIG = 624 * MiB;
constexpr size_t WS_QKVC = WS_BIG, WS_OG = WS_BIG + 576 * MiB;
constexpr size_t WS_ACT = WS_BIG;
constexpr size_t WS_Y = WS_BIG + 480 * MiB;
constexpr size_t WS_END = WS_BIG + 768 * MiB;
constexpr int MAX_TILES = 2 * M_TOK / 256 + N_EXP, MAX_SLOTS = MAX_TILES * 256;
static_assert(WS_ACT + (size_t)MAX_SLOTS * D_FFE * 2 <= WS_Y && WS_Y + (size_t)MAX_SLOTS * D_MODEL * 2 <= WS_END && WS_STOK + (size_t)MAX_SLOTS * 4 <= WS_LSE, "d_ws map");
constexpr int CW_BAR = 4096;
constexpr int CW_CNT = 8192, CW_CUR = 12288;

constexpr int RING_OFF = 0, RING_BYTES = 131072;
constexpr int TAB_OFF = RING_BYTES;
constexpr int MISC_OFF = TAB_OFF + 8192;
constexpr int LDS_BYTES = 147456;
static_assert(MISC_OFF + 128 <= LDS_BYTES, "LDS map");

#define GAS __attribute__((address_space(1)))
#define LAS __attribute__((address_space(3)))
typedef unsigned short bf16;
typedef unsigned v4u __attribute__((ext_vector_type(4)));
typedef unsigned v2u __attribute__((ext_vector_type(2)));
typedef int v2i __attribute__((ext_vector_type(2)));
typedef float f32x4 __attribute__((ext_vector_type(4)));
typedef float f32x2 __attribute__((ext_vector_type(2)));
#define LDS_WAIT() asm volatile("s_waitcnt lgkmcnt(0)" ::: "memory")
#define VM_WAIT() asm volatile("s_waitcnt vmcnt(0)" ::: "memory")
__device__ __forceinline__ unsigned pk2(float lo, float hi) { return pg8::cvt_pk_bf16(lo, hi); }
__device__ __forceinline__ float bflo(unsigned w) { return __uint_as_float(w << 16); }
__device__ __forceinline__ float bfhi(unsigned w) { return __uint_as_float(w & 0xffff0000u); }
__device__ __forceinline__ float wave_sum(float v) {
#pragma unroll
    for (int o = 1; o < 64; o <<= 1) v += __shfl_xor(v, o);
    return v;
}
__device__ __forceinline__ int rdlane_i(int v, int l) { return __builtin_amdgcn_readlane(v, l); }
__device__ __forceinline__ float rdlane_f(float v, int l) { return __uint_as_float((unsigned)__builtin_amdgcn_readlane((int)__float_as_uint(v), l)); }

#define XB_TMO      128
#define XB_XCNT(j)  (256  + 64 * (j))
#define XB_XSUB(j)  (1280 + 64 * (j))
#define XB_XGEN(j)  (2304 + 64 * (j))
#define XB_TOP      3328
#define XB_TOPGEN   3392
#define XCD_BAR_WORDS 3456
#define XB_SPIN_CAP (1u << 18)

__device__ __forceinline__ unsigned xb_ld(unsigned* p)              { return __hip_atomic_load(p, __ATOMIC_RELAXED, __HIP_MEMORY_SCOPE_AGENT); }
__device__ __forceinline__ unsigned xb_add(unsigned* p, unsigned v) { return __hip_atomic_fetch_add(p, v, __ATOMIC_RELAXED, __HIP_MEMORY_SCOPE_AGENT); }
__device__ __forceinline__ unsigned xb_xcc_id() { return (unsigned)__builtin_amdgcn_s_getreg((3 << 11) | 20) & 0xFu; }
#define XB_SPIN(cond, bar) do { unsigned _sp = 0; while (cond) { __builtin_amdgcn_s_sleep(1); \
    if ((++_sp & 255u) == 0u) { if (xb_ld(&(bar)[XB_TMO])) break; if (_sp > XB_SPIN_CAP) { atomicAdd(&(bar)[XB_TMO], 1u); break; } } } } while (0)

struct XcdBarrier {
    unsigned* bar; unsigned x;
    volatile LAS unsigned* st;
};

__device__ __forceinline__ XcdBarrier xcd_barrier_post(unsigned* bar, volatile LAS unsigned* st) {
    XcdBarrier b; b.bar = bar; b.x = xb_xcc_id(); b.st = st;
    if (threadIdx.x == 0) (void)xb_add(&bar[XB_XCNT(b.x)], 1u);
    return b;
}
__device__ __forceinline__ void xcd_barrier_complete(unsigned* bar, unsigned x, unsigned& nloc, unsigned& nx) {
    const unsigned G = gridDim.x * gridDim.y * gridDim.z;
    unsigned sum, cnt, mine, sp = 0u;
    for (;;) {
        sum = 0u; cnt = 0u; mine = 0u;
#pragma unroll
        for (unsigned j = 0; j < 16; ++j) { const unsigned c = xb_ld(&bar[XB_XCNT(j)]); sum += c; cnt += (c > 0u) ? 1u : 0u; mine = (j == x) ? c : mine; }
        if (sum == G) break;
        __builtin_amdgcn_s_sleep(1);
        if ((++sp & 255u) == 0u) { if (xb_ld(&bar[XB_TMO])) break; if (sp > XB_SPIN_CAP) { atomicAdd(&bar[XB_TMO], 1u); break; } }
    }
    nloc = mine > 0u ? mine : 1u; nx = cnt > 0u ? cnt : 1u;
}

__device__ __forceinline__ void xcd_barrier(const XcdBarrier& b) {
    asm volatile("s_waitcnt vmcnt(0)" ::: "memory");
    __syncthreads();
    if (threadIdx.x == 0) {
        unsigned* bar = b.bar;
        __builtin_amdgcn_s_waitcnt(0);
        unsigned nloc = b.st[0], nx = b.st[1];
        if (nloc == 0u) { xcd_barrier_complete(bar, b.x, nloc, nx); b.st[0] = nloc; b.st[1] = nx; }
        const unsigned old = xb_add(&bar[XB_XSUB(b.x)], 1u);
        const unsigned gen = old / nloc;
        if (old + 1u == (gen + 1u) * nloc) {
            __builtin_amdgcn_fence(__ATOMIC_RELEASE, "agent");
            asm volatile("s_waitcnt vmcnt(0)" ::: "memory");
            const unsigned og = xb_add(&bar[XB_TOP], 1u);
            const unsigned tg = og / nx;
            if (og + 1u == (tg + 1u) * nx) xb_add(&bar[XB_TOPGEN], 1u);
            else XB_SPIN(xb_ld(&bar[XB_TOPGEN]) == tg, bar);
            __builtin_amdgcn_fence(__ATOMIC_ACQUIRE, "agent");
            xb_add(&bar[XB_XGEN(b.x)], 1u);
            asm volatile("s_waitcnt vmcnt(0)" ::: "memory");
        } else {
            XB_SPIN(xb_ld(&bar[XB_XGEN(b.x)]) == gen, bar);
            __builtin_amdgcn_fence(__ATOMIC_ACQUIRE, "agent");
            asm volatile("s_waitcnt vmcnt(0)" ::: "memory");
        }
    }
    __syncthreads();
}
using pg8::mod4;
__device__ __forceinline__ int gu_row(int n0, int F) { return n0 < F ? (n0 >> 7) * 256 + (n0 & 127) : ((n0 - F) >> 7) * 256 + 128 + ((n0 - F) & 127); }
__device__ __forceinline__ void tr_item(const float* W, int N, int k0, int n0, bf16* WT, int Kd, int drow, LAS float* scr, int lane) {
#pragma unroll 8
    for (int i = 0; i < 32; ++i) { const int kk = 2 * i + (lane >> 5); scr[kk * 33 + (lane & 31)] = W[(size_t)(k0 + kk) * N + n0 + (lane & 31)]; }
    LDS_WAIT(); asm volatile("" ::: "memory");
    const int c = lane & 7;
#pragma unroll
    for (int j = 0; j < 4; ++j) { const int n = (lane >> 3) + 8 * j; const LAS float* s = scr + (8 * c) * 33 + n;
        v4u o; o.x = pk2(s[0 * 33], s[1 * 33]); o.y = pk2(s[2 * 33], s[3 * 33]); o.z = pk2(s[4 * 33], s[5 * 33]); o.w = pk2(s[6 * 33], s[7 * 33]);
        *(GAS v4u*)(WT + (size_t)(drow + n) * Kd + k0 + 8 * c) = o; }
    LDS_WAIT(); asm volatile("" ::: "memory");
}
struct ProIn { const float *c, *ada_w, *pool_w, *wqkv, *wo, *wgu, *wdn, *mgu, *mdn; const int* pos; };
constexpr int TI_QKV = 2 * 16 * 288, TI_WO = 2 * 16 * 32, TI_GU = 2 * 16 * 176, TI_DN = 2 * 44 * 32, TI_POOL = 8 * 4 * 8, TI_MGU = 16 * 16 * 224, TI_MDN = 16 * 56 * 32;
constexpr int TI_ALL = TI_QKV + TI_WO + TI_GU + TI_DN + TI_POOL + TI_MGU + TI_MDN;
__device__ __forceinline__ void p0_prologue(const ProIn& I, unsigned char* ws, LAS unsigned char* lds, int gw, int NGW, int wave, int lane) {
    LAS float* scr = (LAS float*)(lds + RING_OFF + wave * 16384);
    for (int it = gw; it < DEPTH * 24 * 4; it += NGW) {
        const int layer = it / 96, rem = it % 96, chunk = rem >> 2, ks = rem & 3, kb = ks * 256;
#pragma unroll
        for (int q = 0; q < 16; ++q) { const int idx = lane + 64 * q, b = idx >> 8, k = idx & 255; const float cv = I.c[b * D_MODEL + kb + k]; scr[idx] = cv / (1.0f + __expf(-cv)); }
        LDS_WAIT(); asm volatile("" ::: "memory");
        const float* wp = I.ada_w + ((size_t)layer * D_MODEL + kb) * (6 * D_MODEL) + chunk * 256 + 4 * lane;
        f32x4 a0 = {0.f, 0.f, 0.f, 0.f}, a1 = a0, a2 = a0, a3 = a0;
#pragma unroll 2
        for (int k = 0; k < 256; k += 4) {
            const f32x4 w0 = *(const GAS f32x4*)(wp + (size_t)(k + 0) * (6 * D_MODEL)), w1 = *(const GAS f32x4*)(wp + (size_t)(k + 1) * (6 * D_MODEL)), w2 = *(const GAS f32x4*)(wp + (size_t)(k + 2) * (6 * D_MODEL)), w3 = *(const GAS f32x4*)(wp + (size_t)(k + 3) * (6 * D_MODEL));
            const f32x4 c0 = *(const LAS f32x4*)(scr + k), c1 = *(const LAS f32x4*)(scr + 256 + k), c2 = *(const LAS f32x4*)(scr + 512 + k), c3 = *(const LAS f32x4*)(scr + 768 + k);
            a0 += w0 * c0.x + w1 * c0.y + w2 * c0.z + w3 * c0.w; a1 += w0 * c1.x + w1 * c1.y + w2 * c1.z + w3 * c1.w;
            a2 += w0 * c2.x + w1 * c2.y + w2 * c2.z + w3 * c2.w; a3 += w0 * c3.x + w1 * c3.y + w2 * c3.z + w3 * c3.w;
        }
        float* mp = (float*)(ws + WS_MODP) + (size_t)ks * pg8::MOD_SZ + (size_t)(layer * BATCH) * (6 * D_MODEL) + chunk * 256 + 4 * lane;
        *(f32x4*)(mp) = a0; *(f32x4*)(mp + 6 * D_MODEL) = a1; *(f32x4*)(mp + 12 * D_MODEL) = a2; *(f32x4*)(mp + 18 * D_MODEL) = a3;
        LDS_WAIT(); asm volatile("" ::: "memory");
    }
    for (int it = gw; it < M_TOK / 4; it += NGW) {
        const int m = 4 * it + (lane >> 4), i = lane & 15;
        unsigned fb = 0x3f800000u;
        fb = (i == 1) ? 0x3ee177bbu : fb; fb = (i == 2) ? 0x3e4693afu : fb; fb = (i == 3) ? 0x3daee4adu : fb; fb = (i == 4) ? 0x3d1a08c8u : fb; fb = (i == 5) ? 0x3c87a9c2u : fb;
        fb = (i == 6) ? 0x3beef74eu : fb; fb = (i == 7) ? 0x3b52771fu : fb; fb = (i == 8) ? 0x3ab95d22u : fb; fb = (i == 9) ? 0x3a23418cu : fb; fb = (i == 10) ? 0x398fc8f8u : fb;
        fb = (i == 11) ? 0x38fd45c2u : fb; fb = (i == 12) ? 0x385f10c5u : fb; fb = (i == 13) ? 0x37c47611u : fb; fb = (i == 14) ? 0x372d07a8u : fb; fb = (i == 15) ? 0x369864a7u : fb;
        const float invf = __uint_as_float(fb);
        const float angf = (float)I.pos[m] * invf; const double ang = (double)angf;
        const double q = rint(ang * 0.63661977236758134308); const double r = fma(-q, 1.57079632679489661923, ang) - q * 6.123233995736766e-17; const double r2 = r * r;
        double sp = -1.0 / 1307674368000.0; sp = sp * r2 + 1.0 / 6227020800.0; sp = sp * r2 - 1.0 / 39916800.0; sp = sp * r2 + 1.0 / 362880.0; sp = sp * r2 - 1.0 / 5040.0; sp = sp * r2 + 1.0 / 120.0; sp = sp * r2 - 1.0 / 6.0; sp = sp * r2 + 1.0; sp *= r;
        double cp = 1.0 / 20922789888000.0; cp = cp * r2 - 1.0 / 87178291200.0; cp = cp * r2 + 1.0 / 479001600.0; cp = cp * r2 - 1.0 / 3628800.0; cp = cp * r2 + 1.0 / 40320.0; cp = cp * r2 - 1.0 / 720.0; cp = cp * r2 + 1.0 / 24.0; cp = cp * r2 - 0.5; cp = cp * r2 + 1.0;
        const int qi = ((int)q) & 3; const double sv = (qi == 0) ? sp : (qi == 1) ? cp : (qi == 2) ? -sp : -cp, cv = (qi == 0) ? cp : (qi == 1) ? -sp : (qi == 2) ? -cp : sp;
        ((float*)(ws + WS_COS))[(size_t)m * 16 + i] = (float)cv; ((float*)(ws + WS_SIN))[(size_t)m * 16 + i] = (float)sv;
    }
    for (int it0 = gw; it0 < TI_ALL; it0 += NGW) {
        int it = it0; const float* W; bf16* WT; int K, N, nblk, r; bool gu = false; int F = 0;
        if (it < TI_QKV) { const int j = it / (16 * 288); r = it % (16 * 288); K = 1024; N = QKV_W; nblk = 288; W = I.wqkv + (size_t)j * 1024 * QKV_W; WT = (bf16*)(ws + WS_WQKV) + (size_t)j * QKV_W * 1024; }
        else { it -= TI_QKV;
        if (it < TI_WO) { const int j = it / 512; r = it % 512; K = 1024; N = 1024; nblk = 32; W = I.wo + (size_t)j * 1024 * 1024; WT = (bf16*)(ws + WS_WO) + (size_t)j * 1024 * 1024; }
        else { it -= TI_WO;
        if (it < TI_GU) { const int j = it / (16 * 176); r = it % (16 * 176); K = 1024; N = 2 * D_FF; nblk = 176; gu = true; F = D_FF; W = I.wgu + (size_t)j * 1024 * 2 * D_FF; WT = (bf16*)(ws + WS_WGU) + (size_t)j * 2 * D_FF * 1024; }
        else { it -= TI_GU;
        if (it < TI_DN) { const int j = it / (44 * 32); r = it % (44 * 32); K = D_FF; N = 1024; nblk = 32; W = I.wdn + (size_t)j * D_FF * 1024; WT = (bf16*)(ws + WS_WDN) + (size_t)j * 1024 * D_FF; }
        else { it -= TI_DN;
        if (it < TI_POOL) { const int jg = it / 32; r = it % 32; K = 256; N = 256; nblk = 8; W = I.pool_w + (size_t)jg * 65536; WT = (bf16*)(ws + WS_WPOOL) + (size_t)jg * 65536; }
        else { it -= TI_POOL;
        if (it < TI_MGU) { const int je = it / (16 * 224); r = it % (16 * 224); K = 1024; N = 2 * D_FFE; nblk = 224; gu = true; F = D_FFE; W = I.mgu + (size_t)je * 1024 * 2 * D_FFE; WT = (bf16*)(ws + WS_WMGU) + (size_t)je * 2 * D_FFE * 1024; }
        else { it -= TI_MGU;
        { const int je = it / (56 * 32); r = it % (56 * 32); K = D_FFE; N = 1024; nblk = 32; W = I.mdn + (size_t)je * D_FFE * 1024; WT = (bf16*)(ws + WS_WMDN) + (size_t)je * 1024 * D_FFE; } } } } } } }
        const int kb = r / nblk, nb = r % nblk, n0 = 32 * nb;
        tr_item(W, N, 64 * kb, n0, WT, K, gu ? gu_row(n0, F) : n0, scr, lane);
    }
}

__device__ __forceinline__ void ld_row(const float* p, int lane, f32x4 (&v)[4]) {
#pragma unroll
    for (int j = 0; j < 4; ++j) v[j] = *(const GAS f32x4*)(p + 4 * lane + 256 * j); }
__device__ __forceinline__ void ld_yrow(const bf16* p, int lane, v2u (&y)[4]) {
#pragma unroll
    for (int j = 0; j < 4; ++j) y[j] = *(const GAS v2u*)(p + 4 * lane + 256 * j); }
__device__ __forceinline__ f32x4 y4(v2u a) { return (f32x4){bflo(a.x), bfhi(a.x), bflo(a.y), bfhi(a.y)}; }
__device__ __forceinline__ float row_rstd(const f32x4 (&v)[4]) {
    float s = 0.f;
#pragma unroll
    for (int j = 0; j < 4; ++j) s += (v[j].x * v[j].x + v[j].y * v[j].y) + (v[j].z * v[j].z + v[j].w * v[j].w);
    return rsqrtf(wave_sum(s) * (1.0f / D_MODEL) + NORM_EPS);
}
__device__ __forceinline__ void st_row_bf16(bf16* p, int lane, const f32x4 (&h)[4]) {
#pragma unroll
    for (int j = 0; j < 4; ++j) { v2u o; o.x = pk2(h[j].x, h[j].y); o.y = pk2(h[j].z, h[j].w); *(GAS v2u*)(p + 4 * lane + 256 * j) = o; } }

template <bool COMBINE>
__device__ __forceinline__ void pool_prep_phase(int gw, int NGW, int wave, int lane, LAS unsigned char* lds, const float* Xprev, float* Xcur, bf16* P, const float* gain, const float* modp, const float* ada_b, int layer,
                                                const bf16* Y, const int* slot_of, const float* gatev) {
    LAS v2u* ring = (LAS v2u*)(lds + RING_OFF + wave * 16384) + lane;
    for (int it = gw; it < M_TOK / 16; it += NGW) {
        const int t0 = 16 * it, b = t0 / SEQ; const bool first = (t0 % SEQ) == 0;
        f32x4 A[4], G2[4];
#pragma unroll
        for (int j = 0; j < 4; ++j) { const int col = 4 * lane + 256 * j; A[j] = *(const f32x4*)(gain + col) * (mod4(modp, ada_b, layer, b, 1, col) + 1.0f); if (COMBINE) G2[j] = mod4(modp, ada_b, layer - 1, b, 5, col); }
        v2i sl = {0, 0}; f32x2 gt = {0.f, 0.f};
        if (COMBINE) { const int rr = first ? t0 + (lane & 15) : t0 - 16 + (lane & 31); sl = *(const GAS v2i*)(slot_of + 2 * rr); gt = *(const GAS f32x2*)(gatev + 2 * rr); }
#pragma unroll
        for (int q = 0; q < 30; ++q) ring[q * 64] = (v2u){0u, 0u};
        f32x4 s[4];
#pragma unroll
        for (int q = 0; q < 4; ++q) s[q] = (f32x4){0.f, 0.f, 0.f, 0.f};
        const int q0 = first ? 16 : 0; const int rbase = t0 - 16;
        f32x4 xv[4]; v2u ya[4], yb[4];
        { ld_row(Xprev + (size_t)(rbase + q0) * D_MODEL, lane, xv);
          if (COMBINE) { ld_yrow(Y + (size_t)rdlane_i(sl.x, 0) * D_MODEL, lane, ya); ld_yrow(Y + (size_t)rdlane_i(sl.y, 0) * D_MODEL, lane, yb); } }
#pragma nounroll
        for (int q = q0; q < 32; ++q) {
            const int row = rbase + q, li = q - q0, i = q & 15;
            f32x4 v[4];
#pragma unroll
            for (int j = 0; j < 4; ++j) v[j] = xv[j];
            if (COMBINE) { const float g0 = rdlane_f(gt.x, li), g1 = rdlane_f(gt.y, li);
#pragma unroll
                for (int j = 0; j < 4; ++j) v[j] += G2[j] * (y4(ya[j]) * g0 + y4(yb[j]) * g1); }
            if (q < 31) { ld_row(Xprev + (size_t)(row + 1) * D_MODEL, lane, xv);
                if (COMBINE) { ld_yrow(Y + (size_t)rdlane_i(sl.x, li + 1) * D_MODEL, lane, ya); ld_yrow(Y + (size_t)rdlane_i(sl.y, li + 1) * D_MODEL, lane, yb); } }
            if (COMBINE && q >= 16) {
#pragma unroll
                for (int j = 0; j < 4; ++j) *(GAS f32x4*)(Xcur + (size_t)row * D_MODEL + 4 * lane + 256 * j) = v[j]; }
            const float rstd = row_rstd(v);
#pragma unroll
            for (int j = 0; j < 4; ++j) { v[j] *= rstd;
                constexpr int W_[4] = {2, 4, 8, 16}, B_[4] = {0, 2, 6, 14};
                const int slot = B_[j] + (i & (W_[j] - 1));
                v2u nw; nw.x = pk2(v[j].x, v[j].y); nw.y = pk2(v[j].z, v[j].w);
                const v2u od = ring[slot * 64]; ring[slot * 64] = nw;
                s[j] += y4(nw) - y4(od); }
            if (q >= 16) {
                const int n1 = i + 1;
                const float i0 = first ? 1.0f / (float)(n1 < 2 ? n1 : 2) : 0.5f, i1 = first ? 1.0f / (float)(n1 < 4 ? n1 : 4) : 0.25f;
                const float i2 = first ? 1.0f / (float)(n1 < 8 ? n1 : 8) : 0.125f, i3 = first ? 1.0f / (float)n1 : 0.0625f;
                f32x4 h[4]; h[0] = (s[0] * i0 - v[0]) * A[0]; h[1] = (s[1] * i1 - v[1]) * A[1]; h[2] = (s[2] * i2 - v[2]) * A[2]; h[3] = (s[3] * i3 - v[3]) * A[3];
                st_row_bf16(P + (size_t)row * D_MODEL, lane, h);
            }
        }
        LDS_WAIT(); asm volatile("" ::: "memory");
    }
}

template <bool ROUTE>
__device__ __forceinline__ void norm_phase(int gw, int NGW, int lane, const float* X, bf16* H, const float* gain, const float* modp, const float* ada_b, int layer, int part_sh,
                                           const LAS float* wr_t  , const float* rb, int* eidx, float* gatev, unsigned* cnt) {
    int mycnt = 0;
    for (int it = gw; it < M_TOK / 16; it += NGW) {
        const int t0 = 16 * it, b = t0 / SEQ;
        f32x4 A[4], Bv[4];
#pragma unroll
        for (int j = 0; j < 4; ++j) { const int col = 4 * lane + 256 * j; A[j] = *(const f32x4*)(gain + col) * (mod4(modp, ada_b, layer, b, part_sh + 1, col) + 1.0f); Bv[j] = mod4(modp, ada_b, layer, b, part_sh, col); }
        f32x4 xv[4]; ld_row(X + (size_t)t0 * D_MODEL, lane, xv);
#pragma unroll 2
        for (int i = 0; i < 16; ++i) {
            const int row = t0 + i; f32x4 v[4];
#pragma unroll
            for (int j = 0; j < 4; ++j) v[j] = xv[j];
            if (i < 15) ld_row(X + (size_t)(row + 1) * D_MODEL, lane, xv);
            const float rstd = row_rstd(v);
#pragma unroll
            for (int j = 0; j < 4; ++j) v[j] = v[j] * rstd * A[j] + Bv[j];
            st_row_bf16(H + (size_t)row * D_MODEL, lane, v);
            if (ROUTE) {
                float lg[8];
#pragma unroll
                for (int e = 0; e < 8; ++e) { float p = 0.f;
#pragma unroll
                    for (int j = 0; j < 4; ++j) { const f32x4 w = *(const LAS f32x4*)(wr_t + e * D_MODEL + 4 * lane + 256 * j); p += (v[j].x * w.x + v[j].y * w.y) + (v[j].z * w.z + v[j].w * w.w); }
                    lg[e] = wave_sum(p) + rb[e]; }
                int e1 = 0; float v1 = lg[0];
#pragma unroll
                for (int e = 1; e < 8; ++e) if (lg[e] > v1) { v1 = lg[e]; e1 = e; }
                int e2 = -1; float v2 = -__builtin_inff();
#pragma unroll
                for (int e = 0; e < 8; ++e) if (e != e1 && lg[e] > v2) { v2 = lg[e]; e2 = e; }
                const float ex = __expf(v2 - v1), g1 = 1.0f / (1.0f + ex), g2 = ex * g1;
                if (lane == 0) { *(GAS v2i*)(eidx + 2 * row) = (v2i){e1, e2}; *(GAS f32x2*)(gatev + 2 * row) = (f32x2){g1, g2}; }
                mycnt += (lane == e1 || lane == e2) ? 1 : 0;
            }
        }
    }
    if (ROUTE) { if (lane < 8 && mycnt > 0) atomicAdd(cnt + lane * 64, (unsigned)mycnt); }
}

__device__ __forceinline__ void slot_phase(int gw, int NGW, int lane, const int* eidx, const unsigned* cnt, unsigned* cur, int* stok, int* slot_of) {
    int base[8]; { int acc = 0;
#pragma unroll
        for (int e = 0; e < 8; ++e) { base[e] = acc * 256; acc += ((int)__hip_atomic_load(cnt + e * 64, __ATOMIC_RELAXED, __HIP_MEMORY_SCOPE_AGENT) + 255) >> 8; } }
    for (int it = gw; it < M_TOK / 32; it += NGW) {
        const int ent = 64 * it + lane;
        const int e = eidx[ent]; int slot = 0;
#pragma unroll
        for (int x = 0; x < 8; ++x) {
            const unsigned long long mask = __ballot(e == x);
            if (mask) { const int n = __popcll(mask), leader = __ffsll((long long)mask) - 1; unsigned st = 0;
                if (lane == leader) st = atomicAdd(cur + x * 64, (unsigned)n);
                st = (unsigned)rdlane_i((int)st, leader);
                if (e == x) slot = base[x] + (int)st + __popcll(mask & ((1ull << lane) - 1ull)); }
        }
        stok[slot] = ent >> 1; slot_of[ent] = slot;
    }
}

__device__ __forceinline__ void merge_phase(int gw, int NGW, int lane, const bf16* OG, const float* LSE, bf16* AO) {
    for (int it = gw; it < M_TOK / 16; it += NGW) {
#pragma unroll 2
        for (int i = 0; i < 16; ++i) {
            const int m = 16 * it + i, b = m / SEQ, p = m % SEQ;
#pragma unroll
            for (int seg = 0; seg < 2; ++seg) {
                const int col = 512 * seg + 8 * lane, h = col >> 7, e0 = col & 127;
                v4u o[3]; float ls[3];
#pragma unroll
                for (int g = 0; g < 3; ++g) { const int sh = 2 * g, Lg = SEQ >> sh, j = p >> sh, r = p & ((1 << sh) - 1); const size_t ci = (size_t)(((b << sh) | r) * NHEAD + h) * Lg + j;
                    o[g] = *(const GAS v4u*)(OG + (size_t)g * ((size_t)M_TOK * D_MODEL) + ci * HEAD_DIM + e0); ls[g] = LSE[(size_t)g * ((size_t)M_TOK * NHEAD) + ci]; }
                const float mx = fmaxf(ls[0], fmaxf(ls[1], ls[2])); float a0 = __expf(ls[0] - mx), a1 = __expf(ls[1] - mx), a2 = __expf(ls[2] - mx); const float inv = 1.0f / (a0 + a1 + a2); a0 *= inv; a1 *= inv; a2 *= inv;
                v4u w;
#pragma unroll
                for (int q = 0; q < 4; ++q) { const float lo = bflo(o[0][q]) * a0 + bflo(o[1][q]) * a1 + bflo(o[2][q]) * a2, hi = bfhi(o[0][q]) * a0 + bfhi(o[1][q]) * a1 + bfhi(o[2][q]) * a2; w[q] = pk2(lo, hi); }
                *(GAS v4u*)(AO + (size_t)m * D_MODEL + col) = w;
            }
        }
    }
}

__device__ __forceinline__ void final_phase(int gw, int NGW, int lane, const float* X, float* out, const float* modp, const float* ada_b, int layer, const bf16* Y, const int* slot_of, const float* gatev) {
    for (int it = gw; it < M_TOK / 16; it += NGW) {
        const int t0 = 16 * it, b = t0 / SEQ;
        f32x4 G2[4];
#pragma unroll
        for (int j = 0; j < 4; ++j) G2[j] = mod4(modp, ada_b, layer, b, 5, 4 * lane + 256 * j);
        const v2i sl = *(const GAS v2i*)(slot_of + 2 * (t0 + (lane & 15))); const f32x2 gt = *(const GAS f32x2*)(gatev + 2 * (t0 + (lane & 15)));
        f32x4 xv[4]; v2u ya[4], yb[4];
        ld_row(X + (size_t)t0 * D_MODEL, lane, xv); ld_yrow(Y + (size_t)rdlane_i(sl.x, 0) * D_MODEL, lane, ya); ld_yrow(Y + (size_t)rdlane_i(sl.y, 0) * D_MODEL, lane, yb);
#pragma unroll
        for (int i = 0; i < 16; ++i) {
            const int row = t0 + i; f32x4 v[4]; const float g0 = rdlane_f(gt.x, i), g1 = rdlane_f(gt.y, i);
#pragma unroll
            for (int j = 0; j < 4; ++j) v[j] = xv[j] + G2[j] * (y4(ya[j]) * g0 + y4(yb[j]) * g1);
            if (i < 15) { ld_row(X + (size_t)(row + 1) * D_MODEL, lane, xv); ld_yrow(Y + (size_t)rdlane_i(sl.x, i + 1) * D_MODEL, lane, ya); ld_yrow(Y + (size_t)rdlane_i(sl.y, i + 1) * D_MODEL, lane, yb); }
#pragma unroll
            for (int j = 0; j < 4; ++j) *(GAS f32x4*)(out + (size_t)row * D_MODEL + 4 * lane + 256 * j) = v[j];
        }
    }
}
typedef __hip_bfloat16 hbf;
constexpr size_t SUBT = (size_t)M_TOK * D_MODEL;
constexpr int ATT_ITEMS = 3 * (M_TOK * NHEAD / 256);
__device__ __forceinline__ swa::BlockRef<hbf, hbf> attn_ref(int L, const hbf* qkvc, hbf* og) {
    const int g = L >> 10, rem = L & 1023, sh = 2 * g, lq = 5 - sh, chain = rem >> lq, qb = rem & ((1 << lq) - 1), Lg = SEQ >> sh;
    const size_t co = (size_t)chain * Lg * HEAD_DIM, qo = (size_t)qb * 256 * HEAD_DIM;
    swa::BlockRef<hbf, hbf> r;
    r.Q = qkvc + (size_t)(g * 3 + 0) * SUBT + co + qo; r.K = qkvc + (size_t)(g * 3 + 1) * SUBT + co; r.V = qkvc + (size_t)(g * 3 + 2) * SUBT + co;
    r.O = og + (size_t)g * SUBT + co + qo; r.P0 = qb * 256;
    return r;
}

struct Args { const void* in[19]; float* out; unsigned char* ws; int ph_lo, ph_hi, grid, pad; };
typedef const unsigned char __attribute__((address_space(4)))* kptr_t;
__device__ __forceinline__ kptr_t kargs() { kptr_t p = (kptr_t)__builtin_amdgcn_kernarg_segment_ptr(); asm volatile("" : "+s"(p)); return p; }
#define KIN(T, k) ((const T*)*(const void* const __attribute__((address_space(4)))*)(kp + 8 * (k)))
#define KOUT() ((float*)*(void* const __attribute__((address_space(4)))*)(kp + 152))
#define KWS() ((unsigned char*)*(void* const __attribute__((address_space(4)))*)(kp + 160))
static_assert(sizeof(Args) == 184, "Args layout: in[19] at 0, out at 152, ws at 160, ph_lo 168, ph_hi 172, grid 176");
#define KINT(off) (*(const int __attribute__((address_space(4)))*)(kp + (off)))
__device__ __forceinline__ bool ph_in(int k) { const kptr_t kp = kargs(); return KINT(168) <= k && k < KINT(172); }
__global__ void __launch_bounds__(NWAVES * 64, 2) mk_fwd(Args args) {
    extern __shared__ __attribute__((aligned(16))) unsigned char lds_raw[];
    LAS unsigned char* lds = (LAS unsigned char*)lds_raw;
    for (int u = threadIdx.x; u < (LDS_BYTES - MISC_OFF) / 4; u += NWAVES * 64) ((LAS unsigned*)(lds + MISC_OFF))[u] = 0u;
    __syncthreads();
    if (args.ph_hi - args.ph_lo > 1) (void)xcd_barrier_post((unsigned*)(args.ws + WS_CTL) + CW_BAR, (volatile LAS unsigned*)(lds + MISC_OFF) + 8);
#ifndef DBG_MASK
#define DBG_MASK 0xFFFF
#endif
#define EN(t) (((DBG_MASK) >> (t)) & 1)
#define IN(k) ph_in(k)
#define SEAM(k) do { if (IN(k) && IN((k) + 1)) { const kptr_t kp = kargs(); XcdBarrier bar_; bar_.bar = (unsigned*)(KWS() + WS_CTL) + CW_BAR; bar_.x = xb_xcc_id(); bar_.st = (volatile LAS unsigned*)(lds + MISC_OFF) + 8; xcd_barrier(bar_); } } while (0)
#define PH_SETUP() const kptr_t kp = kargs(); unsigned char* ws = KWS(); int tid = threadIdx.x; asm volatile("" : "+v"(tid)); const int lane = tid & 63, wave = __builtin_amdgcn_readfirstlane(tid >> 6); \
    const int G = KINT(176), bx = blockIdx.x, vcu = (G % 8 == 0) ? (bx % 8) * (G / 8) + bx / 8 : bx, gw = vcu * NWAVES + wave, NGW = G * NWAVES; (void)tid; (void)lane; (void)vcu; (void)gw; (void)NGW; (void)ws
#define MODP() ((const float*)(ws + WS_MODP))
#define ADAB() KIN(float, 6)
#define XCUR() ((lp == 0) ? KOUT() : (float*)(ws + WS_XB))
#define CNT() ((unsigned*)(ws + WS_CTL) + CW_CNT + lp * 8 * 64)

    if (EN(0) && IN(0)) { PH_SETUP(); ProIn I; I.c = KIN(float, 1); I.ada_w = KIN(float, 5); I.pool_w = KIN(float, 7); I.wqkv = KIN(float, 9); I.wo = KIN(float, 10);
        I.wgu = KIN(float, 13); I.wdn = KIN(float, 14); I.mgu = KIN(float, 17); I.mdn = KIN(float, 18); I.pos = KIN(int, 2);
        p0_prologue(I, ws, lds, gw, NGW, wave, lane); }
    SEAM(0);
    for (int lp = 0; lp < 2; ++lp) {
        const int pb = 1 + PH_PER_PAIR * lp;
        if (EN(1) && IN(pb + 0)) { PH_SETUP(); bf16* H = (bf16*)(ws + WS_H);
            if (lp == 0) pool_prep_phase<false>(gw, NGW, wave, lane, lds, KIN(float, 0), nullptr, H, KIN(float, 3), MODP(), ADAB(), 0, nullptr, nullptr, nullptr);
            else pool_prep_phase<true>(gw, NGW, wave, lane, lds, KOUT(), (float*)(ws + WS_XB), H, KIN(float, 3) + 2 * D_MODEL, MODP(), ADAB(), 2, (const bf16*)(ws + WS_Y), (const int*)(ws + WS_SLOTOF), (const float*)(ws + WS_GATE)); }
        SEAM(pb + 0);
        if (EN(2) && IN(pb + 1)) { PH_SETUP();
            pg8::SchedPlain S; S.init(ws + WS_H, (const bf16*)(ws + WS_WPOOL) + (size_t)lp * D_MODEL * 256, M_TOK, D_MODEL, 256, D_MODEL, 512, G, bx);
            pg8::EpiResid E{lp == 0 ? KIN(float, 0) : (const float*)(ws + WS_XB), XCUR(), MODP(), ADAB(), KIN(float, 8) + lp * D_MODEL, 2 * lp, 2};
            pg8::gemm_phase<pg8::EpiResid, pg8::SchedPlain, true>(lds + RING_OFF, 256, S, E); }
        SEAM(pb + 1);
        if (EN(3) && IN(pb + 2)) { PH_SETUP();
            norm_phase<false>(gw, NGW, lane, XCUR(), (bf16*)(ws + WS_H), KIN(float, 4) + 2 * lp * D_MODEL, MODP(), ADAB(), 2 * lp, 3, nullptr, nullptr, nullptr, nullptr, nullptr); }
        SEAM(pb + 2);
        if (EN(4) && IN(pb + 3)) { PH_SETUP();
            pg8::SchedPlain S; S.init(ws + WS_H, (const bf16*)(ws + WS_WGU) + (size_t)lp * 2 * D_FF * D_MODEL, M_TOK, 2 * D_FF, D_MODEL, D_MODEL, 0, G, bx);
            pg8::EpiSwiglu E{(bf16*)(ws + WS_ACT), D_FF};
            pg8::gemm_phase<pg8::EpiSwiglu, pg8::SchedPlain, true>(lds + RING_OFF, D_MODEL, S, E); }
        SEAM(pb + 3);
        if (EN(5) && IN(pb + 4)) { PH_SETUP();
            pg8::SchedPlain S; S.init(ws + WS_ACT, (const bf16*)(ws + WS_WDN) + (size_t)lp * D_MODEL * D_FF, M_TOK, D_MODEL, D_FF, D_FF, 0, G, bx);
            float* Xc = XCUR(); pg8::EpiResid E{Xc, Xc, MODP(), ADAB(), nullptr, 2 * lp, 5};
            pg8::gemm_phase<pg8::EpiResid, pg8::SchedPlain, true>(lds + RING_OFF, D_FF, S, E); }
        SEAM(pb + 4);
        if (EN(6) && IN(pb + 5)) { PH_SETUP();
            norm_phase<false>(gw, NGW, lane, XCUR(), (bf16*)(ws + WS_H), KIN(float, 3) + (2 * lp + 1) * D_MODEL, MODP(), ADAB(), 2 * lp + 1, 0, nullptr, nullptr, nullptr, nullptr, nullptr); }
        SEAM(pb + 5);
        if (EN(7) && IN(pb + 6)) { PH_SETUP();
            pg8::SchedPlain S; S.init(ws + WS_H, (const bf16*)(ws + WS_WQKV) + (size_t)lp * QKV_W * D_MODEL, M_TOK, QKV_W, D_MODEL, D_MODEL, 0, G, bx);
            pg8::EpiQKV E{(bf16*)(ws + WS_QKVC), KIN(float, 11) + lp * 3 * HEAD_DIM, KIN(float, 12) + lp * 3 * HEAD_DIM, (const float*)(ws + WS_COS), (const float*)(ws + WS_SIN), (LAS float*)(lds + TAB_OFF)};
            pg8::gemm_phase<pg8::EpiQKV, pg8::SchedPlain, true>(lds + RING_OFF, D_MODEL, S, E); }
        SEAM(pb + 6);
        if (EN(8) && IN(pb + 7)) { PH_SETUP();
            const hbf* qkvc = (const hbf*)(ws + WS_QKVC); hbf* og = (hbf*)(ws + WS_OG); float* lse = (float*)(ws + WS_LSE);
            int L = vcu;
            if (L < ATT_ITEMS) {
                swa::BlockRef<hbf, hbf> cb = attn_ref(L, qkvc, og); swa::Seam<hbf> S;
                swa::causal_swa_prime<hbf, hbf>(cb, 129, (char*)lds_raw, S);
                for (;;) {
                    const bool more = L + G < ATT_ITEMS;
                    const swa::BlockRef<hbf, hbf> nb = more ? attn_ref(L + G, qkvc, og) : cb;
                    swa::causal_swa_block<hbf, hbf>(cb, nb, SEQ >> (2 * (L >> 10)), 129, (char*)lds_raw, S, (const char*)og, (char*)lse);
                    if (!more) break;
                    cb = nb; L += G;
                }
            }
        }
        SEAM(pb + 7);
        if (EN(9) && IN(pb + 8)) { PH_SETUP(); merge_phase(gw, NGW, lane, (const bf16*)(ws + WS_OG), (const float*)(ws + WS_LSE), (bf16*)(ws + WS_H)); }
        SEAM(pb + 8);
        if (EN(10) && IN(pb + 9)) { PH_SETUP();
            pg8::SchedPlain S; S.init(ws + WS_H, (const bf16*)(ws + WS_WO) + (size_t)lp * D_MODEL * D_MODEL, M_TOK, D_MODEL, D_MODEL, D_MODEL, 0, G, bx);
            float* Xc = XCUR(); pg8::EpiResid E{Xc, Xc, MODP(), ADAB(), nullptr, 2 * lp + 1, 2};
            pg8::gemm_phase<pg8::EpiResid, pg8::SchedPlain, true>(lds + RING_OFF, D_MODEL, S, E); }
        SEAM(pb + 9);
        if (EN(11) && IN(pb + 10)) { PH_SETUP();
            LAS float* wr_t = (LAS float*)(lds + RING_OFF); const float* router_w = KIN(float, 15); int* stok = (int*)(ws + WS_STOK);
            for (int idx = tid; idx < D_MODEL * N_EXP; idx += NWAVES * 64) wr_t[(idx & 7) * D_MODEL + (idx >> 3)] = router_w[(size_t)lp * D_MODEL * N_EXP + idx];
            for (int i = gw * 64 + lane; i < MAX_SLOTS; i += NGW * 64) stok[i] = 0;
            __syncthreads();
            norm_phase<true>(gw, NGW, lane, XCUR(), (bf16*)(ws + WS_H), KIN(float, 4) + (2 * lp + 1) * D_MODEL, MODP(), ADAB(), 2 * lp + 1, 3, wr_t, KIN(float, 16) + lp * N_EXP, (int*)(ws + WS_EIDX), (float*)(ws + WS_GATE), CNT());
        }
        SEAM(pb + 10);
        if (EN(12) && IN(pb + 11)) { PH_SETUP();
            slot_phase(gw, NGW, lane, (const int*)(ws + WS_EIDX), CNT(), (unsigned*)(ws + WS_CTL) + CW_CUR + lp * 8 * 64, (int*)(ws + WS_STOK), (int*)(ws + WS_SLOTOF)); }
        SEAM(pb + 11);
        if (EN(13) && IN(pb + 12)) { PH_SETUP(); const unsigned* cnt = CNT();
            pg8::SchedMoE<true> S; { int acc = 0;
#pragma unroll
                for (int e = 0; e < 8; ++e) { S.tb[e] = acc; acc += ((int)__hip_atomic_load(cnt + e * 64, __ATOMIC_RELAXED, __HIP_MEMORY_SCOPE_AGENT) + 255) >> 8; } S.tb[8] = acc; }
            S.init_order(S.tb[8], 2 * D_FFE / 256, G, bx); S.A = (const char*)(ws + WS_H); S.B = (const char*)((const bf16*)(ws + WS_WMGU) + (size_t)lp * N_EXP * 2 * D_FFE * D_MODEL); S.lda = D_MODEL;
            S.b_exp = (size_t)2 * D_FFE * D_MODEL * 2; S.b_tile = (size_t)256 * D_MODEL * 2; S.tok = (const int*)(ws + WS_STOK);
            pg8::EpiSwiglu E{(bf16*)(ws + WS_ACT), D_FFE};
            pg8::gemm_phase<pg8::EpiSwiglu, pg8::SchedMoE<true>, true>(lds + RING_OFF, D_MODEL, S, E); }
        SEAM(pb + 12);
        if (EN(14) && IN(pb + 13)) { PH_SETUP(); const unsigned* cnt = CNT();
            pg8::SchedMoE<false> S; { int acc = 0;
#pragma unroll
                for (int e = 0; e < 8; ++e) { S.tb[e] = acc; acc += ((int)__hip_atomic_load(cnt + e * 64, __ATOMIC_RELAXED, __HIP_MEMORY_SCOPE_AGENT) + 255) >> 8; } S.tb[8] = acc; }
            S.init_order(S.tb[8], D_MODEL / 256, G, bx); S.A = (const char*)(ws + WS_ACT); S.B = (const char*)((const bf16*)(ws + WS_WMDN) + (size_t)lp * N_EXP * D_MODEL * D_FFE); S.lda = D_FFE;
            S.b_exp = (size_t)D_MODEL * D_FFE * 2; S.b_tile = (size_t)256 * D_FFE * 2; S.tok = nullptr;
            pg8::EpiBf16 E{(bf16*)(ws + WS_Y), D_MODEL};
            pg8::gemm_phase<pg8::EpiBf16, pg8::SchedMoE<false>, true>(lds + RING_OFF, D_FFE, S, E); }
        SEAM(pb + 13);
    }
    if (EN(15) && IN(NPHASES - 1)) { PH_SETUP();
        final_phase(gw, NGW, lane, (const float*)(ws + WS_XB), KOUT(), MODP(), ADAB(), DEPTH - 1, (const bf16*)(ws + WS_Y), (const int*)(ws + WS_SLOTOF), (const float*)(ws + WS_GATE)); }
#undef IN
#undef SEAM
#undef EN
#undef MODP
#undef ADAB
#undef XCUR
#undef CNT
#undef PH_SETUP
}

extern "C" void kernel_launch(void* const* d_in, const int* in_sizes, int n_in, void* d_out, int out_size, void* d_ws, size_t ws_size, hipStream_t stream) {
    static int grid = 0;
    if (grid == 0) {
        if (n_in != 19 || in_sizes[0] != M_TOK * D_MODEL || out_size != M_TOK * D_MODEL || ws_size < WS_END) { fprintf(stderr, "kernel_launch: unexpected shapes (n_in %d, in0 %d, out %d, ws %zu < %zu); nothing launched\n", n_in, n_in > 0 ? in_sizes[0] : -1, out_size, ws_size, (size_t)WS_END); grid = -1; return; }
        int dev = 0, cus = 0, per_cu = 0;
        if (hipGetDevice(&dev) != hipSuccess || hipDeviceGetAttribute(&cus, hipDeviceAttributeMultiprocessorCount, dev) != hipSuccess) { fprintf(stderr, "kernel_launch: device query failed\n"); grid = -1; return; }
        if (hipFuncSetAttribute((const void*)mk_fwd, hipFuncAttributeMaxDynamicSharedMemorySize, LDS_BYTES) != hipSuccess) { fprintf(stderr, "kernel_launch: hipFuncSetAttribute failed\n"); grid = -1; return; }
        if (hipOccupancyMaxActiveBlocksPerMultiprocessor(&per_cu, (const void*)mk_fwd, NWAVES * 64, LDS_BYTES) != hipSuccess || per_cu < 1) fprintf(stderr, "kernel_launch: note: occupancy query reports %d workgroups per CU\n", per_cu);
        (void)hipGetLastError();
        grid = cus;
    }
    if (grid < 0) return;
    if (hipMemsetAsync((char*)d_ws + WS_CTL, 0, CTL_ZERO_BYTES, stream) != hipSuccess) { fprintf(stderr, "kernel_launch: hipMemsetAsync failed\n"); return; }
    Args a{};
    for (int i = 0; i < 19; ++i) a.in[i] = d_in[i];
    a.out = (float*)d_out; a.ws = (unsigned char*)d_ws; a.grid = grid; a.pad = 0;
#if MK_PER_PHASE
    for (int k = 0; k < NPHASES; ++k) { a.ph_lo = k; a.ph_hi = k + 1; hipLaunchKernelGGL(mk_fwd, dim3(grid), dim3(NWAVES * 64), LDS_BYTES, stream, a); }
#else
    a.ph_lo = 0; a.ph_hi = NPHASES; hipLaunchKernelGGL(mk_fwd, dim3(grid), dim3(NWAVES * 64), LDS_BYTES, stream, a);
#endif
    const hipError_t le = hipPeekAtLastError();
    if (le != hipSuccess) fprintf(stderr, "kernel_launch: launch failed: %s\n", hipGetErrorName(le));
}
```

```cpp
#include <hip/hip_runtime.h>
#include <hip/hip_bf16.h>
#include <cstdio>
#include <cstdint>

constexpr int D_MODEL = 1024, BATCH = 4, SEQ = 8192, DEPTH = 4, M_TOK = BATCH * SEQ;
constexpr int QKV_W = 9216, D_FF = 2816, N_EXP = 8, D_FFE = 3584, HEAD_DIM = 128, NHEAD = 8;
constexpr float NORM_EPS = 1e-6f;

namespace pg8 {
#define PG8_LAS __attribute__((address_space(3)))
typedef unsigned short bf16_t;
typedef short bf16x8 __attribute__((ext_vector_type(8)));
typedef float f32x4 __attribute__((ext_vector_type(4)));
typedef float f32x2 __attribute__((ext_vector_type(2)));
typedef unsigned u32x4 __attribute__((ext_vector_type(4)));
typedef unsigned u32x2 __attribute__((ext_vector_type(2)));
constexpr int BM = 256, BK = 64, HALF = 128, HTB = HALF * BK * 2  , STAGE_BYTES = 8 * HTB, NXCD = 8, WGM = 8;

__host__ __device__ __forceinline__ int lds_byte(int r, int c) { const int st = (r >> 4) * 2 + (c >> 5), rr = r & 15, cc = c & 31, ob = rr * 64 + cc * 2; return st * 1024 + (ob ^ (((ob >> 9) & 1) << 5)); }
__host__ __device__ __forceinline__ void stage_rc(int b, int& R, int& C) { const int st = b / 1024, sb = b % 1024, swz = sb ^ (((sb >> 9) & 1) << 5); R = (st >> 1) * 16 + swz / 64; C = (st & 1) * 32 + (swz % 64) / 2; }
__host__ __device__ __forceinline__ int perm32(int rho) { const int n = rho >> 4, i = rho & 15; return 8 * (i >> 2) + 4 * n + (i & 3); }
__device__ __forceinline__ unsigned cvt_pk_bf16(float lo, float hi) { unsigned r; asm volatile("v_cvt_pk_bf16_f32 %0, %1, %2" : "=v"(r) : "v"(lo), "v"(hi)); return r; }

struct Unit { int pm, pn; };

struct OrderBase {
    int nM, nN, nwg, G, c;
    __device__ __forceinline__ void init_order(int nM_, int nN_, int G_, int c_) { nM = nM_; nN = nN_; nwg = nM * nN; G = G_; c = c_; }
    __device__ __forceinline__ bool next(int i, Unit& u) const {
        const long L = (long)i * G + c; if (L >= nwg) return false;
        int wgid = (int)L; { const int q = nwg / NXCD, r = nwg % NXCD, xcd = wgid % NXCD, off = wgid / NXCD; wgid = (xcd < r ? xcd * (q + 1) : r * (q + 1) + (xcd - r) * q) + off; }
        const int nig = WGM * nN, gid = wgid / nig, fm = gid * WGM, gsz = (nM - fm) < WGM ? (nM - fm) : WGM;
        u.pm = fm + ((wgid % nig) % gsz); u.pn = (wgid % nig) / gsz; return true;
    }
};
struct SchedPlain : OrderBase {
    const char* A; const char* B; int lda; int a_pn_step; size_t a_tile, b_tile;
    __device__ __forceinline__ void init(const void* A_, const void* B_, int M, int N, int K, int lda_, int a_pn_step_, int G_, int c_) {
        init_order(M / BM, N / BM, G_, c_); A = (const char*)A_; B = (const char*)B_; lda = lda_; a_pn_step = a_pn_step_; a_tile = (size_t)BM * lda_ * 2; b_tile = (size_t)BM * K * 2; }
    __device__ __forceinline__ const char* a_base(const Unit& u) const { return A + (size_t)u.pm * a_tile + (size_t)u.pn * a_pn_step; }
    __device__ __forceinline__ const char* b_base(const Unit& u) const { return B + (size_t)u.pn * b_tile; }
    __device__ __forceinline__ void a_offs(const Unit&, const int (&R)[2], const int (&C)[2], unsigned (&v)[2][2]) const {
#pragma unroll
        for (int h = 0; h < 2; ++h)
#pragma unroll
            for (int i = 0; i < 2; ++i) v[h][i] = (unsigned)((h * HALF + R[i]) * lda + C[i]) * 2u; }
};
template <bool GATHER> struct SchedMoE : OrderBase {
    int tb[9]; const char* A; const char* B; int lda; size_t b_exp, b_tile; const int* tok;
    __device__ __forceinline__ int expert(int pm) const { int e = 0;
#pragma unroll
        for (int j = 1; j < 8; ++j) e += (pm >= tb[j]) ? 1 : 0; return e; }
    __device__ __forceinline__ const char* a_base(const Unit& u) const { return GATHER ? A : A + (size_t)u.pm * BM * lda * 2; }
    __device__ __forceinline__ const char* b_base(const Unit& u) const { return B + (size_t)expert(u.pm) * b_exp + (size_t)u.pn * b_tile; }
    __device__ __forceinline__ void a_offs(const Unit& u, const int (&R)[2], const int (&C)[2], unsigned (&v)[2][2]) const {
#pragma unroll
        for (int h = 0; h < 2; ++h)
#pragma unroll
            for (int i = 0; i < 2; ++i) { const int row = GATHER ? tok[u.pm * BM + h * HALF + R[i]] : (h * HALF + R[i]); v[h][i] = (unsigned)(row * lda + C[i]) * 2u; } }
};

template <class Epi, class Sched, bool ALIGN_EPI>
__device__ __forceinline__ void gemm_phase(PG8_LAS unsigned char* lds, const int K, const Sched& S, const Epi& E) {
    int tid = threadIdx.x; asm volatile("" : "+v"(tid));
    const int wid = __builtin_amdgcn_readfirstlane(tid >> 6), lane = tid & 63, wr = wid >> 2, wc = wid & 3, fr = lane & 15, fq = lane >> 4;
    const int nt = K / BK;
    int RA[2], CA[2]; unsigned voffB[2];
#pragma unroll
    for (int i = 0; i < 2; ++i) { int R, C; stage_rc(tid * 16 + i * 8192, R, C); const int Rb = Epi::PERM ? ((R & ~31) + perm32(R & 31)) : R; RA[i] = R; CA[i] = C; voffB[i] = (unsigned)(Rb * K + C) * 2u; }
    const size_t kstep = (size_t)(BK * 2);
    const size_t hstep = (size_t)HALF * K * 2;
    const unsigned ldsw = (unsigned)wid * 1024u;
    const int aoff = lds_byte(wr * 64 + fr, fq * 8), boff = lds_byte(wc * 32 + fr, fq * 8);
#define PG8_SA(b, h) (((b) * 2 + (h)) * HTB)
#define PG8_SB(b, h) ((4 + (b) * 2 + (h)) * HTB)
#define PG8_STAGE2(bufoff, gbase, v0, v1) do { \
        __builtin_amdgcn_global_load_lds((const unsigned*)((const char*)(gbase) + (v0)), (PG8_LAS unsigned*)(lds + (bufoff) + ldsw), 16, 0, 0); \
        __builtin_amdgcn_global_load_lds((const unsigned*)((const char*)(gbase) + (v1)), (PG8_LAS unsigned*)(lds + (bufoff) + ldsw + 8192), 16, 0, 0); } while (0)
#define PG8_STAGEB(bufoff, gbase) PG8_STAGE2(bufoff, gbase, voffB[0], voffB[1])
#define PG8_LDA(dst, b, h) do { _Pragma("unroll") for (int m = 0; m < 4; ++m) _Pragma("unroll") for (int k = 0; k < 2; ++k) dst[m][k] = *(const PG8_LAS bf16x8*)(lds + PG8_SA(b, h) + aoff + m * 2048 + k * 1024); } while (0)
#define PG8_LDB(dst, b, h) do { _Pragma("unroll") for (int n = 0; n < 2; ++n) _Pragma("unroll") for (int k = 0; k < 2; ++k) dst[n][k] = *(const PG8_LAS bf16x8*)(lds + PG8_SB(b, h) + boff + n * 2048 + k * 1024); } while (0)
#define PG8_MMA(ai, bj, At, Bt) do { __builtin_amdgcn_s_setprio(1); _Pragma("unroll") for (int m = 0; m < 4; ++m) _Pragma("unroll") for (int n = 0; n < 2; ++n) _Pragma("unroll") for (int k = 0; k < 2; ++k) \
        acc[ai][bj][m][n] = __builtin_amdgcn_mfma_f32_16x16x32_bf16(Bt[n][k], At[m][k], acc[ai][bj][m][n], 0, 0, 0); __builtin_amdgcn_s_setprio(0); } while (0)
#define PG8_WAIT_V(n) asm volatile("s_waitcnt vmcnt(" #n ")" ::: "memory")
#define PG8_WAIT_L(n) asm volatile("s_waitcnt lgkmcnt(" #n ")" ::: "memory")
#define PG8_BAR __builtin_amdgcn_s_barrier()
#define PG8_SCHED __builtin_amdgcn_sched_barrier(0)
    Unit cur, nxt; int ui = 0;
    if (!S.next(0, cur)) return;
    f32x4 acc[2][2][4][2];
#pragma unroll
    for (int a = 0; a < 2; ++a)
#pragma unroll
        for (int b = 0; b < 2; ++b)
#pragma unroll
            for (int m = 0; m < 4; ++m)
#pragma unroll
                for (int n = 0; n < 2; ++n) acc[a][b][m][n] = (f32x4){0.f, 0.f, 0.f, 0.f};
    bf16x8 At[4][2], B0[2][2], B1[2][2];
    unsigned vA[2][2], vN[2][2];
    const char* cA = S.a_base(cur); const char* cB = S.b_base(cur);
    S.a_offs(cur, RA, CA, vA);
#pragma unroll
    for (int h = 0; h < 2; ++h)
#pragma unroll
        for (int i = 0; i < 2; ++i) vN[h][i] = vA[h][i];
    PG8_STAGEB(PG8_SB(0, 0), cB); PG8_STAGEB(PG8_SB(0, 1), cB + hstep); PG8_STAGE2(PG8_SA(0, 0), cA, vA[0][0], vA[0][1]); PG8_STAGE2(PG8_SA(0, 1), cA, vA[1][0], vA[1][1]);
    if (wr == 1) PG8_BAR;
    PG8_WAIT_V(2); PG8_BAR;
    PG8_STAGEB(PG8_SB(1, 0), cB + kstep); PG8_STAGE2(PG8_SA(1, 0), cA + kstep, vA[0][0], vA[0][1]); PG8_STAGEB(PG8_SB(1, 1), cB + hstep + kstep);
    PG8_WAIT_V(6); PG8_BAR;
    for (;;) {
        const bool has_next = S.next(ui + 1, nxt);
        const char* nA = has_next ? S.a_base(nxt) : cA; const char* nB = has_next ? S.b_base(nxt) : cB;
#pragma nounroll
        for (int t = 0; t < nt; t += 2) {
            const bool last = (t == nt - 2);
            const char* a1 = cA + (size_t)(t + 1) * kstep;
            if (last && has_next) S.a_offs(nxt, RA, CA, vN);
            const char* a2 = last ? nA : cA + (size_t)(t + 2) * kstep; const char* b2 = last ? nB : cB + (size_t)(t + 2) * kstep;
            const char* a3 = a2 + kstep; const char* b3 = b2 + kstep;
            const unsigned u00 = last ? vN[0][0] : vA[0][0], u01 = last ? vN[0][1] : vA[0][1], u10 = last ? vN[1][0] : vA[1][0], u11 = last ? vN[1][1] : vA[1][1];
            PG8_LDB(B0, 0, 0); PG8_LDB(B1, 0, 1); PG8_SCHED; PG8_LDA(At, 0, 0); PG8_STAGE2(PG8_SA(1, 1), a1, vA[1][0], vA[1][1]);
            PG8_WAIT_V(8); PG8_WAIT_L(0); PG8_BAR; PG8_MMA(0, 0, At, B0); PG8_MMA(0, 1, At, B1); PG8_BAR; PG8_SCHED;
            PG8_LDA(At, 0, 1); PG8_STAGEB(PG8_SB(0, 0), b2); PG8_STAGEB(PG8_SB(0, 1), b2 + hstep); PG8_STAGE2(PG8_SA(0, 0), a2, u00, u01);
            PG8_WAIT_V(8); PG8_WAIT_L(0); PG8_BAR; PG8_MMA(1, 0, At, B0); PG8_MMA(1, 1, At, B1); PG8_BAR; PG8_SCHED;
            PG8_LDB(B0, 1, 0); PG8_LDB(B1, 1, 1); PG8_SCHED; PG8_LDA(At, 1, 0); PG8_STAGE2(PG8_SA(0, 1), a2, u10, u11);
            PG8_WAIT_V(8); PG8_WAIT_L(0); PG8_BAR; PG8_MMA(0, 0, At, B0); PG8_MMA(0, 1, At, B1); PG8_BAR; PG8_SCHED;
            PG8_LDA(At, 1, 1); PG8_STAGEB(PG8_SB(1, 0), b3); PG8_STAGEB(PG8_SB(1, 1), b3 + hstep); PG8_STAGE2(PG8_SA(1, 0), a3, u00, u01);
            PG8_WAIT_V(8); PG8_WAIT_L(0); PG8_BAR; PG8_MMA(1, 0, At, B0); PG8_MMA(1, 1, At, B1); PG8_BAR; PG8_SCHED;
        }
        if constexpr (ALIGN_EPI) { if (wr == 0) PG8_BAR; }
        E(acc, cur, wr, wc, fr, fq);
        if (!has_next) break;
#pragma unroll
        for (int a = 0; a < 2; ++a)
#pragma unroll
            for (int b = 0; b < 2; ++b)
#pragma unroll
                for (int m = 0; m < 4; ++m)
#pragma unroll
                    for (int n = 0; n < 2; ++n) acc[a][b][m][n] = (f32x4){0.f, 0.f, 0.f, 0.f};
        cur = nxt; cA = nA; cB = nB; ++ui;
#pragma unroll
        for (int h = 0; h < 2; ++h)
#pragma unroll
            for (int i = 0; i < 2; ++i) vA[h][i] = vN[h][i];
        if constexpr (ALIGN_EPI) { if (wr == 1) PG8_BAR; }
    }
    PG8_WAIT_V(0);
    if constexpr (!ALIGN_EPI) { if (wr == 0) PG8_BAR; }
    PG8_BAR;
#undef PG8_SA
#undef PG8_SB
#undef PG8_STAGE2
#undef PG8_STAGEB
#undef PG8_LDA
#undef PG8_LDB
#undef PG8_MMA
#undef PG8_WAIT_V
#undef PG8_WAIT_L
#undef PG8_BAR
#undef PG8_SCHED
}
}
namespace pg8 {
constexpr int MOD_SZ = DEPTH * BATCH * 6 * D_MODEL;
__device__ __forceinline__ f32x4 mod4(const float* modp, const float* ada_b, int layer, int b, int part, int col) {
    const int o = part * D_MODEL + col; const float* p = modp + (size_t)(layer * BATCH + b) * (6 * D_MODEL) + o;
    f32x4 v = *(const f32x4*)(ada_b + layer * (6 * D_MODEL) + o);
#pragma unroll
    for (int ks = 0; ks < 4; ++ks) v += *(const f32x4*)(p + (size_t)ks * MOD_SZ);
    return v;
}
struct EpiResid {
    static constexpr bool PERM = false;
    const float* xin; float* xout; const float* modp; const float* ada_b; const float* colscale; int layer, part;
    __device__ __forceinline__ void operator()(const f32x4 (&acc)[2][2][4][2], const Unit& u, int wr, int wc, int fr, int fq) const {
        const int row0 = u.pm * BM + wr * 64 + fr, col0 = u.pn * BM + wc * 32 + 4 * fq, b = (u.pm * BM) / SEQ;
        f32x4 gs[2][2];
#pragma unroll
        for (int bj = 0; bj < 2; ++bj)
#pragma unroll
            for (int n = 0; n < 2; ++n) { const int c = col0 + bj * HALF + n * 16; gs[bj][n] = mod4(modp, ada_b, layer, b, part, c); if (colscale) gs[bj][n] *= *(const f32x4*)(colscale + c); }
#pragma unroll
        for (int ai = 0; ai < 2; ++ai)
#pragma unroll
            for (int m = 0; m < 4; ++m) { const size_t off = (size_t)(row0 + ai * HALF + m * 16) * D_MODEL + col0;
#pragma unroll
                for (int bj = 0; bj < 2; ++bj)
#pragma unroll
                    for (int n = 0; n < 2; ++n) { const f32x4 xv = *(const f32x4*)(xin + off + bj * HALF + n * 16); *(f32x4*)(xout + off + bj * HALF + n * 16) = xv + gs[bj][n] * acc[ai][bj][m][n]; }
                asm volatile("" ::: "memory"); }
    }
};
struct EpiSwiglu {
    static constexpr bool PERM = true;
    bf16_t* O; int ldo;
    __device__ __forceinline__ void operator()(const f32x4 (&acc)[2][2][4][2], const Unit& u, int wr, int wc, int fr, int fq) const {
        const int row0 = u.pm * BM + wr * 64 + fr, col0 = u.pn * HALF + wc * 32 + 8 * fq;
#pragma unroll
        for (int ai = 0; ai < 2; ++ai)
#pragma unroll
            for (int m = 0; m < 4; ++m) { bf16_t* rowp = O + (size_t)(row0 + ai * HALF + m * 16) * ldo + col0; float v[8];
#pragma unroll
                for (int n = 0; n < 2; ++n)
#pragma unroll
                    for (int j = 0; j < 4; ++j) { const float g = acc[ai][0][m][n][j], uu = acc[ai][1][m][n][j]; v[n * 4 + j] = g * uu * __builtin_amdgcn_rcpf(1.0f + __expf(-g)); }
                u32x4 w; w.x = cvt_pk_bf16(v[0], v[1]); w.y = cvt_pk_bf16(v[2], v[3]); w.z = cvt_pk_bf16(v[4], v[5]); w.w = cvt_pk_bf16(v[6], v[7]);
                *(u32x4*)rowp = w; }
    }
};
struct EpiBf16 {
    static constexpr bool PERM = true;
    bf16_t* O; int ldo;
    __device__ __forceinline__ void operator()(const f32x4 (&acc)[2][2][4][2], const Unit& u, int wr, int wc, int fr, int fq) const {
        const int row0 = u.pm * BM + wr * 64 + fr, col0 = u.pn * BM + wc * 32 + 8 * fq;
#pragma unroll
        for (int ai = 0; ai < 2; ++ai)
#pragma unroll
            for (int m = 0; m < 4; ++m) { bf16_t* rowp = O + (size_t)(row0 + ai * HALF + m * 16) * ldo + col0;
#pragma unroll
                for (int bj = 0; bj < 2; ++bj) { const f32x4 v0 = acc[ai][bj][m][0], v1 = acc[ai][bj][m][1];
                    u32x4 w; w.x = cvt_pk_bf16(v0[0], v0[1]); w.y = cvt_pk_bf16(v0[2], v0[3]); w.z = cvt_pk_bf16(v1[0], v1[1]); w.w = cvt_pk_bf16(v1[2], v1[3]);
                    *(u32x4*)(rowp + bj * HALF) = w; } }
    }
};
struct EpiQKV {
    static constexpr bool PERM = true;
    bf16_t* qkvc; const float* qg; const float* kg; const float* cosT; const float* sinT; PG8_LAS float* tab;
    __device__ __forceinline__ void operator()(f32x4 (&acc)[2][2][4][2], const Unit& u, int wr, int wc, int fr, int fq) const {
        const int g = u.pn / 12, which = (u.pn % 12) >> 2, hp = u.pn & 3, sh = 2 * g, d = 1 << sh;
        const int b = (u.pm * BM) / SEQ, p0 = (u.pm * BM) % SEQ + wr * 64 + fr;
        if (which < 2) {
#pragma unroll
            for (int ai = 0; ai < 2; ++ai)
#pragma unroll
                for (int bj = 0; bj < 2; ++bj)
#pragma unroll
                    for (int m = 0; m < 4; ++m) { const f32x4 a = acc[ai][bj][m][0], c = acc[ai][bj][m][1];
                        float s = (a[0] * a[0] + a[1] * a[1]) + (a[2] * a[2] + a[3] * a[3]) + (c[0] * c[0] + c[1] * c[1]) + (c[2] * c[2] + c[3] * c[3]);
                        s += __shfl_xor(s, 16); s += __shfl_xor(s, 32);
                        if (fq == 0) tab[((((ai * 2 + bj) * 4 + m) * 2 + wr) * 16 + fr) * 4 + wc] = s; }
            asm volatile("s_waitcnt lgkmcnt(0)" ::: "memory"); __builtin_amdgcn_s_barrier(); asm volatile("" ::: "memory");
            const float* gain = (which == 0 ? qg : kg) + g * HEAD_DIM + wc * 32 + 8 * fq;
            const f32x4 g0 = *(const f32x4*)gain, g1 = *(const f32x4*)(gain + 4);
#pragma unroll
            for (int ai = 0; ai < 2; ++ai)
#pragma unroll
                for (int m = 0; m < 4; ++m) {
                    f32x4 cs0, cs1, sn0, sn1;
                    if (wc == 0) { const size_t ti = (size_t)(b * SEQ + p0 + ai * HALF + m * 16) * 16 + 8 * (fq & 1);
                        cs0 = *(const f32x4*)(cosT + ti); cs1 = *(const f32x4*)(cosT + ti + 4); sn0 = *(const f32x4*)(sinT + ti); sn1 = *(const f32x4*)(sinT + ti + 4); }
#pragma unroll
                    for (int bj = 0; bj < 2; ++bj) { const f32x4 t = *(const PG8_LAS f32x4*)(tab + ((((ai * 2 + bj) * 4 + m) * 2 + wr) * 16 + fr) * 4);
                        const float rstd = rsqrtf(((t[0] + t[1]) + (t[2] + t[3])) * (1.0f / HEAD_DIM) + NORM_EPS);
                        f32x4 v0 = acc[ai][bj][m][0] * rstd * g0, v1 = acc[ai][bj][m][1] * rstd * g1;
                        if (wc == 0) {
                            f32x4 o0, o1;
#pragma unroll
                            for (int j = 0; j < 4; ++j) { const float pa = __shfl_xor(v0[j], 32), pb = __shfl_xor(v1[j], 32);
                                o0[j] = (fq < 2) ? v0[j] * cs0[j] - pa * sn0[j] : v0[j] * cs0[j] + pa * sn0[j];
                                o1[j] = (fq < 2) ? v1[j] * cs1[j] - pb * sn1[j] : v1[j] * cs1[j] + pb * sn1[j]; }
                            v0 = o0; v1 = o1; }
                        acc[ai][bj][m][0] = v0; acc[ai][bj][m][1] = v1; } }
        }
        bf16_t* base = qkvc + (size_t)(g * 3 + which) * ((size_t)M_TOK * D_MODEL) + wc * 32 + 8 * fq;
        const int Lg = SEQ >> sh;
#pragma unroll
        for (int ai = 0; ai < 2; ++ai)
#pragma unroll
            for (int m = 0; m < 4; ++m) { const int p = p0 + ai * HALF + m * 16, j = p >> sh, r = p & (d - 1);
#pragma unroll
                for (int bj = 0; bj < 2; ++bj) { const int h = 2 * hp + bj; const f32x4 v0 = acc[ai][bj][m][0], v1 = acc[ai][bj][m][1];
                    u32x4 w; w.x = cvt_pk_bf16(v0[0], v0[1]); w.y = cvt_pk_bf16(v0[2], v0[3]); w.z = cvt_pk_bf16(v1[0], v1[1]); w.w = cvt_pk_bf16(v1[2], v1[3]);
                    *(u32x4*)(base + ((size_t)(((b << sh) | r) * NHEAD + h) * Lg + j) * HEAD_DIM) = w; } }
    }
};
}
namespace swa {
constexpr int D = 128;
constexpr float THR = 8.f;
constexpr bool WSKIP = true;
constexpr float SCALE = 0.08838834764831845f;
constexpr int NW = 8, QBLK = 32, KVBLK = 64, QB = NW * QBLK;
constexpr int SHM_V = KVBLK * D * 2, SHM_K = KVBLK * D * 2;
constexpr int LDS_BYTES = 2 * SHM_V + 2 * SHM_K + NW * 64 * 4;
using bf16 = __hip_bfloat16;
typedef short bf16x8 __attribute__((ext_vector_type(8)));
typedef short s16x4 __attribute__((ext_vector_type(4)));
typedef float f32x16 __attribute__((ext_vector_type(16)));
typedef float f32x4 __attribute__((ext_vector_type(4)));
typedef unsigned u32x4 __attribute__((ext_vector_type(4)));
template <class A, class Bt> struct same_t { static constexpr bool v = false; };
template <class A> struct same_t<A, A> { static constexpr bool v = true; };

#define KSWZ(row, colB) ((row) * 256 + ((colB) ^ (((row) & 7) << 4)))
#define SBAR() __builtin_amdgcn_sched_barrier(0)
__device__ __forceinline__ int v_st(int k, int c) { const int kk = (k & ~0xC) | ((k & 4) << 1) | ((k & 8) >> 1); return ((kk >> 3) * 4 + (c >> 5)) * 512 + ((kk & 7) * 32 + (c & 31)) * 2; }
__device__ __forceinline__ int v_rd_base(int lane) { return ((lane & 3) << 3) | (((lane >> 2) & 3) << 6) | (((lane >> 4) & 1) << 5) | (((lane >> 5) & 1) << 8); }
constexpr int v_rd_off(int d0, int ks, int half) { return d0 * 512 + ks * 4096 + half * 2048; }
__device__ __forceinline__ int crow(int r, int hi) { return (r & 3) + 8 * (r >> 2) + 4 * hi; }
__device__ __forceinline__ unsigned cvtpk(float lo, float hi) {
    unsigned r; asm volatile("v_cvt_pk_bf16_f32 %0, %1, %2" : "=v"(r) : "v"(lo), "v"(hi)); return r;
}
__device__ __forceinline__ bf16x8 pack8(f32x4 a, f32x4 b) {
    u32x4 w = {cvtpk(a[0], a[1]), cvtpk(a[2], a[3]), cvtpk(b[0], b[1]), cvtpk(b[2], b[3])};
    return *reinterpret_cast<bf16x8*>(&w);
}
template <class T> __device__ __forceinline__ bf16x8 load8(const T* p) {
    if constexpr (same_t<T, float>::v) { return pack8(*(const f32x4*)p, *(const f32x4*)(p + 4)); }
    else { return *reinterpret_cast<const bf16x8*>(p); }
}
__device__ __forceinline__ void mask_tile(f32x16& p0, f32x16& p1, int dq, unsigned W) {
    const float NEG = -__builtin_inff();
#pragma unroll
    for (int r = 0; r < 16; ++r) {
        const int c = (r & 3) + 8 * (r >> 2);
        if ((unsigned)(dq - c) >= W) p0[r] = NEG;
        if ((unsigned)(dq - c - 32) >= W) p1[r] = NEG;
    }
}
__device__ __forceinline__ void partialSM(f32x16& p0, f32x16& p1, float& m_reg, float& mn, float& alpha) {
    float pmax = p0[0]; for (int r = 1; r < 16; ++r) pmax = fmaxf(pmax, p0[r]); for (int r = 0; r < 16; ++r) pmax = fmaxf(pmax, p1[r]);
    { auto rr = __builtin_amdgcn_permlane32_swap(__float_as_uint(pmax), __float_as_uint(pmax), false, false);
      pmax = fmaxf(__uint_as_float(rr[0]), __uint_as_float(rr[1])); }
    constexpr float C2 = 1.4426950408889634f * SCALE;
    if (__builtin_expect(__all((pmax - m_reg) * SCALE <= THR), 1)) { mn = m_reg; alpha = 1.f; }
    else { mn = fmaxf(m_reg, pmax); alpha = __builtin_amdgcn_exp2f((m_reg - mn) * C2); m_reg = mn; }
    const float mnL = -mn * C2;
    for (int r = 0; r < 16; ++r) p0[r] = fmaf(p0[r], C2, mnL); for (int r = 0; r < 16; ++r) p1[r] = fmaf(p1[r], C2, mnL);
    for (int r = 0; r < 16; ++r) p0[r] = __builtin_amdgcn_exp2f(p0[r]);
}
__device__ __forceinline__ void finishSM(f32x16& p0, f32x16& p1, float alpha, float& l_reg, bf16x8& pa0, bf16x8& pa1, bf16x8& pa2, bf16x8& pa3) {
    for (int r = 0; r < 16; ++r) p1[r] = __builtin_amdgcn_exp2f(p1[r]);
    float ps = 0; for (int r = 0; r < 16; ++r) ps += p0[r]; for (int r = 0; r < 16; ++r) ps += p1[r];
    { auto rr = __builtin_amdgcn_permlane32_swap(__float_as_uint(ps), __float_as_uint(ps), false, false);
      ps = __uint_as_float(rr[0]) + __uint_as_float(rr[1]); }
    l_reg = l_reg * alpha + ps;
#define PK4(P, B_, OUT) do { unsigned a0 = cvtpk(P[B_+0], P[B_+1]), a1 = cvtpk(P[B_+2], P[B_+3]);                          \
        unsigned b0 = cvtpk(P[B_+4], P[B_+5]), b1 = cvtpk(P[B_+6], P[B_+7]);                                             \
        auto r0 = __builtin_amdgcn_permlane32_swap(a0, b0, false, false); auto r1 = __builtin_amdgcn_permlane32_swap(a1, b1, false, false); \
        u32x4 w = {r0[0], r1[0], r0[1], r1[1]}; OUT = *reinterpret_cast<bf16x8*>(&w); } while (0)
    PK4(p0, 0, pa0); PK4(p0, 8, pa1); PK4(p1, 0, pa2); PK4(p1, 8, pa3);
#undef PK4
}
template <int KB, bool SK>
__device__ __forceinline__ void qkt(f32x16& p0, f32x16& p1, const char* K_lds, int r32, int hi, const bf16x8* qr, bool act) {
    if (SK && !act) { const float NEG = -__builtin_inff();
#pragma unroll
        for (int r = 0; r < 16; ++r) { p0[r] = NEG; p1[r] = NEG; } return; }
    p0 = f32x16{}; p1 = f32x16{};
    const char* kb[4];
#pragma unroll
    for (int dd = 0; dd < 4; ++dd) kb[dd] = K_lds + KB * SHM_K + KSWZ(r32, (dd * 16 + hi * 8) * 2);
#pragma unroll
    for (int d0 = 0; d0 < 8; ++d0) { const char* a = kb[d0 & 3] + (d0 >> 2) * 128;
        bf16x8 b0 = *reinterpret_cast<const bf16x8*>(a);
        bf16x8 b1 = *reinterpret_cast<const bf16x8*>(a + 32 * 256);
        p0 = __builtin_amdgcn_mfma_f32_32x32x16_bf16(b0, qr[d0], p0, 0, 0, 0);
        p1 = __builtin_amdgcn_mfma_f32_32x32x16_bf16(b1, qr[d0], p1, 0, 0, 0); }
}
template <int VB, bool SK>
__device__ __forceinline__ void pv_tile(f32x16* o, int vb0, bf16x8 pa0, bf16x8 pa1, bf16x8 pa2, bf16x8 pa3, bool act) {
    if (SK && !act) return;
#define TRRD(dst, off) asm volatile("ds_read_b64_tr_b16 %0, %1 offset:%2" : "=&v"(dst) : "v"(vb0), "i"(off) : "memory")
#define PV_D0(d0) do { s16x4 l0, l1, l2, l3, h0, h1, h2, h3; constexpr int b_ = VB * SHM_V + v_rd_off(d0, 0, 0);     \
        TRRD(l0, b_); TRRD(h0, b_ + 2048); TRRD(l1, b_ + 4096); TRRD(h1, b_ + 6144); TRRD(l2, b_ + 8192); TRRD(h2, b_ + 10240); TRRD(l3, b_ + 12288); TRRD(h3, b_ + 14336); \
        asm volatile("s_waitcnt lgkmcnt(0)" ::: "memory"); SBAR();                 \
        o[d0] = __builtin_amdgcn_mfma_f32_32x32x16_bf16(pa0, (bf16x8){l0[0], l0[1], l0[2], l0[3], h0[0], h0[1], h0[2], h0[3]}, o[d0], 0, 0, 0);   \
        o[d0] = __builtin_amdgcn_mfma_f32_32x32x16_bf16(pa1, (bf16x8){l1[0], l1[1], l1[2], l1[3], h1[0], h1[1], h1[2], h1[3]}, o[d0], 0, 0, 0);   \
        o[d0] = __builtin_amdgcn_mfma_f32_32x32x16_bf16(pa2, (bf16x8){l2[0], l2[1], l2[2], l2[3], h2[0], h2[1], h2[2], h2[3]}, o[d0], 0, 0, 0);   \
        o[d0] = __builtin_amdgcn_mfma_f32_32x32x16_bf16(pa3, (bf16x8){l3[0], l3[1], l3[2], l3[3], h3[0], h3[1], h3[2], h3[3]}, o[d0], 0, 0, 0); } while (0)
    PV_D0(0); PV_D0(1); PV_D0(2); PV_D0(3);
#undef PV_D0
#undef TRRD
}

template <class TIn, class TOut> struct BlockRef { const TIn* Q; const TIn* K; const TIn* V; TOut* O; int P0; };
template <class TIn> struct Seam {
    bf16x8 qr[8];
    bf16x8 st_v0, st_v1, st_k0, st_k1; f32x4 sf0, sf1, sf2, sf3;
    f32x4 tq[16];
};
__device__ __forceinline__ int swa_jlo(int P0, int W) { const int lowk = P0 - W + 1; return lowk > 0 ? lowk / KVBLK : 0; }
#define ROW(p, k0, rr) ((p) + (size_t)((k0) + (rr)) * D + sc)
#define VMW() asm volatile("s_waitcnt vmcnt(0)" ::: "memory")
#define VMWN(n) asm volatile("s_waitcnt vmcnt(%0)" :: "i"(n) : "memory")
#define SLOAD_H(Kp, Vp, k0) do { S.st_v0 = load8<TIn>(ROW(Vp, k0, sr)); S.st_v1 = load8<TIn>(ROW(Vp, k0, 32 + sr));              \
                         S.st_k0 = load8<TIn>(ROW(Kp, k0, sr)); S.st_k1 = load8<TIn>(ROW(Kp, k0, 32 + sr)); } while (0)
#define SWRITE_HK(bf) do { *(bf16x8*)(K_lds + (bf) * SHM_K + kws) = S.st_k0; *(bf16x8*)(K_lds + (bf) * SHM_K + kws + 32 * 256) = S.st_k1; } while (0)
#define SWRITE_HV(bf) do { *(bf16x8*)(V_lds + (bf) * SHM_V + vst0) = S.st_v0; *(bf16x8*)(V_lds + (bf) * SHM_V + vst1) = S.st_v1; } while (0)
#define SWRITE_H(bf) do { SWRITE_HV(bf); SWRITE_HK(bf); } while (0)
#define SLOAD_F(p, k0) do { S.sf0 = *(const f32x4*)ROW(p, k0, sr); S.sf1 = *(const f32x4*)(ROW(p, k0, sr) + 4);                \
                            S.sf2 = *(const f32x4*)ROW(p, k0, 32 + sr); S.sf3 = *(const f32x4*)(ROW(p, k0, 32 + sr) + 4); } while (0)
#define SWRITE_KF(bf) do { *(bf16x8*)(K_lds + (bf) * SHM_K + kws) = pack8(S.sf0, S.sf1); *(bf16x8*)(K_lds + (bf) * SHM_K + kws + 32 * 256) = pack8(S.sf2, S.sf3); } while (0)
#define SWRITE_VF(bf) do { *(bf16x8*)(V_lds + (bf) * SHM_V + vst0) = pack8(S.sf0, S.sf1); *(bf16x8*)(V_lds + (bf) * SHM_V + vst1) = pack8(S.sf2, S.sf3); } while (0)
template <class TIn, class TOut>
__device__ __forceinline__ void causal_swa_prime(const BlockRef<TIn, TOut>& cur, int W, char* lds, Seam<TIn>& S) {
    constexpr bool F32 = same_t<TIn, float>::v;
    int tid = threadIdx.x; asm volatile("" : "+v"(tid));
    const int wid = __builtin_amdgcn_readfirstlane(tid >> 6), lane = tid & 63, r32 = lane & 31, hi = lane >> 5;
    const int sr = tid >> 4, sc = (tid & 15) * 8, kws = KSWZ(sr, sc * 2); char* K_lds = lds + 2 * SHM_V;
    const int kb0 = swa_jlo(cur.P0, W) * KVBLK;
    for (int d0 = 0; d0 < 8; ++d0) S.qr[d0] = load8<TIn>(cur.Q + (size_t)(wid * QBLK + r32) * D + d0 * 16 + hi * 8);
    if constexpr (F32) { SLOAD_F((const float*)cur.K, kb0); VMW(); SWRITE_KF(0); SBAR(); SLOAD_F((const float*)cur.V, kb0); }
    else { SLOAD_H(cur.K, cur.V, kb0); VMW(); SWRITE_HK(0); }
    __syncthreads();
}
template <class TIn, class TOut>
__device__ __forceinline__ void causal_swa_block(const BlockRef<TIn, TOut>& cur, const BlockRef<TIn, TOut>& nxt, int skv, int W, char* lds, Seam<TIn>& S, const char* og_base, char* lse_base) {
    constexpr bool F32 = same_t<TIn, float>::v;
    int tid = threadIdx.x; asm volatile("" : "+v"(tid));
    const int wid = __builtin_amdgcn_readfirstlane(tid >> 6), lane = tid & 63, r32 = lane & 31, hi = lane >> 5;
    const int j_lo = swa_jlo(cur.P0, W);
    int j_hi = (cur.P0 + QB - 1) / KVBLK + 1; if (j_hi > skv / KVBLK) j_hi = skv / KVBLK;
    const int NT = j_hi - j_lo;
    const int kbn = swa_jlo(nxt.P0, W) * KVBLK;
    const int qlo = cur.P0 + wid * QBLK, qm = qlo + r32 - 4 * hi;
    char* V_lds = lds; char* K_lds = lds + 2 * SHM_V;
    float* ws = (float*)(lds + 2 * SHM_V + 2 * SHM_K) + wid * 64; float* li_l = ws, * al_l = ws + 32;
    float m_reg = -1e30f, l_reg = 0; f32x16 o[4] = {};
    const int sr = tid >> 4, sc = (tid & 15) * 8, vst0 = v_st(sr, sc), vst1 = v_st(32 + sr, sc), kws = KSWZ(sr, sc * 2);
    const int vb0 = (int)(uintptr_t)V_lds + v_rd_base(lane);
    const TIn* Kh = cur.K; const TIn* Vh = cur.V;
#define RESC(a) do { if (__any((a) < 1.f)) { if (hi == 0) al_l[r32] = (a); asm volatile("s_waitcnt lgkmcnt(0)" ::: "memory");              \
                     for (int d_ = 0; d_ < 4; ++d_) for (int r = 0; r < 16; ++r) o[d_][r] *= al_l[crow(r, hi)]; } } while (0)
#define KBASE(t) ((j_lo + (t)) * KVBLK)
#define ACT(t) (KBASE(t) <= qlo + QBLK - 1 && KBASE(t) + KVBLK - 1 >= qlo - W + 1)
#define MASKT(P0_, P1_, t) do { const int kb_ = KBASE(t); if ((!SK || ACT(t)) && (kb_ + KVBLK - 1 > qlo || kb_ <= qlo + QBLK - 1 - W)) mask_tile(P0_, P1_, qm - kb_, (unsigned)W); } while (0)
    constexpr int NQL = F32 ? 16 : 8;
    constexpr bool SK = WSKIP && !F32;
#define SEAM_K0() do { VMWN(NQL); if constexpr (F32) { SWRITE_KF(0); SBAR(); SLOAD_F((const float*)nxt.V, kbn); } else { SWRITE_HK(0); } SBAR(); } while (0)
    f32x16 pA0, pA1, pB0, pB1; float mnA, mnB, alA, alB; bf16x8 pa0, pa1, pa2, pa3;
    if constexpr (F32) { VMW(); SWRITE_VF(0); SBAR(); } else { SWRITE_HV(0); SBAR(); }
    if (NT > 1) { if constexpr (F32) SLOAD_F((const float*)Kh, KBASE(1)); else SLOAD_H(Kh, Vh, KBASE(1)); }
    SBAR(); qkt<0, SK>(pA0, pA1, K_lds, r32, hi, S.qr, ACT(0));
    if constexpr (F32) { if (NT > 1) { VMW(); SWRITE_KF(1); SBAR(); SLOAD_F((const float*)Vh, KBASE(1)); } }
    MASKT(pA0, pA1, 0); partialSM(pA0, pA1, m_reg, mnA, alA);
    if (NT > 1) { VMW(); if constexpr (F32) { SWRITE_VF(1); SBAR(); if (NT > 2) SLOAD_F((const float*)Kh, KBASE(2)); } else SWRITE_H(1); }
    __syncthreads();
#define HALF_STEP(PX0, PX1, mnX, alX, PY0, PY1, alY, t, KB, VB, SB) do {                                                      \
        SBAR(); qkt<KB, SK>(PX0, PX1, K_lds, r32, hi, S.qr, ACT(t));                                             \
        finishSM(PY0, PY1, alY, l_reg, pa0, pa1, pa2, pa3); SBAR();                                                           \
        if ((t) + 1 < NT) { if constexpr (F32) { VMW(); SWRITE_KF(SB); SBAR(); SLOAD_F((const float*)Vh, KBASE((t) + 1)); }  \
                            else { SLOAD_H(Kh, Vh, KBASE((t) + 1)); } SBAR(); }                                               \
        pv_tile<VB, SK>(o, vb0, pa0, pa1, pa2, pa3, ACT((t) - 1)); MASKT(PX0, PX1, (t)); partialSM(PX0, PX1, m_reg, mnX, alX);                                        \
        __syncthreads();                                                                                                      \
        if ((t) + 1 < NT) { VMW(); if constexpr (F32) { SWRITE_VF(SB); SBAR(); if ((t) + 2 < NT) SLOAD_F((const float*)Kh, KBASE((t) + 2)); } \
                            else { SWRITE_H(SB); } }                                                                          \
        RESC(alX); __syncthreads(); } while (0)
    for (int t = 1; t + 1 < NT; t += 2) {
        HALF_STEP(pB0, pB1, mnB, alB, pA0, pA1, alA, t, 1, 0, 0);
        HALF_STEP(pA0, pA1, mnA, alA, pB0, pB1, alB, t + 1, 0, 1, 1);
    }
    const bool even = (NT & 1) == 0;
    if (even) { SBAR(); qkt<1, SK>(pB0, pB1, K_lds, r32, hi, S.qr, ACT(NT - 1)); SBAR(); }
#define QROW(e) (nxt.Q + (size_t)(wid * QBLK + r32) * D + ((e) >> 1) * 16 + hi * 8 + ((e) & 1) * 4)
    if constexpr (F32) { SLOAD_F((const float*)nxt.K, kbn); SBAR();
#pragma unroll
        for (int e = 0; e < 8; ++e) S.tq[e] = *(const f32x4*)QROW(e); }
    else { SLOAD_H(nxt.K, nxt.V, kbn); SBAR();
#pragma unroll
        for (int d0 = 0; d0 < 8; ++d0) S.qr[d0] = load8<TIn>(nxt.Q + (size_t)(wid * QBLK + r32) * D + d0 * 16 + hi * 8); }
    SBAR();
    finishSM(pA0, pA1, alA, l_reg, pa0, pa1, pa2, pa3); SBAR();
    if constexpr (F32) {
#pragma unroll
        for (int e = 8; e < 16; ++e) S.tq[e] = *(const f32x4*)QROW(e); SBAR(); }
#undef QROW
    pv_tile<0, SK>(o, vb0, pa0, pa1, pa2, pa3, ACT(even ? NT - 2 : NT - 1));
    if (even) { MASKT(pB0, pB1, NT - 1); partialSM(pB0, pB1, m_reg, mnB, alB); __syncthreads(); RESC(alB);
        finishSM(pB0, pB1, alB, l_reg, pa0, pa1, pa2, pa3); SBAR(); pv_tile<1, SK>(o, vb0, pa0, pa1, pa2, pa3, ACT(NT - 1)); }
    SBAR(); SEAM_K0();
    if (hi == 0) { li_l[r32] = l_reg; ((float*)(lse_base + (((const char*)cur.O - og_base) >> 6)))[wid * QBLK + r32] = m_reg * SCALE + __logf(l_reg); } asm volatile("s_waitcnt lgkmcnt(0)" ::: "memory");
    float rli[16];
#pragma unroll
    for (int r = 0; r < 16; ++r) rli[r] = __builtin_amdgcn_rcpf(li_l[crow(r, hi)]);
    TOut* Ow = cur.O + (size_t)(wid * QBLK) * D;
#pragma unroll
    for (int r = 0; r < 16; ++r) { const int orow = crow(r, hi);
#pragma unroll
        for (int d0 = 0; d0 < 4; ++d0) { const float v = o[d0][r] * rli[r];
            if constexpr (same_t<TOut, float>::v) { Ow[(size_t)orow * D + d0 * 32 + r32] = v; }
            else { const float vn = __shfl_xor(v, 1);
                   if ((r32 & 1) == 0) *(unsigned*)(Ow + (size_t)orow * D + d0 * 32 + r32) = cvtpk(v, vn); } } }
    if constexpr (F32) {
#pragma unroll
        for (int d0 = 0; d0 < 8; ++d0) S.qr[d0] = pack8(S.tq[2 * d0], S.tq[2 * d0 + 1]); }
    __syncthreads();
#undef RESC
#undef KBASE
#undef ACT
#undef MASKT
#undef SEAM_K0
#undef HALF_STEP
}
#undef ROW
#undef VMW
#undef VMWN
#undef SLOAD_H
#undef SWRITE_HK
#undef SWRITE_HV
#undef SWRITE_H
#undef SLOAD_F
#undef SWRITE_KF
#undef SWRITE_VF


}
constexpr int NWAVES = 8;
#ifndef MK_PER_PHASE
#define MK_PER_PHASE 0
#endif
constexpr int PH_PER_PAIR = 14, NPHASES = 2 + 2 * PH_PER_PAIR;

constexpr size_t MiB = 1u << 20;
constexpr size_t WS_CTL = 0, CTL_ZERO_BYTES = 1 * MiB;
constexpr size_t WS_MODP = 1 * MiB;
constexpr size_t WS_COS = 3 * MiB, WS_SIN = 5 * MiB;
constexpr size_t WS_EIDX = 7 * MiB, WS_GATE = 7 * MiB + 256 * 1024, WS_SLOTOF = 7 * MiB + 512 * 1024, WS_STOK = 8 * MiB;
constexpr size_t WS_LSE = 9 * MiB;
constexpr size_t WS_WQKV = 16 * MiB, WS_WO = 52 * MiB, WS_WGU = 56 * MiB, WS_WDN = 78 * MiB, WS_WPOOL = 89 * MiB, WS_WMGU = 90 * MiB, WS_WMDN = 314 * MiB;
constexpr size_t WS_XB = 432 * MiB;
constexpr size_t WS_H = 560 * MiB;
constexpr size_t WS_BIG = 624 * MiB;
constexpr size_t WS_QKVC = WS_BIG, WS_OG = WS_BIG + 576 * MiB;
constexpr size_t WS_ACT = WS_BIG;
constexpr size_t WS_Y = WS_BIG + 480 * MiB;
constexpr size_t WS_END = WS_BIG + 768 * MiB;
constexpr int MAX_TILES = 2 * M_TOK / 256 + N_EXP, MAX_SLOTS = MAX_TILES * 256;
static_assert(WS_ACT + (size_t)MAX_SLOTS * D_FFE * 2 <= WS_Y && WS_Y + (size_t)MAX_SLOTS * D_MODEL * 2 <= WS_END && WS_STOK + (size_t)MAX_SLOTS * 4 <= WS_LSE, "d_ws map");
constexpr int CW_BAR = 4096;
constexpr int CW_CNT = 8192, CW_CUR = 12288;

constexpr int RING_OFF = 0, RING_BYTES = 131072;
constexpr int TAB_OFF = RING_BYTES;
constexpr int MISC_OFF = TAB_OFF + 8192;
constexpr int LDS_BYTES = 147456;
static_assert(MISC_OFF + 128 <= LDS_BYTES, "LDS map");

#define GAS __attribute__((address_space(1)))
#define LAS __attribute__((address_space(3)))
typedef unsigned short bf16;
typedef unsigned v4u __attribute__((ext_vector_type(4)));
typedef unsigned v2u __attribute__((ext_vector_type(2)));
typedef int v2i __attribute__((ext_vector_type(2)));
typedef float f32x4 __attribute__((ext_vector_type(4)));
typedef float f32x2 __attribute__((ext_vector_type(2)));
#define LDS_WAIT() asm volatile("s_waitcnt lgkmcnt(0)" ::: "memory")
#define VM_WAIT() asm volatile("s_waitcnt vmcnt(0)" ::: "memory")
__device__ __forceinline__ unsigned pk2(float lo, float hi) { return pg8::cvt_pk_bf16(lo, hi); }
__device__ __forceinline__ float bflo(unsigned w) { return __uint_as_float(w << 16); }
__device__ __forceinline__ float bfhi(unsigned w) { return __uint_as_float(w & 0xffff0000u); }
__device__ __forceinline__ float wave_sum(float v) {
#pragma unroll
    for (int o = 1; o < 64; o <<= 1) v += __shfl_xor(v, o);
    return v;
}
__device__ __forceinline__ int rdlane_i(int v, int l) { return __builtin_amdgcn_readlane(v, l); }
__device__ __forceinline__ float rdlane_f(float v, int l) { return __uint_as_float((unsigned)__builtin_amdgcn_readlane((int)__float_as_uint(v), l)); }

#define XB_TMO      128
#define XB_XCNT(j)  (256  + 64 * (j))
#define XB_XSUB(j)  (1280 + 64 * (j))
#define XB_XGEN(j)  (2304 + 64 * (j))
#define XB_TOP      3328
#define XB_TOPGEN   3392
#define XCD_BAR_WORDS 3456
#define XB_SPIN_CAP (1u << 18)

__device__ __forceinline__ unsigned xb_ld(unsigned* p)              { return __hip_atomic_load(p, __ATOMIC_RELAXED, __HIP_MEMORY_SCOPE_AGENT); }
__device__ __forceinline__ unsigned xb_add(unsigned* p, unsigned v) { return __hip_atomic_fetch_add(p, v, __ATOMIC_RELAXED, __HIP_MEMORY_SCOPE_AGENT); }
__device__ __forceinline__ unsigned xb_xcc_id() { return (unsigned)__builtin_amdgcn_s_getreg((3 << 11) | 20) & 0xFu; }
#define XB_SPIN(cond, bar) do { unsigned _sp = 0; while (cond) { __builtin_amdgcn_s_sleep(1); \
    if ((++_sp & 255u) == 0u) { if (xb_ld(&(bar)[XB_TMO])) break; if (_sp > XB_SPIN_CAP) { atomicAdd(&(bar)[XB_TMO], 1u); break; } } } } while (0)

struct XcdBarrier {
    unsigned* bar; unsigned x;
    volatile LAS unsigned* st;
};

__device__ __forceinline__ XcdBarrier xcd_barrier_post(unsigned* bar, volatile LAS unsigned* st) {
    XcdBarrier b; b.bar = bar; b.x = xb_xcc_id(); b.st = st;
    if (threadIdx.x == 0) (void)xb_add(&bar[XB_XCNT(b.x)], 1u);
    return b;
}
__device__ __forceinline__ void xcd_barrier_complete(unsigned* bar, unsigned x, unsigned& nloc, unsigned& nx) {
    const unsigned G = gridDim.x * gridDim.y * gridDim.z;
    unsigned sum, cnt, mine, sp = 0u;
    for (;;) {
        sum = 0u; cnt = 0u; mine = 0u;
#pragma unroll
        for (unsigned j = 0; j < 16; ++j) { const unsigned c = xb_ld(&bar[XB_XCNT(j)]); sum += c; cnt += (c > 0u) ? 1u : 0u; mine = (j == x) ? c : mine; }
        if (sum == G) break;
        __builtin_amdgcn_s_sleep(1);
        if ((++sp & 255u) == 0u) { if (xb_ld(&bar[XB_TMO])) break; if (sp > XB_SPIN_CAP) { atomicAdd(&bar[XB_TMO], 1u); break; } }
    }
    nloc = mine > 0u ? mine : 1u; nx = cnt > 0u ? cnt : 1u;
}

__device__ __forceinline__ void xcd_barrier(const XcdBarrier& b) {
    asm volatile("s_waitcnt vmcnt(0)" ::: "memory");
    __syncthreads();
    if (threadIdx.x == 0) {
        unsigned* bar = b.bar;
        __builtin_amdgcn_s_waitcnt(0);
        unsigned nloc = b.st[0], nx = b.st[1];
        if (nloc == 0u) { xcd_barrier_complete(bar, b.x, nloc, nx); b.st[0] = nloc; b.st[1] = nx; }
        const unsigned old = xb_add(&bar[XB_XSUB(b.x)], 1u);
        const unsigned gen = old / nloc;
        if (old + 1u == (gen + 1u) * nloc) {
            __builtin_amdgcn_fence(__ATOMIC_RELEASE, "agent");
            asm volatile("s_waitcnt vmcnt(0)" ::: "memory");
            const unsigned og = xb_add(&bar[XB_TOP], 1u);
            const unsigned tg = og / nx;
            if (og + 1u == (tg + 1u) * nx) xb_add(&bar[XB_TOPGEN], 1u);
            else XB_SPIN(xb_ld(&bar[XB_TOPGEN]) == tg, bar);
            __builtin_amdgcn_fence(__ATOMIC_ACQUIRE, "agent");
            xb_add(&bar[XB_XGEN(b.x)], 1u);
            asm volatile("s_waitcnt vmcnt(0)" ::: "memory");
        } else {
            XB_SPIN(xb_ld(&bar[XB_XGEN(b.x)]) == gen, bar);
            __builtin_amdgcn_fence(__ATOMIC_ACQUIRE, "agent");
            asm volatile("s_waitcnt vmcnt(0)" ::: "memory");
        }
    }
    __syncthreads();
}
using pg8::mod4;
__device__ __forceinline__ int gu_row(int n0, int F) { return n0 < F ? (n0 >> 7) * 256 + (n0 & 127) : ((n0 - F) >> 7) * 256 + 128 + ((n0 - F) & 127); }
__device__ __forceinline__ void tr_item(const float* W, int N, int k0, int n0, bf16* WT, int Kd, int drow, LAS float* scr, int lane) {
#pragma unroll 8
    for (int i = 0; i < 32; ++i) { const int kk = 2 * i + (lane >> 5); scr[kk * 33 + (lane & 31)] = W[(size_t)(k0 + kk) * N + n0 + (lane & 31)]; }
    LDS_WAIT(); asm volatile("" ::: "memory");
    const int c = lane & 7;
#pragma unroll
    for (int j = 0; j < 4; ++j) { const int n = (lane >> 3) + 8 * j; const LAS float* s = scr + (8 * c) * 33 + n;
        v4u o; o.x = pk2(s[0 * 33], s[1 * 33]); o.y = pk2(s[2 * 33], s[3 * 33]); o.z = pk2(s[4 * 33], s[5 * 33]); o.w = pk2(s[6 * 33], s[7 * 33]);
        *(GAS v4u*)(WT + (size_t)(drow + n) * Kd + k0 + 8 * c) = o; }
    LDS_WAIT(); asm volatile("" ::: "memory");
}
struct ProIn { const float *c, *ada_w, *pool_w, *wqkv, *wo, *wgu, *wdn, *mgu, *mdn; const int* pos; };
constexpr int TI_QKV = 2 * 16 * 288, TI_WO = 2 * 16 * 32, TI_GU = 2 * 16 * 176, TI_DN = 2 * 44 * 32, TI_POOL = 8 * 4 * 8, TI_MGU = 16 * 16 * 224, TI_MDN = 16 * 56 * 32;
constexpr int TI_ALL = TI_QKV + TI_WO + TI_GU + TI_DN + TI_POOL + TI_MGU + TI_MDN;
__device__ __forceinline__ void p0_prologue(const ProIn& I, unsigned char* ws, LAS unsigned char* lds, int gw, int NGW, int wave, int lane) {
    LAS float* scr = (LAS float*)(lds + RING_OFF + wave * 16384);
    for (int it = gw; it < DEPTH * 24 * 4; it += NGW) {
        const int layer = it / 96, rem = it % 96, chunk = rem >> 2, ks = rem & 3, kb = ks * 256;
#pragma unroll
        for (int q = 0; q < 16; ++q) { const int idx = lane + 64 * q, b = idx >> 8, k = idx & 255; const float cv = I.c[b * D_MODEL + kb + k]; scr[idx] = cv / (1.0f + __expf(-cv)); }
        LDS_WAIT(); asm volatile("" ::: "memory");
        const float* wp = I.ada_w + ((size_t)layer * D_MODEL + kb) * (6 * D_MODEL) + chunk * 256 + 4 * lane;
        f32x4 a0 = {0.f, 0.f, 0.f, 0.f}, a1 = a0, a2 = a0, a3 = a0;
#pragma unroll 2
        for (int k = 0; k < 256; k += 4) {
            const f32x4 w0 = *(const GAS f32x4*)(wp + (size_t)(k + 0) * (6 * D_MODEL)), w1 = *(const GAS f32x4*)(wp + (size_t)(k + 1) * (6 * D_MODEL)), w2 = *(const GAS f32x4*)(wp + (size_t)(k + 2) * (6 * D_MODEL)), w3 = *(const GAS f32x4*)(wp + (size_t)(k + 3) * (6 * D_MODEL));
            const f32x4 c0 = *(const LAS f32x4*)(scr + k), c1 = *(const LAS f32x4*)(scr + 256 + k), c2 = *(const LAS f32x4*)(scr + 512 + k), c3 = *(const LAS f32x4*)(scr + 768 + k);
            a0 += w0 * c0.x + w1 * c0.y + w2 * c0.z + w3 * c0.w; a1 += w0 * c1.x + w1 * c1.y + w2 * c1.z + w3 * c1.w;
            a2 += w0 * c2.x + w1 * c2.y + w2 * c2.z + w3 * c2.w; a3 += w0 * c3.x + w1 * c3.y + w2 * c3.z + w3 * c3.w;
        }
        float* mp = (float*)(ws + WS_MODP) + (size_t)ks * pg8::MOD_SZ + (size_t)(layer * BATCH) * (6 * D_MODEL) + chunk * 256 + 4 * lane;
        *(f32x4*)(mp) = a0; *(f32x4*)(mp + 6 * D_MODEL) = a1; *(f32x4*)(mp + 12 * D_MODEL) = a2; *(f32x4*)(mp + 18 * D_MODEL) = a3;
        LDS_WAIT(); asm volatile("" ::: "memory");
    }
    for (int it = gw; it < M_TOK / 4; it += NGW) {
        const int m = 4 * it + (lane >> 4), i = lane & 15;
        unsigned fb = 0x3f800000u;
        fb = (i == 1) ? 0x3ee177bbu : fb; fb = (i == 2) ? 0x3e4693afu : fb; fb = (i == 3) ? 0x3daee4adu : fb; fb = (i == 4) ? 0x3d1a08c8u : fb; fb = (i == 5) ? 0x3c87a9c2u : fb;
        fb = (i == 6) ? 0x3beef74eu : fb; fb = (i == 7) ? 0x3b52771fu : fb; fb = (i == 8) ? 0x3ab95d22u : fb; fb = (i == 9) ? 0x3a23418cu : fb; fb = (i == 10) ? 0x398fc8f8u : fb;
        fb = (i == 11) ? 0x38fd45c2u : fb; fb = (i == 12) ? 0x385f10c5u : fb; fb = (i == 13) ? 0x37c47611u : fb; fb = (i == 14) ? 0x372d07a8u : fb; fb = (i == 15) ? 0x369864a7u : fb;
        const float invf = __uint_as_float(fb);
        const float angf = (float)I.pos[m] * invf; const double ang = (double)angf;
        const double q = rint(ang * 0.63661977236758134308); const double r = fma(-q, 1.57079632679489661923, ang) - q * 6.123233995736766e-17; const double r2 = r * r;
        double sp = -1.0 / 1307674368000.0; sp = sp * r2 + 1.0 / 6227020800.0; sp = sp * r2 - 1.0 / 39916800.0; sp = sp * r2 + 1.0 / 362880.0; sp = sp * r2 - 1.0 / 5040.0; sp = sp * r2 + 1.0 / 120.0; sp = sp * r2 - 1.0 / 6.0; sp = sp * r2 + 1.0; sp *= r;
        double cp = 1.0 / 20922789888000.0; cp = cp * r2 - 1.0 / 87178291200.0; cp = cp * r2 + 1.0 / 479001600.0; cp = cp * r2 - 1.0 / 3628800.0; cp = cp * r2 + 1.0 / 40320.0; cp = cp * r2 - 1.0 / 720.0; cp = cp * r2 + 1.0 / 24.0; cp = cp * r2 - 0.5; cp = cp * r2 + 1.0;
        const int qi = ((int)q) & 3; const double sv = (qi == 0) ? sp : (qi == 1) ? cp : (qi == 2) ? -sp : -cp, cv = (qi == 0) ? cp : (qi == 1) ? -sp : (qi == 2) ? -cp : sp;
        ((float*)(ws + WS_COS))[(size_t)m * 16 + i] = (float)cv; ((float*)(ws + WS_SIN))[(size_t)m * 16 + i] = (float)sv;
    }
    for (int it0 = gw; it0 < TI_ALL; it0 += NGW) {
        int it = it0; const float* W; bf16* WT; int K, N, nblk, r; bool gu = false; int F = 0;
        if (it < TI_QKV) { const int j = it / (16 * 288); r = it % (16 * 288); K = 1024; N = QKV_W; nblk = 288; W = I.wqkv + (size_t)j * 1024 * QKV_W; WT = (bf16*)(ws + WS_WQKV) + (size_t)j * QKV_W * 1024; }
        else { it -= TI_QKV;
        if (it < TI_WO) { const int j = it / 512; r = it % 512; K = 1024; N = 1024; nblk = 32; W = I.wo + (size_t)j * 1024 * 1024; WT = (bf16*)(ws + WS_WO) + (size_t)j * 1024 * 1024; }
        else { it -= TI_WO;
        if (it < TI_GU) { const int j = it / (16 * 176); r = it % (16 * 176); K = 1024; N = 2 * D_FF; nblk = 176; gu = true; F = D_FF; W = I.wgu + (size_t)j * 1024 * 2 * D_FF; WT = (bf16*)(ws + WS_WGU) + (size_t)j * 2 * D_FF * 1024; }
        else { it -= TI_GU;
        if (it < TI_DN) { const int j = it / (44 * 32); r = it % (44 * 32); K = D_FF; N = 1024; nblk = 32; W = I.wdn + (size_t)j * D_FF * 1024; WT = (bf16*)(ws + WS_WDN) + (size_t)j * 1024 * D_FF; }
        else { it -= TI_DN;
        if (it < TI_POOL) { const int jg = it / 32; r = it % 32; K = 256; N = 256; nblk = 8; W = I.pool_w + (size_t)jg * 65536; WT = (bf16*)(ws + WS_WPOOL) + (size_t)jg * 65536; }
        else { it -= TI_POOL;
        if (it < TI_MGU) { const int je = it / (16 * 224); r = it % (16 * 224); K = 1024; N = 2 * D_FFE; nblk = 224; gu = true; F = D_FFE; W = I.mgu + (size_t)je * 1024 * 2 * D_FFE; WT = (bf16*)(ws + WS_WMGU) + (size_t)je * 2 * D_FFE * 1024; }
        else { it -= TI_MGU;
        { const int je = it / (56 * 32); r = it % (56 * 32); K = D_FFE; N = 1024; nblk = 32; W = I.mdn + (size_t)je * D_FFE * 1024; WT = (bf16*)(ws + WS_WMDN) + (size_t)je * 1024 * D_FFE; } } } } } } }
        const int kb = r / nblk, nb = r % nblk, n0 = 32 * nb;
        tr_item(W, N, 64 * kb, n0, WT, K, gu ? gu_row(n0, F) : n0, scr, lane);
    }
}

__device__ __forceinline__ void ld_row(const float* p, int lane, f32x4 (&v)[4]) {
#pragma unroll
    for (int j = 0; j < 4; ++j) v[j] = *(const GAS f32x4*)(p + 4 * lane + 256 * j); }
__device__ __forceinline__ void ld_yrow(const bf16* p, int lane, v2u (&y)[4]) {
#pragma unroll
    for (int j = 0; j < 4; ++j) y[j] = *(const GAS v2u*)(p + 4 * lane + 256 * j); }
__device__ __forceinline__ f32x4 y4(v2u a) { return (f32x4){bflo(a.x), bfhi(a.x), bflo(a.y), bfhi(a.y)}; }
__device__ __forceinline__ float row_rstd(const f32x4 (&v)[4]) {
    float s = 0.f;
#pragma unroll
    for (int j = 0; j < 4; ++j) s += (v[j].x * v[j].x + v[j].y * v[j].y) + (v[j].z * v[j].z + v[j].w * v[j].w);
    return rsqrtf(wave_sum(s) * (1.0f / D_MODEL) + NORM_EPS);
}
__device__ __forceinline__ void st_row_bf16(bf16* p, int lane, const f32x4 (&h)[4]) {
#pragma unroll
    for (int j = 0; j < 4; ++j) { v2u o; o.x = pk2(h[j].x, h[j].y); o.y = pk2(h[j].z, h[j].w); *(GAS v2u*)(p + 4 * lane + 256 * j) = o; } }

template <bool COMBINE>
__device__ __forceinline__ void pool_prep_phase(int gw, int NGW, int wave, int lane, LAS unsigned char* lds, const float* Xprev, float* Xcur, bf16* P, const float* gain, const float* modp, const float* ada_b, int layer,
                                                const bf16* Y, const int* slot_of, const float* gatev) {
    LAS v2u* ring = (LAS v2u*)(lds + RING_OFF + wave * 16384) + lane;
    for (int it = gw; it < M_TOK / 16; it += NGW) {
        const int t0 = 16 * it, b = t0 / SEQ; const bool first = (t0 % SEQ) == 0;
        f32x4 A[4], G2[4];
#pragma unroll
        for (int j = 0; j < 4; ++j) { const int col = 4 * lane + 256 * j; A[j] = *(const f32x4*)(gain + col) * (mod4(modp, ada_b, layer, b, 1, col) + 1.0f); if (COMBINE) G2[j] = mod4(modp, ada_b, layer - 1, b, 5, col); }
        v2i sl = {0, 0}; f32x2 gt = {0.f, 0.f};
        if (COMBINE) { const int rr = first ? t0 + (lane & 15) : t0 - 16 + (lane & 31); sl = *(const GAS v2i*)(slot_of + 2 * rr); gt = *(const GAS f32x2*)(gatev + 2 * rr); }
#pragma unroll
        for (int q = 0; q < 30; ++q) ring[q * 64] = (v2u){0u, 0u};
        f32x4 s[4];
#pragma unroll
        for (int q = 0; q < 4; ++q) s[q] = (f32x4){0.f, 0.f, 0.f, 0.f};
        const int q0 = first ? 16 : 0; const int rbase = t0 - 16;
        f32x4 xv[4]; v2u ya[4], yb[4];
        { ld_row(Xprev + (size_t)(rbase + q0) * D_MODEL, lane, xv);
          if (COMBINE) { ld_yrow(Y + (size_t)rdlane_i(sl.x, 0) * D_MODEL, lane, ya); ld_yrow(Y + (size_t)rdlane_i(sl.y, 0) * D_MODEL, lane, yb); } }
#pragma nounroll
        for (int q = q0; q < 32; ++q) {
            const int row = rbase + q, li = q - q0, i = q & 15;
            f32x4 v[4];
#pragma unroll
            for (int j = 0; j < 4; ++j) v[j] = xv[j];
            if (COMBINE) { const float g0 = rdlane_f(gt.x, li), g1 = rdlane_f(gt.y, li);
#pragma unroll
                for (int j = 0; j < 4; ++j) v[j] += G2[j] * (y4(ya[j]) * g0 + y4(yb[j]) * g1); }
            if (q < 31) { ld_row(Xprev + (size_t)(row + 1) * D_MODEL, lane, xv);
                if (COMBINE) { ld_yrow(Y + (size_t)rdlane_i(sl.x, li + 1) * D_MODEL, lane, ya); ld_yrow(Y + (size_t)rdlane_i(sl.y, li + 1) * D_MODEL, lane, yb); } }
            if (COMBINE && q >= 16) {
#pragma unroll
                for (int j = 0; j < 4; ++j) *(GAS f32x4*)(Xcur + (size_t)row * D_MODEL + 4 * lane + 256 * j) = v[j]; }
            const float rstd = row_rstd(v);
#pragma unroll
            for (int j = 0; j < 4; ++j) { v[j] *= rstd;
                constexpr int W_[4] = {2, 4, 8, 16}, B_[4] = {0, 2, 6, 14};
                const int slot = B_[j] + (i & (W_[j] - 1));
                v2u nw; nw.x = pk2(v[j].x, v[j].y); nw.y = pk2(v[j].z, v[j].w);
                const v2u od = ring[slot * 64]; ring[slot * 64] = nw;
                s[j] += y4(nw) - y4(od); }
            if (q >= 16) {
                const int n1 = i + 1;
                const float i0 = first ? 1.0f / (float)(n1 < 2 ? n1 : 2) : 0.5f, i1 = first ? 1.0f / (float)(n1 < 4 ? n1 : 4) : 0.25f;
                const float i2 = first ? 1.0f / (float)(n1 < 8 ? n1 : 8) : 0.125f, i3 = first ? 1.0f / (float)n1 : 0.0625f;
                f32x4 h[4]; h[0] = (s[0] * i0 - v[0]) * A[0]; h[1] = (s[1] * i1 - v[1]) * A[1]; h[2] = (s[2] * i2 - v[2]) * A[2]; h[3] = (s[3] * i3 - v[3]) * A[3];
                st_row_bf16(P + (size_t)row * D_MODEL, lane, h);
            }
        }
        LDS_WAIT(); asm volatile("" ::: "memory");
    }
}

template <bool ROUTE>
__device__ __forceinline__ void norm_phase(int gw, int NGW, int lane, const float* X, bf16* H, const float* gain, const float* modp, const float* ada_b, int layer, int part_sh,
                                           const LAS float* wr_t  , const float* rb, int* eidx, float* gatev, unsigned* cnt) {
    int mycnt = 0;
    for (int it = gw; it < M_TOK / 16; it += NGW) {
        const int t0 = 16 * it, b = t0 / SEQ;
        f32x4 A[4], Bv[4];
#pragma unroll
        for (int j = 0; j < 4; ++j) { const int col = 4 * lane + 256 * j; A[j] = *(const f32x4*)(gain + col) * (mod4(modp, ada_b, layer, b, part_sh + 1, col) + 1.0f); Bv[j] = mod4(modp, ada_b, layer, b, part_sh, col); }
        f32x4 xv[4]; ld_row(X + (size_t)t0 * D_MODEL, lane, xv);
#pragma unroll 2
        for (int i = 0; i < 16; ++i) {
            const int row = t0 + i; f32x4 v[4];
#pragma unroll
            for (int j = 0; j < 4; ++j) v[j] = xv[j];
            if (i < 15) ld_row(X + (size_t)(row + 1) * D_MODEL, lane, xv);
            const float rstd = row_rstd(v);
#pragma unroll
            for (int j = 0; j < 4; ++j) v[j] = v[j] * rstd * A[j] + Bv[j];
            st_row_bf16(H + (size_t)row * D_MODEL, lane, v);
            if (ROUTE) {
                float lg[8];
#pragma unroll
                for (int e = 0; e < 8; ++e) { float p = 0.f;
#pragma unroll
                    for (int j = 0; j < 4; ++j) { const f32x4 w = *(const LAS f32x4*)(wr_t + e * D_MODEL + 4 * lane + 256 * j); p += (v[j].x * w.x + v[j].y * w.y) + (v[j].z * w.z + v[j].w * w.w); }
                    lg[e] = wave_sum(p) + rb[e]; }
                int e1 = 0; float v1 = lg[0];
#pragma unroll
                for (int e = 1; e < 8; ++e) if (lg[e] > v1) { v1 = lg[e]; e1 = e; }
                int e2 = -1; float v2 = -__builtin_inff();
#pragma unroll
                for (int e = 0; e < 8; ++e) if (e != e1 && lg[e] > v2) { v2 = lg[e]; e2 = e; }
                const float ex = __expf(v2 - v1), g1 = 1.0f / (1.0f + ex), g2 = ex * g1;
                if (lane == 0) { *(GAS v2i*)(eidx + 2 * row) = (v2i){e1, e2}; *(GAS f32x2*)(gatev + 2 * row) = (f32x2){g1, g2}; }
                mycnt += (lane == e1 || lane == e2) ? 1 : 0;
            }
        }
    }
    if (ROUTE) { if (lane < 8 && mycnt > 0) atomicAdd(cnt + lane * 64, (unsigned)mycnt); }
}

__device__ __forceinline__ void slot_phase(int gw, int NGW, int lane, const int* eidx, const unsigned* cnt, unsigned* cur, int* stok, int* slot_of) {
    int base[8]; { int acc = 0;
#pragma unroll
        for (int e = 0; e < 8; ++e) { base[e] = acc * 256; acc += ((int)__hip_atomic_load(cnt + e * 64, __ATOMIC_RELAXED, __HIP_MEMORY_SCOPE_AGENT) + 255) >> 8; } }
    for (int it = gw; it < M_TOK / 32; it += NGW) {
        const int ent = 64 * it + lane;
        const int e = eidx[ent]; int slot = 0;
#pragma unroll
        for (int x = 0; x < 8; ++x) {
            const unsigned long long mask = __ballot(e == x);
            if (mask) { const int n = __popcll(mask), leader = __ffsll((long long)mask) - 1; unsigned st = 0;
                if (lane == leader) st = atomicAdd(cur + x * 64, (unsigned)n);
                st = (unsigned)rdlane_i((int)st, leader);
                if (e == x) slot = base[x] + (int)st + __popcll(mask & ((1ull << lane) - 1ull)); }
        }
        stok[slot] = ent >> 1; slot_of[ent] = slot;
    }
}

__device__ __forceinline__ void merge_phase(int gw, int NGW, int lane, const bf16* OG, const float* LSE, bf16* AO) {
    for (int it = gw; it < M_TOK / 16; it += NGW) {
#pragma unroll 2
        for (int i = 0; i < 16; ++i) {
            const int m = 16 * it + i, b = m / SEQ, p = m % SEQ;
#pragma unroll
            for (int seg = 0; seg < 2; ++seg) {
                const int col = 512 * seg + 8 * lane, h = col >> 7, e0 = col & 127;
                v4u o[3]; float ls[3];
#pragma unroll
                for (int g = 0; g < 3; ++g) { const int sh = 2 * g, Lg = SEQ >> sh, j = p >> sh, r = p & ((1 << sh) - 1); const size_t ci = (size_t)(((b << sh) | r) * NHEAD + h) * Lg + j;
                    o[g] = *(const GAS v4u*)(OG + (size_t)g * ((size_t)M_TOK * D_MODEL) + ci * HEAD_DIM + e0); ls[g] = LSE[(size_t)g * ((size_t)M_TOK * NHEAD) + ci]; }
                const float mx = fmaxf(ls[0], fmaxf(ls[1], ls[2])); float a0 = __expf(ls[0] - mx), a1 = __expf(ls[1] - mx), a2 = __expf(ls[2] - mx); const float inv = 1.0f / (a0 + a1 + a2); a0 *= inv; a1 *= inv; a2 *= inv;
                v4u w;
#pragma unroll
                for (int q = 0; q < 4; ++q) { const float lo = bflo(o[0][q]) * a0 + bflo(o[1][q]) * a1 + bflo(o[2][q]) * a2, hi = bfhi(o[0][q]) * a0 + bfhi(o[1][q]) * a1 + bfhi(o[2][q]) * a2; w[q] = pk2(lo, hi); }
                *(GAS v4u*)(AO + (size_t)m * D_MODEL + col) = w;
            }
        }
    }
}

__device__ __forceinline__ void final_phase(int gw, int NGW, int lane, const float* X, float* out, const float* modp, const float* ada_b, int layer, const bf16* Y, const int* slot_of, const float* gatev) {
    for (int it = gw; it < M_TOK / 16; it += NGW) {
        const int t0 = 16 * it, b = t0 / SEQ;
        f32x4 G2[4];
#pragma unroll
        for (int j = 0; j < 4; ++j) G2[j] = mod4(modp, ada_b, layer, b, 5, 4 * lane + 256 * j);
        const v2i sl = *(const GAS v2i*)(slot_of + 2 * (t0 + (lane & 15))); const f32x2 gt = *(const GAS f32x2*)(gatev + 2 * (t0 + (lane & 15)));
        f32x4 xv[4]; v2u ya[4], yb[4];
        ld_row(X + (size_t)t0 * D_MODEL, lane, xv); ld_yrow(Y + (size_t)rdlane_i(sl.x, 0) * D_MODEL, lane, ya); ld_yrow(Y + (size_t)rdlane_i(sl.y, 0) * D_MODEL, lane, yb);
#pragma unroll
        for (int i = 0; i < 16; ++i) {
            const int row = t0 + i; f32x4 v[4]; const float g0 = rdlane_f(gt.x, i), g1 = rdlane_f(gt.y, i);
#pragma unroll
            for (int j = 0; j < 4; ++j) v[j] = xv[j] + G2[j] * (y4(ya[j]) * g0 + y4(yb[j]) * g1);
            if (i < 15) { ld_row(X + (size_t)(row + 1) * D_MODEL, lane, xv); ld_yrow(Y + (size_t)rdlane_i(sl.x, i + 1) * D_MODEL, lane, ya); ld_yrow(Y + (size_t)rdlane_i(sl.y, i + 1) * D_MODEL, lane, yb); }
#pragma unroll
            for (int j = 0; j < 4; ++j) *(GAS f32x4*)(out + (size_t)row * D_MODEL + 4 * lane + 256 * j) = v[j];
        }
    }
}
typedef __hip_bfloat16 hbf;
constexpr size_t SUBT = (size_t)M_TOK * D_MODEL;
constexpr int ATT_ITEMS = 3 * (M_TOK * NHEAD / 256);
__device__ __forceinline__ swa::BlockRef<hbf, hbf> attn_ref(int L, const hbf* qkvc, hbf* og) {
    const int g = L >> 10, rem = L & 1023, sh = 2 * g, lq = 5 - sh, chain = rem >> lq, qb = rem & ((1 << lq) - 1), Lg = SEQ >> sh;
    const size_t co = (size_t)chain * Lg * HEAD_DIM, qo = (size_t)qb * 256 * HEAD_DIM;
    swa::BlockRef<hbf, hbf> r;
    r.Q = qkvc + (size_t)(g * 3 + 0) * SUBT + co + qo; r.K = qkvc + (size_t)(g * 3 + 1) * SUBT + co; r.V = qkvc + (size_t)(g * 3 + 2) * SUBT + co;
    r.O = og + (size_t)g * SUBT + co + qo; r.P0 = qb * 256;
    return r;
}

struct Args { const void* in[19]; float* out; unsigned char* ws; int ph_lo, ph_hi, grid, pad; };
typedef const unsigned char __attribute__((address_space(4)))* kptr_t;
__device__ __forceinline__ kptr_t kargs() { kptr_t p = (kptr_t)__builtin_amdgcn_kernarg_segment_ptr(); asm volatile("" : "+s"(p)); return p; }
#define KIN(T, k) ((const T*)*(const void* const __attribute__((address_space(4)))*)(kp + 8 * (k)))
#define KOUT() ((float*)*(void* const __attribute__((address_space(4)))*)(kp + 152))
#define KWS() ((unsigned char*)*(void* const __attribute__((address_space(4)))*)(kp + 160))
static_assert(sizeof(Args) == 184, "Args layout: in[19] at 0, out at 152, ws at 160, ph_lo 168, ph_hi 172, grid 176");
#define KINT(off) (*(const int __attribute__((address_space(4)))*)(kp + (off)))
__device__ __forceinline__ bool ph_in(int k) { const kptr_t kp = kargs(); return KINT(168) <= k && k < KINT(172); }
__global__ void __launch_bounds__(NWAVES * 64, 2) mk_fwd(Args args) {
    extern __shared__ __attribute__((aligned(16))) unsigned char lds_raw[];
    LAS unsigned char* lds = (LAS unsigned char*)lds_raw;
    for (int u = threadIdx.x; u < (LDS_BYTES - MISC_OFF) / 4; u += NWAVES * 64) ((LAS unsigned*)(lds + MISC_OFF))[u] = 0u;
    __syncthreads();
    if (args.ph_hi - args.ph_lo > 1) (void)xcd_barrier_post((unsigned*)(args.ws + WS_CTL) + CW_BAR, (volatile LAS unsigned*)(lds + MISC_OFF) + 8);
#ifndef DBG_MASK
#define DBG_MASK 0xFFFF
#endif
#define EN(t) (((DBG_MASK) >> (t)) & 1)
#define IN(k) ph_in(k)
#define SEAM(k) do { if (IN(k) && IN((k) + 1)) { const kptr_t kp = kargs(); XcdBarrier bar_; bar_.bar = (unsigned*)(KWS() + WS_CTL) + CW_BAR; bar_.x = xb_xcc_id(); bar_.st = (volatile LAS unsigned*)(lds + MISC_OFF) + 8; xcd_barrier(bar_); } } while (0)
#define PH_SETUP() const kptr_t kp = kargs(); unsigned char* ws = KWS(); int tid = threadIdx.x; asm volatile("" : "+v"(tid)); const int lane = tid & 63, wave = __builtin_amdgcn_readfirstlane(tid >> 6); \
    const int G = KINT(176), bx = blockIdx.x, vcu = (G % 8 == 0) ? (bx % 8) * (G / 8) + bx / 8 : bx, gw = vcu * NWAVES + wave, NGW = G * NWAVES; (void)tid; (void)lane; (void)vcu; (void)gw; (void)NGW; (void)ws
#define MODP() ((const float*)(ws + WS_MODP))
#define ADAB() KIN(float, 6)
#define XCUR() ((lp == 0) ? KOUT() : (float*)(ws + WS_XB))
#define CNT() ((unsigned*)(ws + WS_CTL) + CW_CNT + lp * 8 * 64)

    if (EN(0) && IN(0)) { PH_SETUP(); ProIn I; I.c = KIN(float, 1); I.ada_w = KIN(float, 5); I.pool_w = KIN(float, 7); I.wqkv = KIN(float, 9); I.wo = KIN(float, 10);
        I.wgu = KIN(float, 13); I.wdn = KIN(float, 14); I.mgu = KIN(float, 17); I.mdn = KIN(float, 18); I.pos = KIN(int, 2);
        p0_prologue(I, ws, lds, gw, NGW, wave, lane); }
    SEAM(0);
    for (int lp = 0; lp < 2; ++lp) {
        const int pb = 1 + PH_PER_PAIR * lp;
        if (EN(1) && IN(pb + 0)) { PH_SETUP(); bf16* H = (bf16*)(ws + WS_H);
            if (lp == 0) pool_prep_phase<false>(gw, NGW, wave, lane, lds, KIN(float, 0), nullptr, H, KIN(float, 3), MODP(), ADAB(), 0, nullptr, nullptr, nullptr);
            else pool_prep_phase<true>(gw, NGW, wave, lane, lds, KOUT(), (float*)(ws + WS_XB), H, KIN(float, 3) + 2 * D_MODEL, MODP(), ADAB(), 2, (const bf16*)(ws + WS_Y), (const int*)(ws + WS_SLOTOF), (const float*)(ws + WS_GATE)); }
        SEAM(pb + 0);
        if (EN(2) && IN(pb + 1)) { PH_SETUP();
            pg8::SchedPlain S; S.init(ws + WS_H, (const bf16*)(ws + WS_WPOOL) + (size_t)lp * D_MODEL * 256, M_TOK, D_MODEL, 256, D_MODEL, 512, G, bx);
            pg8::EpiResid E{lp == 0 ? KIN(float, 0) : (const float*)(ws + WS_XB), XCUR(), MODP(), ADAB(), KIN(float, 8) + lp * D_MODEL, 2 * lp, 2};
            pg8::gemm_phase<pg8::EpiResid, pg8::SchedPlain, true>(lds + RING_OFF, 256, S, E); }
        SEAM(pb + 1);
        if (EN(3) && IN(pb + 2)) { PH_SETUP();
            norm_phase<false>(gw, NGW, lane, XCUR(), (bf16*)(ws + WS_H), KIN(float, 4) + 2 * lp * D_MODEL, MODP(), ADAB(), 2 * lp, 3, nullptr, nullptr, nullptr, nullptr, nullptr); }
        SEAM(pb + 2);
        if (EN(4) && IN(pb + 3)) { PH_SETUP();
            pg8::SchedPlain S; S.init(ws + WS_H, (const bf16*)(ws + WS_WGU) + (size_t)lp * 2 * D_FF * D_MODEL, M_TOK, 2 * D_FF, D_MODEL, D_MODEL, 0, G, bx);
            pg8::EpiSwiglu E{(bf16*)(ws + WS_ACT), D_FF};
            pg8::gemm_phase<pg8::EpiSwiglu, pg8::SchedPlain, true>(lds + RING_OFF, D_MODEL, S, E); }
        SEAM(pb + 3);
        if (EN(5) && IN(pb + 4)) { PH_SETUP();
            pg8::SchedPlain S; S.init(ws + WS_ACT, (const bf16*)(ws + WS_WDN) + (size_t)lp * D_MODEL * D_FF, M_TOK, D_MODEL, D_FF, D_FF, 0, G, bx);
            float* Xc = XCUR(); pg8::EpiResid E{Xc, Xc, MODP(), ADAB(), nullptr, 2 * lp, 5};
            pg8::gemm_phase<pg8::EpiResid, pg8::SchedPlain, true>(lds + RING_OFF, D_FF, S, E); }
        SEAM(pb + 4);
        if (EN(6) && IN(pb + 5)) { PH_SETUP();
            norm_phase<false>(gw, NGW, lane, XCUR(), (bf16*)(ws + WS_H), KIN(float, 3) + (2 * lp + 1) * D_MODEL, MODP(), ADAB(), 2 * lp + 1, 0, nullptr, nullptr, nullptr, nullptr, nullptr); }
        SEAM(pb + 5);
        if (EN(7) && IN(pb + 6)) { PH_SETUP();
            pg8::SchedPlain S; S.init(ws + WS_H, (const bf16*)(ws + WS_WQKV) + (size_t)lp * QKV_W * D_MODEL, M_TOK, QKV_W, D_MODEL, D_MODEL, 0, G, bx);
            pg8::EpiQKV E{(bf16*)(ws + WS_QKVC), KIN(float, 11) + lp * 3 * HEAD_DIM, KIN(float, 12) + lp * 3 * HEAD_DIM, (const float*)(ws + WS_COS), (const float*)(ws + WS_SIN), (LAS float*)(lds + TAB_OFF)};
            pg8::gemm_phase<pg8::EpiQKV, pg8::SchedPlain, true>(lds + RING_OFF, D_MODEL, S, E); }
        SEAM(pb + 6);
        if (EN(8) && IN(pb + 7)) { PH_SETUP();
            const hbf* qkvc = (const hbf*)(ws + WS_QKVC); hbf* og = (hbf*)(ws + WS_OG); float* lse = (float*)(ws + WS_LSE);
            int L = vcu;
            if (L < ATT_ITEMS) {
                swa::BlockRef<hbf, hbf> cb = attn_ref(L, qkvc, og); swa::Seam<hbf> S;
                swa::causal_swa_prime<hbf, hbf>(cb, 129, (char*)lds_raw, S);
                for (;;) {
                    const bool more = L + G < ATT_ITEMS;
                    const swa::BlockRef<hbf, hbf> nb = more ? attn_ref(L + G, qkvc, og) : cb;
                    swa::causal_swa_block<hbf, hbf>(cb, nb, SEQ >> (2 * (L >> 10)), 129, (char*)lds_raw, S, (const char*)og, (char*)lse);
                    if (!more) break;
                    cb = nb; L += G;
                }
            }
        }
        SEAM(pb + 7);
        if (EN(9) && IN(pb + 8)) { PH_SETUP(); merge_phase(gw, NGW, lane, (const bf16*)(ws + WS_OG), (const float*)(ws + WS_LSE), (bf16*)(ws + WS_H)); }
        SEAM(pb + 8);
        if (EN(10) && IN(pb + 9)) { PH_SETUP();
            pg8::SchedPlain S; S.init(ws + WS_H, (const bf16*)(ws + WS_WO) + (size_t)lp * D_MODEL * D_MODEL, M_TOK, D_MODEL, D_MODEL, D_MODEL, 0, G, bx);
            float* Xc = XCUR(); pg8::EpiResid E{Xc, Xc, MODP(), ADAB(), nullptr, 2 * lp + 1, 2};
            pg8::gemm_phase<pg8::EpiResid, pg8::SchedPlain, true>(lds + RING_OFF, D_MODEL, S, E); }
        SEAM(pb + 9);
        if (EN(11) && IN(pb + 10)) { PH_SETUP();
            LAS float* wr_t = (LAS float*)(lds + RING_OFF); const float* router_w = KIN(float, 15); int* stok = (int*)(ws + WS_STOK);
            for (int idx = tid; idx < D_MODEL * N_EXP; idx += NWAVES * 64) wr_t[(idx & 7) * D_MODEL + (idx >> 3)] = router_w[(size_t)lp * D_MODEL * N_EXP + idx];
            for (int i = gw * 64 + lane; i < MAX_SLOTS; i += NGW * 64) stok[i] = 0;
            __syncthreads();
            norm_phase<true>(gw, NGW, lane, XCUR(), (bf16*)(ws + WS_H), KIN(float, 4) + (2 * lp + 1) * D_MODEL, MODP(), ADAB(), 2 * lp + 1, 3, wr_t, KIN(float, 16) + lp * N_EXP, (int*)(ws + WS_EIDX), (float*)(ws + WS_GATE), CNT());
        }
        SEAM(pb + 10);
        if (EN(12) && IN(pb + 11)) { PH_SETUP();
            slot_phase(gw, NGW, lane, (const int*)(ws + WS_EIDX), CNT(), (unsigned*)(ws + WS_CTL) + CW_CUR + lp * 8 * 64, (int*)(ws + WS_STOK), (int*)(ws + WS_SLOTOF)); }
        SEAM(pb + 11);
        if (EN(13) && IN(pb + 12)) { PH_SETUP(); const unsigned* cnt = CNT();
            pg8::SchedMoE<true> S; { int acc = 0;
#pragma unroll
                for (int e = 0; e < 8; ++e) { S.tb[e] = acc; acc += ((int)__hip_atomic_load(cnt + e * 64, __ATOMIC_RELAXED, __HIP_MEMORY_SCOPE_AGENT) + 255) >> 8; } S.tb[8] = acc; }
            S.init_order(S.tb[8], 2 * D_FFE / 256, G, bx); S.A = (const char*)(ws + WS_H); S.B = (const char*)((const bf16*)(ws + WS_WMGU) + (size_t)lp * N_EXP * 2 * D_FFE * D_MODEL); S.lda = D_MODEL;
            S.b_exp = (size_t)2 * D_FFE * D_MODEL * 2; S.b_tile = (size_t)256 * D_MODEL * 2; S.tok = (const int*)(ws + WS_STOK);
            pg8::EpiSwiglu E{(bf16*)(ws + WS_ACT), D_FFE};
            pg8::gemm_phase<pg8::EpiSwiglu, pg8::SchedMoE<true>, true>(lds + RING_OFF, D_MODEL, S, E); }
        SEAM(pb + 12);
        if (EN(14) && IN(pb + 13)) { PH_SETUP(); const unsigned* cnt = CNT();
            pg8::SchedMoE<false> S; { int acc = 0;
#pragma unroll
                for (int e = 0; e < 8; ++e) { S.tb[e] = acc; acc += ((int)__hip_atomic_load(cnt + e * 64, __ATOMIC_RELAXED, __HIP_MEMORY_SCOPE_AGENT) + 255) >> 8; } S.tb[8] = acc; }
            S.init_order(S.tb[8], D_MODEL / 256, G, bx); S.A = (const char*)(ws + WS_ACT); S.B = (const char*)((const bf16*)(ws + WS_WMDN) + (size_t)lp * N_EXP * D_MODEL * D_FFE); S.lda = D_FFE;
            S.b_exp = (size_t)D_MODEL * D_FFE * 2; S.b_tile = (size_t)256 * D_FFE * 2; S.tok = nullptr;
            pg8::EpiBf16 E{(bf16*)(ws + WS_Y), D_MODEL};
            pg8::gemm_phase<pg8::EpiBf16, pg8::SchedMoE<false>, true>(lds + RING_OFF, D_FFE, S, E); }
        SEAM(pb + 13);
    }
    if (EN(15) && IN(NPHASES - 1)) { PH_SETUP();
        final_phase(gw, NGW, lane, (const float*)(ws + WS_XB), KOUT(), MODP(), ADAB(), DEPTH - 1, (const bf16*)(ws + WS_Y), (const int*)(ws + WS_SLOTOF), (const float*)(ws + WS_GATE)); }
#undef IN
#undef SEAM
#undef EN
#undef MODP
#undef ADAB
#undef XCUR
#undef CNT
#undef PH_SETUP
}

extern "C" void kernel_launch(void* const* d_in, const int* in_sizes, int n_in, void* d_out, int out_size, void* d_ws, size_t ws_size, hipStream_t stream) {
    static int grid = 0;
    if (grid == 0) {
        if (n_in != 19 || in_sizes[0] != M_TOK * D_MODEL || out_size != M_TOK * D_MODEL || ws_size < WS_END) { fprintf(stderr, "kernel_launch: unexpected shapes (n_in %d, in0 %d, out %d, ws %zu < %zu); nothing launched\n", n_in, n_in > 0 ? in_sizes[0] : -1, out_size, ws_size, (size_t)WS_END); grid = -1; return; }
        int dev = 0, cus = 0, per_cu = 0;
        if (hipGetDevice(&dev) != hipSuccess || hipDeviceGetAttribute(&cus, hipDeviceAttributeMultiprocessorCount, dev) != hipSuccess) { fprintf(stderr, "kernel_launch: device query failed\n"); grid = -1; return; }
        if (hipFuncSetAttribute((const void*)mk_fwd, hipFuncAttributeMaxDynamicSharedMemorySize, LDS_BYTES) != hipSuccess) { fprintf(stderr, "kernel_launch: hipFuncSetAttribute failed\n"); grid = -1; return; }
        if (hipOccupancyMaxActiveBlocksPerMultiprocessor(&per_cu, (const void*)mk_fwd, NWAVES * 64, LDS_BYTES) != hipSuccess || per_cu < 1) fprintf(stderr, "kernel_launch: note: occupancy query reports %d workgroups per CU\n", per_cu);
        (void)hipGetLastError();
        grid = cus;
    }
    if (grid < 0) return;
    if (hipMemsetAsync((char*)d_ws + WS_CTL, 0, CTL_ZERO_BYTES, stream) != hipSuccess) { fprintf(stderr, "kernel_launch: hipMemsetAsync failed\n"); return; }
    Args a{};
    for (int i = 0; i < 19; ++i) a.in[i] = d_in[i];
    a.out = (float*)d_out; a.ws = (unsigned char*)d_ws; a.grid = grid; a.pad = 0;
#if MK_PER_PHASE
    for (int k = 0; k < NPHASES; ++k) { a.ph_lo = k; a.ph_hi = k + 1; hipLaunchKernelGGL(mk_fwd, dim3(grid), dim3(NWAVES * 64), LDS_BYTES, stream, a); }
#else
    a.ph_lo = 0; a.ph_hi = NPHASES; hipLaunchKernelGGL(mk_fwd, dim3(grid), dim3(NWAVES * 64), LDS_BYTES, stream, a);
#endif
    const hipError_t le = hipPeekAtLastError();
    if (le != hipSuccess) fprintf(stderr, "kernel_launch: launch failed: %s\n", hipGetErrorName(le));
}
```

```cpp
#include <hip/hip_runtime.h>
#include <hip/hip_bf16.h>
#include <cstdio>
#include <cstdint>

constexpr int D_MODEL = 1024, BATCH = 4, SEQ = 8192, DEPTH = 4, M_TOK = BATCH * SEQ;
constexpr int QKV_W = 9216, D_FF = 2816, N_EXP = 8, D_FFE = 3584, HEAD_DIM = 128, NHEAD = 8;
constexpr float NORM_EPS = 1e-6f;

namespace pg8 {
#define PG8_LAS __attribute__((address_space(3)))
typedef unsigned short bf16_t;
typedef short bf16x8 __attribute__((ext_vector_type(8)));
typedef float f32x4 __attribute__((ext_vector_type(4)));
typedef float f32x2 __attribute__((ext_vector_type(2)));
typedef unsigned u32x4 __attribute__((ext_vector_type(4)));
typedef unsigned u32x2 __attribute__((ext_vector_type(2)));
constexpr int BM = 256, BK = 64, HALF = 128, HTB = HALF * BK * 2  , STAGE_BYTES = 8 * HTB, NXCD = 8, WGM = 8;

__host__ __device__ __forceinline__ int lds_byte(int r, int c) { const int st = (r >> 4) * 2 + (c >> 5), rr = r & 15, cc = c & 31, ob = rr * 64 + cc * 2; return st * 1024 + (ob ^ (((ob >> 9) & 1) << 5)); }
__host__ __device__ __forceinline__ void stage_rc(int b, int& R, int& C) { const int st = b / 1024, sb = b % 1024, swz = sb ^ (((sb >> 9) & 1) << 5); R = (st >> 1) * 16 + swz / 64; C = (st & 1) * 32 + (swz % 64) / 2; }
__host__ __device__ __forceinline__ int perm32(int rho) { const int n = rho >> 4, i = rho & 15; return 8 * (i >> 2) + 4 * n + (i & 3); }
__device__ __forceinline__ unsigned cvt_pk_bf16(float lo, float hi) { unsigned r; asm volatile("v_cvt_pk_bf16_f32 %0, %1, %2" : "=v"(r) : "v"(lo), "v"(hi)); return r; }

struct Unit { int pm, pn; };

struct OrderBase {
    int nM, nN, nwg, G, c;
    __device__ __forceinline__ void init_order(int nM_, int nN_, int G_, int c_) { nM = nM_; nN = nN_; nwg = nM * nN; G = G_; c = c_; }
    __device__ __forceinline__ bool next(int i, Unit& u) const {
        const long L = (long)i * G + c; if (L >= nwg) return false;
        int wgid = (int)L; { const int q = nwg / NXCD, r = nwg % NXCD, xcd = wgid % NXCD, off = wgid / NXCD; wgid = (xcd < r ? xcd * (q + 1) : r * (q + 1) + (xcd - r) * q) + off; }
        const int nig = WGM * nN, gid = wgid / nig, fm = gid * WGM, gsz = (nM - fm) < WGM ? (nM - fm) : WGM;
        u.pm = fm + ((wgid % nig) % gsz); u.pn = (wgid % nig) / gsz; return true;
    }
};
struct SchedPlain : OrderBase {
    const char* A; const char* B; int lda; int a_pn_step; size_t a_tile, b_tile;
    __device__ __forceinline__ void init(const void* A_, const void* B_, int M, int N, int K, int lda_, int a_pn_step_, int G_, int c_) {
        init_order(M / BM, N / BM, G_, c_); A = (const char*)A_; B = (const char*)B_; lda = lda_; a_pn_step = a_pn_step_; a_tile = (size_t)BM * lda_ * 2; b_tile = (size_t)BM * K * 2; }
    __device__ __forceinline__ const char* a_base(const Unit& u) const { return A + (size_t)u.pm * a_tile + (size_t)u.pn * a_pn_step; }
    __device__ __forceinline__ const char* b_base(const Unit& u) const { return B + (size_t)u.pn * b_tile; }
    __device__ __forceinline__ void a_offs(const Unit&, const int (&R)[2], const int (&C)[2], unsigned (&v)[2][2]) const {
#pragma unroll
        for (int h = 0; h < 2; ++h)
#pragma unroll
            for (int i = 0; i < 2; ++i) v[h][i] = (unsigned)((h * HALF + R[i]) * lda + C[i]) * 2u; }
};
template <bool GATHER> struct SchedMoE : OrderBase {
    int tb[9]; const char* A; const char* B; int lda; size_t b_exp, b_tile; const int* tok;
    __device__ __forceinline__ int expert(int pm) const { int e = 0;
#pragma unroll
        for (int j = 1; j < 8; ++j) e += (pm >= tb[j]) ? 1 : 0; return e; }
    __device__ __forceinline__ const char* a_base(const Unit& u) const { return GATHER ? A : A + (size_t)u.pm * BM * lda * 2; }
    __device__ __forceinline__ const char* b_base(const Unit& u) const { return B + (size_t)expert(u.pm) * b_exp + (size_t)u.pn * b_tile; }
    __device__ __forceinline__ void a_offs(const Unit& u, const int (&R)[2], const int (&C)[2], unsigned (&v)[2][2]) const {
#pragma unroll
        for (int h = 0; h < 2; ++h)
#pragma unroll
            for (int i = 0; i < 2; ++i) { const int row = GATHER ? tok[u.pm * BM + h * HALF + R[i]] : (h * HALF + R[i]); v[h][i] = (unsigned)(row * lda + C[i]) * 2u; } }
};

template <class Epi, class Sched, bool ALIGN_EPI>
__device__ __forceinline__ void gemm_phase(PG8_LAS unsigned char* lds, const int K, const Sched& S, const Epi& E) {
    int tid = threadIdx.x; asm volatile("" : "+v"(tid));
    const int wid = __builtin_amdgcn_readfirstlane(tid >> 6), lane = tid & 63, wr = wid >> 2, wc = wid & 3, fr = lane & 15, fq = lane >> 4;
    const int nt = K / BK;
    int RA[2], CA[2]; unsigned voffB[2];
#pragma unroll
    for (int i = 0; i < 2; ++i) { int R, C; stage_rc(tid * 16 + i * 8192, R, C); const int Rb = Epi::PERM ? ((R & ~31) + perm32(R & 31)) : R; RA[i] = R; CA[i] = C; voffB[i] = (unsigned)(Rb * K + C) * 2u; }
    const size_t kstep = (size_t)(BK * 2);
    const size_t hstep = (size_t)HALF * K * 2;
    const unsigned ldsw = (unsigned)wid * 1024u;
    const int aoff = lds_byte(wr * 64 + fr, fq * 8), boff = lds_byte(wc * 32 + fr, fq * 8);
#define PG8_SA(b, h) (((b) * 2 + (h)) * HTB)
#define PG8_SB(b, h) ((4 + (b) * 2 + (h)) * HTB)
#define PG8_STAGE2(bufoff, gbase, v0, v1) do { \
        __builtin_amdgcn_global_load_lds((const unsigned*)((const char*)(gbase) + (v0)), (PG8_LAS unsigned*)(lds + (bufoff) + ldsw), 16, 0, 0); \
        __builtin_amdgcn_global_load_lds((const unsigned*)((const char*)(gbase) + (v1)), (PG8_LAS unsigned*)(lds + (bufoff) + ldsw + 8192), 16, 0, 0); } while (0)
#define PG8_STAGEB(bufoff, gbase) PG8_STAGE2(bufoff, gbase, voffB[0], voffB[1])
#define PG8_LDA(dst, b, h) do { _Pragma("unroll") for (int m = 0; m < 4; ++m) _Pragma("unroll") for (int k = 0; k < 2; ++k) dst[m][k] = *(const PG8_LAS bf16x8*)(lds + PG8_SA(b, h) + aoff + m * 2048 + k * 1024); } while (0)
#define PG8_LDB(dst, b, h) do { _Pragma("unroll") for (int n = 0; n < 2; ++n) _Pragma("unroll") for (int k = 0; k < 2; ++k) dst[n][k] = *(const PG8_LAS bf16x8*)(lds + PG8_SB(b, h) + boff + n * 2048 + k * 1024); } while (0)
#define PG8_MMA(ai, bj, At, Bt) do { __builtin_amdgcn_s_setprio(1); _Pragma("unroll") for (int m = 0; m < 4; ++m) _Pragma("unroll") for (int n = 0; n < 2; ++n) _Pragma("unroll") for (int k = 0; k < 2; ++k) \
        acc[ai][bj][m][n] = __builtin_amdgcn_mfma_f32_16x16x32_bf16(Bt[n][k], At[m][k], acc[ai][bj][m][n], 0, 0, 0); __builtin_amdgcn_s_setprio(0); } while (0)
#define PG8_WAIT_V(n) asm volatile("s_waitcnt vmcnt(" #n ")" ::: "memory")
#define PG8_WAIT_L(n) asm volatile("s_waitcnt lgkmcnt(" #n ")" ::: "memory")
#define PG8_BAR __builtin_amdgcn_s_barrier()
#define PG8_SCHED __builtin_amdgcn_sched_barrier(0)
    Unit cur, nxt; int ui = 0;
    if (!S.next(0, cur)) return;
    f32x4 acc[2][2][4][2];
#pragma unroll
    for (int a = 0; a < 2; ++a)
#pragma unroll
        for (int b = 0; b < 2; ++b)
#pragma unroll
            for (int m = 0; m < 4; ++m)
#pragma unroll
                for (int n = 0; n < 2; ++n) acc[a][b][m][n] = (f32x4){0.f, 0.f, 0.f, 0.f};
    bf16x8 At[4][2], B0[2][2], B1[2][2];
    unsigned vA[2][2], vN[2][2];
    const char* cA = S.a_base(cur); const char* cB = S.b_base(cur);
    S.a_offs(cur, RA, CA, vA);
#pragma unroll
    for (int h = 0; h < 2; ++h)
#pragma unroll
        for (int i = 0; i < 2; ++i) vN[h][i] = vA[h][i];
    PG8_STAGEB(PG8_SB(0, 0), cB); PG8_STAGEB(PG8_SB(0, 1), cB + hstep); PG8_STAGE2(PG8_SA(0, 0), cA, vA[0][0], vA[0][1]); PG8_STAGE2(PG8_SA(0, 1), cA, vA[1][0], vA[1][1]);
    if (wr == 1) PG8_BAR;
    PG8_WAIT_V(2); PG8_BAR;
    PG8_STAGEB(PG8_SB(1, 0), cB + kstep); PG8_STAGE2(PG8_SA(1, 0), cA + kstep, vA[0][0], vA[0][1]); PG8_STAGEB(PG8_SB(1, 1), cB + hstep + kstep);
    PG8_WAIT_V(6); PG8_BAR;
    for (;;) {
        const bool has_next = S.next(ui + 1, nxt);
        const char* nA = has_next ? S.a_base(nxt) : cA; const char* nB = has_next ? S.b_base(nxt) : cB;
#pragma nounroll
        for (int t = 0; t < nt; t += 2) {
            const bool last = (t == nt - 2);
            const char* a1 = cA + (size_t)(t + 1) * kstep;
            if (last && has_next) S.a_offs(nxt, RA, CA, vN);
            const char* a2 = last ? nA : cA + (size_t)(t + 2) * kstep; const char* b2 = last ? nB : cB + (size_t)(t + 2) * kstep;
            const char* a3 = a2 + kstep; const char* b3 = b2 + kstep;
            const unsigned u00 = last ? vN[0][0] : vA[0][0], u01 = last ? vN[0][1] : vA[0][1], u10 = last ? vN[1][0] : vA[1][0], u11 = last ? vN[1][1] : vA[1][1];
            PG8_LDB(B0, 0, 0); PG8_LDB(B1, 0, 1); PG8_SCHED; PG8_LDA(At, 0, 0); PG8_STAGE2(PG8_SA(1, 1), a1, vA[1][0], vA[1][1]);
            PG8_WAIT_V(8); PG8_WAIT_L(0); PG8_BAR; PG8_MMA(0, 0, At, B0); PG8_MMA(0, 1, At, B1); PG8_BAR; PG8_SCHED;
            PG8_LDA(At, 0, 1); PG8_STAGEB(PG8_SB(0, 0), b2); PG8_STAGEB(PG8_SB(0, 1), b2 + hstep); PG8_STAGE2(PG8_SA(0, 0), a2, u00, u01);
            PG8_WAIT_V(8); PG8_WAIT_L(0); PG8_BAR; PG8_MMA(1, 0, At, B0); PG8_MMA(1, 1, At, B1); PG8_BAR; PG8_SCHED;
            PG8_LDB(B0, 1, 0); PG8_LDB(B1, 1, 1); PG8_SCHED; PG8_LDA(At, 1, 0); PG8_STAGE2(PG8_SA(0, 1), a2, u10, u11);
            PG8_WAIT_V(8); PG8_WAIT_L(0); PG8_BAR; PG8_MMA(0, 0, At, B0); PG8_MMA(0, 1, At, B1); PG8_BAR; PG8_SCHED;
            PG8_LDA(At, 1, 1); PG8_STAGEB(PG8_SB(1, 0), b3); PG8_STAGEB(PG8_SB(1, 1), b3 + hstep); PG8_STAGE2(PG8_SA(1, 0), a3, u00, u01);
            PG8_WAIT_V(8); PG8_WAIT_L(0); PG8_BAR; PG8_MMA(1, 0, At, B0); PG8_MMA(1, 1, At, B1); PG8_BAR; PG8_SCHED;
        }
        if constexpr (ALIGN_EPI) { if (wr == 0) PG8_BAR; }
        E(acc, cur, wr, wc, fr, fq);
        if (!has_next) break;
#pragma unroll
        for (int a = 0; a < 2; ++a)
#pragma unroll
            for (int b = 0; b < 2; ++b)
#pragma unroll
                for (int m = 0; m < 4; ++m)
#pragma unroll
                    for (int n = 0; n < 2; ++n) acc[a][b][m][n] = (f32x4){0.f, 0.f, 0.f, 0.f};
        cur = nxt; cA = nA; cB = nB; ++ui;
#pragma unroll
        for (int h = 0; h < 2; ++h)
#pragma unroll
            for (int i = 0; i < 2; ++i) vA[h][i] = vN[h][i];
        if constexpr (ALIGN_EPI) { if (wr == 1) PG8_BAR; }
    }
    PG8_WAIT_V(0);
    if constexpr (!ALIGN_EPI) { if (wr == 0) PG8_BAR; }
    PG8_BAR;
#undef PG8_SA
#undef PG8_SB
#undef PG8_STAGE2
#undef PG8_STAGEB
#undef PG8_LDA
#undef PG8_LDB
#undef PG8_MMA
#undef PG8_WAIT_V
#undef PG8_WAIT_L
#undef PG8_BAR
#undef PG8_SCHED
}
}
namespace pg8 {
constexpr int MOD_SZ = DEPTH * BATCH * 6 * D_MODEL;
constexpr int MOD_KS = 8;
__device__ __forceinline__ f32x4 mod4p(const float* modp, const float* ada_b, int layer, int b, int part, int col) {
    const int o = part * D_MODEL + col; const float* p = modp + (size_t)(layer * BATCH + b) * (6 * D_MODEL) + o;
    f32x4 v = *(const f32x4*)(ada_b + layer * (6 * D_MODEL) + o);
#pragma unroll
    for (int ks = 0; ks < MOD_KS; ++ks) v += *(const f32x4*)(p + (size_t)ks * MOD_SZ);
    return v;
}
__device__ __forceinline__ f32x4 mod4(const float* modr, int layer, int b, int part, int col) { return *(const f32x4*)(modr + (size_t)(layer * BATCH + b) * (6 * D_MODEL) + part * D_MODEL + col); }
struct EpiResid {
    static constexpr bool PERM = false;
    const float* xin; float* xout; const float* modr; const float* colscale; int layer, part;
    __device__ __forceinline__ void operator()(const f32x4 (&acc)[2][2][4][2], const Unit& u, int wr, int wc, int fr, int fq) const {
        const int row0 = u.pm * BM + wr * 64 + fr, col0 = u.pn * BM + wc * 32 + 4 * fq, b = (u.pm * BM) / SEQ;
        f32x4 gs[2][2];
#pragma unroll
        for (int bj = 0; bj < 2; ++bj)
#pragma unroll
            for (int n = 0; n < 2; ++n) { const int c = col0 + bj * HALF + n * 16; gs[bj][n] = mod4(modr, layer, b, part, c); if (colscale) gs[bj][n] *= *(const f32x4*)(colscale + c); }
#pragma unroll
        for (int ai = 0; ai < 2; ++ai)
#pragma unroll
            for (int m = 0; m < 4; ++m) { const size_t off = (size_t)(row0 + ai * HALF + m * 16) * D_MODEL + col0;
#pragma unroll
                for (int bj = 0; bj < 2; ++bj)
#pragma unroll
                    for (int n = 0; n < 2; ++n) { const f32x4 xv = *(const f32x4*)(xin + off + bj * HALF + n * 16); *(f32x4*)(xout + off + bj * HALF + n * 16) = xv + gs[bj][n] * acc[ai][bj][m][n]; }
                asm volatile("" ::: "memory"); }
    }
};
struct EpiSwiglu {
    static constexpr bool PERM = true;
    bf16_t* O; int ldo;
    __device__ __forceinline__ void operator()(const f32x4 (&acc)[2][2][4][2], const Unit& u, int wr, int wc, int fr, int fq) const {
        const int row0 = u.pm * BM + wr * 64 + fr, col0 = u.pn * HALF + wc * 32 + 8 * fq;
#pragma unroll
        for (int ai = 0; ai < 2; ++ai)
#pragma unroll
            for (int m = 0; m < 4; ++m) { bf16_t* rowp = O + (size_t)(row0 + ai * HALF + m * 16) * ldo + col0; float v[8];
#pragma unroll
                for (int n = 0; n < 2; ++n)
#pragma unroll
                    for (int j = 0; j < 4; ++j) { const float g = acc[ai][0][m][n][j], uu = acc[ai][1][m][n][j]; v[n * 4 + j] = g * uu * __builtin_amdgcn_rcpf(1.0f + __expf(-g)); }
                u32x4 w; w.x = cvt_pk_bf16(v[0], v[1]); w.y = cvt_pk_bf16(v[2], v[3]); w.z = cvt_pk_bf16(v[4], v[5]); w.w = cvt_pk_bf16(v[6], v[7]);
                *(u32x4*)rowp = w; }
    }
};
struct EpiBf16 {
    static constexpr bool PERM = true;
    bf16_t* O; int ldo;
    __device__ __forceinline__ void operator()(const f32x4 (&acc)[2][2][4][2], const Unit& u, int wr, int wc, int fr, int fq) const {
        const int row0 = u.pm * BM + wr * 64 + fr, col0 = u.pn * BM + wc * 32 + 8 * fq;
#pragma unroll
        for (int ai = 0; ai < 2; ++ai)
#pragma unroll
            for (int m = 0; m < 4; ++m) { bf16_t* rowp = O + (size_t)(row0 + ai * HALF + m * 16) * ldo + col0;
#pragma unroll
                for (int bj = 0; bj < 2; ++bj) { const f32x4 v0 = acc[ai][bj][m][0], v1 = acc[ai][bj][m][1];
                    u32x4 w; w.x = cvt_pk_bf16(v0[0], v0[1]); w.y = cvt_pk_bf16(v0[2], v0[3]); w.z = cvt_pk_bf16(v1[0], v1[1]); w.w = cvt_pk_bf16(v1[2], v1[3]);
                    *(u32x4*)(rowp + bj * HALF) = w; } }
    }
};
constexpr unsigned ROPE_IFB[16] = {0x3f800000u, 0x3ee177bbu, 0x3e4693afu, 0x3daee4adu, 0x3d1a08c8u, 0x3c87a9c2u, 0x3beef74eu, 0x3b52771fu, 0x3ab95d22u, 0x3a23418cu, 0x398fc8f8u, 0x38fd45c2u, 0x385f10c5u, 0x37c47611u, 0x372d07a8u, 0x369864a7u};
struct EpiQKV {
    static constexpr bool PERM = true;
    bf16_t* qkvc; const float* qg; const float* kg; const int* pos; PG8_LAS float* tab;
    __device__ __forceinline__ void operator()(f32x4 (&acc)[2][2][4][2], const Unit& u, int wr, int wc, int fr, int fq) const {
        const int g = u.pn / 12, which = (u.pn % 12) >> 2, hp = u.pn & 3, sh = 2 * g, d = 1 << sh;
        const int b = (u.pm * BM) / SEQ, p0 = (u.pm * BM) % SEQ + wr * 64 + fr;
        if (which < 2) {
            float pf[2][4];
#pragma unroll
            for (int ai = 0; ai < 2; ++ai)
#pragma unroll
                for (int m = 0; m < 4; ++m) pf[ai][m] = (float)pos[b * SEQ + p0 + ai * HALF + m * 16];
            const float* gain = (which == 0 ? qg : kg) + g * HEAD_DIM + wc * 32 + 8 * fq;
            const f32x4 g0 = *(const f32x4*)gain, g1 = *(const f32x4*)(gain + 4);
#pragma unroll
            for (int ai = 0; ai < 2; ++ai)
#pragma unroll
                for (int bj = 0; bj < 2; ++bj)
#pragma unroll
                    for (int m = 0; m < 4; ++m) { const f32x4 a = acc[ai][bj][m][0], c = acc[ai][bj][m][1];
                        float s = (a[0] * a[0] + a[1] * a[1]) + (a[2] * a[2] + a[3] * a[3]) + (c[0] * c[0] + c[1] * c[1]) + (c[2] * c[2] + c[3] * c[3]);
                        s += __shfl_xor(s, 16); s += __shfl_xor(s, 32);
                        if (fq == 0) tab[((((ai * 2 + bj) * 4 + m) * 2 + wr) * 16 + fr) * 4 + wc] = s; }
            asm volatile("s_waitcnt lgkmcnt(0)" ::: "memory"); __builtin_amdgcn_s_barrier(); asm volatile("" ::: "memory");
#pragma unroll
            for (int ai = 0; ai < 2; ++ai)
#pragma unroll
                for (int m = 0; m < 4; ++m) {
#pragma unroll
                    for (int bj = 0; bj < 2; ++bj) { const f32x4 t = *(const PG8_LAS f32x4*)(tab + ((((ai * 2 + bj) * 4 + m) * 2 + wr) * 16 + fr) * 4);
                        const float rstd = rsqrtf(((t[0] + t[1]) + (t[2] + t[3])) * (1.0f / HEAD_DIM) + NORM_EPS);
                        acc[ai][bj][m][0] = acc[ai][bj][m][0] * rstd * g0; acc[ai][bj][m][1] = acc[ai][bj][m][1] * rstd * g1; }
                    const float pfv = pf[ai][m];
                    if (wc == 0) {
                        float cs[8], sn[8];
#pragma unroll
                        for (int q = 0; q < 8; ++q) { const float inv = __uint_as_float((fq & 1) ? ROPE_IFB[8 + q] : ROPE_IFB[q]); const float th = pfv * inv;
                            const float k = rintf(th * 0.15915494309189535f); float r = fmaf(-k, 6.2831854820251465f, th); r = fmaf(-k, -1.7484555e-07f, r); const float x = r * 0.15915494309189535f;
                            cs[q] = __builtin_amdgcn_cosf(x); sn[q] = __builtin_amdgcn_sinf(x); }
#pragma unroll
                        for (int bj = 0; bj < 2; ++bj)
#pragma unroll
                            for (int n = 0; n < 2; ++n) { f32x4 v = acc[ai][bj][m][n], o;
#pragma unroll
                                for (int j = 0; j < 4; ++j) { const float pa = __shfl_xor(v[j], 32); o[j] = (fq < 2) ? v[j] * cs[4 * n + j] - pa * sn[4 * n + j] : v[j] * cs[4 * n + j] + pa * sn[4 * n + j]; }
                                acc[ai][bj][m][n] = o; }
                    }
                }
        }
        bf16_t* base = qkvc + (size_t)(g * 3 + which) * ((size_t)M_TOK * D_MODEL) + wc * 32 + 8 * fq;
        const int Lg = SEQ >> sh;
#pragma unroll
        for (int ai = 0; ai < 2; ++ai)
#pragma unroll
            for (int m = 0; m < 4; ++m) { const int p = p0 + ai * HALF + m * 16, j = p >> sh, r = p & (d - 1);
#pragma unroll
                for (int bj = 0; bj < 2; ++bj) { const int h = 2 * hp + bj; const f32x4 v0 = acc[ai][bj][m][0], v1 = acc[ai][bj][m][1];
                    u32x4 w; w.x = cvt_pk_bf16(v0[0], v0[1]); w.y = cvt_pk_bf16(v0[2], v0[3]); w.z = cvt_pk_bf16(v1[0], v1[1]); w.w = cvt_pk_bf16(v1[2], v1[3]);
                    *(u32x4*)(base + ((size_t)(((b << sh) | r) * NHEAD + h) * Lg + j) * HEAD_DIM) = w; } }
    }
};
}
namespace swa {
constexpr int D = 128;
constexpr float THR = 8.f;
constexpr bool WSKIP = true;
constexpr float SCALE = 0.08838834764831845f;
constexpr int NW = 8, QBLK = 32, KVBLK = 64, QB = NW * QBLK;
constexpr int SHM_V = KVBLK * D * 2, SHM_K = KVBLK * D * 2;
constexpr int LDS_BYTES = 2 * SHM_V + 2 * SHM_K + NW * 64 * 4;
using bf16 = __hip_bfloat16;
typedef short bf16x8 __attribute__((ext_vector_type(8)));
typedef short s16x4 __attribute__((ext_vector_type(4)));
typedef float f32x16 __attribute__((ext_vector_type(16)));
typedef float f32x4 __attribute__((ext_vector_type(4)));
typedef unsigned u32x4 __attribute__((ext_vector_type(4)));
template <class A, class Bt> struct same_t { static constexpr bool v = false; };
template <class A> struct same_t<A, A> { static constexpr bool v = true; };

#define KSWZ(row, colB) ((row) * 256 + ((colB) ^ (((row) & 7) << 4)))
#define SBAR() __builtin_amdgcn_sched_barrier(0)
__device__ __forceinline__ int v_st(int k, int c) { const int kk = (k & ~0xC) | ((k & 4) << 1) | ((k & 8) >> 1); return ((kk >> 3) * 4 + (c >> 5)) * 512 + ((kk & 7) * 32 + (c & 31)) * 2; }
__device__ __forceinline__ int v_rd_base(int lane) { return ((lane & 3) << 3) | (((lane >> 2) & 3) << 6) | (((lane >> 4) & 1) << 5) | (((lane >> 5) & 1) << 8); }
constexpr int v_rd_off(int d0, int ks, int half) { return d0 * 512 + ks * 4096 + half * 2048; }
__device__ __forceinline__ int crow(int r, int hi) { return (r & 3) + 8 * (r >> 2) + 4 * hi; }
__device__ __forceinline__ unsigned cvtpk(float lo, float hi) {
    unsigned r; asm volatile("v_cvt_pk_bf16_f32 %0, %1, %2" : "=v"(r) : "v"(lo), "v"(hi)); return r;
}
__device__ __forceinline__ bf16x8 pack8(f32x4 a, f32x4 b) {
    u32x4 w = {cvtpk(a[0], a[1]), cvtpk(a[2], a[3]), cvtpk(b[0], b[1]), cvtpk(b[2], b[3])};
    return *reinterpret_cast<bf16x8*>(&w);
}
template <class T> __device__ __forceinline__ bf16x8 load8(const T* p) {
    if constexpr (same_t<T, float>::v) { return pack8(*(const f32x4*)p, *(const f32x4*)(p + 4)); }
    else { return *reinterpret_cast<const bf16x8*>(p); }
}
__device__ __forceinline__ void mask_tile(f32x16& p0, f32x16& p1, int dq, unsigned W) {
    const float NEG = -__builtin_inff();
#pragma unroll
    for (int r = 0; r < 16; ++r) {
        const int c = (r & 3) + 8 * (r >> 2);
        if ((unsigned)(dq - c) >= W) p0[r] = NEG;
        if ((unsigned)(dq - c - 32) >= W) p1[r] = NEG;
    }
}
__device__ __forceinline__ void partialSM(f32x16& p0, f32x16& p1, float& m_reg, float& mn, float& alpha) {
    float pmax = p0[0]; for (int r = 1; r < 16; ++r) pmax = fmaxf(pmax, p0[r]); for (int r = 0; r < 16; ++r) pmax = fmaxf(pmax, p1[r]);
    { auto rr = __builtin_amdgcn_permlane32_swap(__float_as_uint(pmax), __float_as_uint(pmax), false, false);
      pmax = fmaxf(__uint_as_float(rr[0]), __uint_as_float(rr[1])); }
    constexpr float C2 = 1.4426950408889634f * SCALE;
    if (__builtin_expect(__all((pmax - m_reg) * SCALE <= THR), 1)) { mn = m_reg; alpha = 1.f; }
    else { mn = fmaxf(m_reg, pmax); alpha = __builtin_amdgcn_exp2f((m_reg - mn) * C2); m_reg = mn; }
    const float mnL = -mn * C2;
    for (int r = 0; r < 16; ++r) p0[r] = fmaf(p0[r], C2, mnL); for (int r = 0; r < 16; ++r) p1[r] = fmaf(p1[r], C2, mnL);
    for (int r = 0; r < 16; ++r) p0[r] = __builtin_amdgcn_exp2f(p0[r]);
}
__device__ __forceinline__ void finishSM(f32x16& p0, f32x16& p1, float alpha, float& l_reg, bf16x8& pa0, bf16x8& pa1, bf16x8& pa2, bf16x8& pa3) {
    for (int r = 0; r < 16; ++r) p1[r] = __builtin_amdgcn_exp2f(p1[r]);
    float ps = 0; for (int r = 0; r < 16; ++r) ps += p0[r]; for (int r = 0; r < 16; ++r) ps += p1[r];
    { auto rr = __builtin_amdgcn_permlane32_swap(__float_as_uint(ps), __float_as_uint(ps), false, false);
      ps = __uint_as_float(rr[0]) + __uint_as_float(rr[1]); }
    l_reg = l_reg * alpha + ps;
#define PK4(P, B_, OUT) do { unsigned a0 = cvtpk(P[B_+0], P[B_+1]), a1 = cvtpk(P[B_+2], P[B_+3]);                          \
        unsigned b0 = cvtpk(P[B_+4], P[B_+5]), b1 = cvtpk(P[B_+6], P[B_+7]);                                             \
        auto r0 = __builtin_amdgcn_permlane32_swap(a0, b0, false, false); auto r1 = __builtin_amdgcn_permlane32_swap(a1, b1, false, false); \
        u32x4 w = {r0[0], r1[0], r0[1], r1[1]}; OUT = *reinterpret_cast<bf16x8*>(&w); } while (0)
    PK4(p0, 0, pa0); PK4(p0, 8, pa1); PK4(p1, 0, pa2); PK4(p1, 8, pa3);
#undef PK4
}
template <int KB, bool SK>
__device__ __forceinline__ void qkt(f32x16& p0, f32x16& p1, const char* K_lds, int r32, int hi, const bf16x8* qr, bool act) {
    if (SK && !act) { const float NEG = -__builtin_inff();
#pragma unroll
        for (int r = 0; r < 16; ++r) { p0[r] = NEG; p1[r] = NEG; } return; }
    p0 = f32x16{}; p1 = f32x16{};
    const char* kb[4];
#pragma unroll
    for (int dd = 0; dd < 4; ++dd) kb[dd] = K_lds + KB * SHM_K + KSWZ(r32, (dd * 16 + hi * 8) * 2);
#pragma unroll
    for (int d0 = 0; d0 < 8; ++d0) { const char* a = kb[d0 & 3] + (d0 >> 2) * 128;
        bf16x8 b0 = *reinterpret_cast<const bf16x8*>(a);
        bf16x8 b1 = *reinterpret_cast<const bf16x8*>(a + 32 * 256);
        p0 = __builtin_amdgcn_mfma_f32_32x32x16_bf16(b0, qr[d0], p0, 0, 0, 0);
        p1 = __builtin_amdgcn_mfma_f32_32x32x16_bf16(b1, qr[d0], p1, 0, 0, 0); }
}
template <int VB, bool SK>
__device__ __forceinline__ void pv_tile(f32x16* o, int vb0, bf16x8 pa0, bf16x8 pa1, bf16x8 pa2, bf16x8 pa3, bool act) {
    if (SK && !act) return;
#define TRRD(dst, off) asm volatile("ds_read_b64_tr_b16 %0, %1 offset:%2" : "=&v"(dst) : "v"(vb0), "i"(off) : "memory")
#define PV_D0(d0) do { s16x4 l0, l1, l2, l3, h0, h1, h2, h3; constexpr int b_ = VB * SHM_V + v_rd_off(d0, 0, 0);     \
        TRRD(l0, b_); TRRD(h0, b_ + 2048); TRRD(l1, b_ + 4096); TRRD(h1, b_ + 6144); TRRD(l2, b_ + 8192); TRRD(h2, b_ + 10240); TRRD(l3, b_ + 12288); TRRD(h3, b_ + 14336); \
        asm volatile("s_waitcnt lgkmcnt(0)" ::: "memory"); SBAR();                 \
        o[d0] = __builtin_amdgcn_mfma_f32_32x32x16_bf16(pa0, (bf16x8){l0[0], l0[1], l0[2], l0[3], h0[0], h0[1], h0[2], h0[3]}, o[d0], 0, 0, 0);   \
        o[d0] = __builtin_amdgcn_mfma_f32_32x32x16_bf16(pa1, (bf16x8){l1[0], l1[1], l1[2], l1[3], h1[0], h1[1], h1[2], h1[3]}, o[d0], 0, 0, 0);   \
        o[d0] = __builtin_amdgcn_mfma_f32_32x32x16_bf16(pa2, (bf16x8){l2[0], l2[1], l2[2], l2[3], h2[0], h2[1], h2[2], h2[3]}, o[d0], 0, 0, 0);   \
        o[d0] = __builtin_amdgcn_mfma_f32_32x32x16_bf16(pa3, (bf16x8){l3[0], l3[1], l3[2], l3[3], h3[0], h3[1], h3[2], h3[3]}, o[d0], 0, 0, 0); } while (0)
    PV_D0(0); PV_D0(1); PV_D0(2); PV_D0(3);
#undef PV_D0
#undef TRRD
}

template <class TIn, class TOut> struct BlockRef { const TIn* Q; const TIn* K; const TIn* V; TOut* O; int P0; };
template <class TIn> struct Seam {
    bf16x8 qr[8];
    bf16x8 st_v0, st_v1, st_k0, st_k1; f32x4 sf0, sf1, sf2, sf3;
    f32x4 tq[16];
};
__device__ __forceinline__ int swa_jlo(int P0, int W) { const int lowk = P0 - W + 1; return lowk > 0 ? lowk / KVBLK : 0; }
#define ROW(p, k0, rr) ((p) + (size_t)((k0) + (rr)) * D + sc)
#define VMW() asm volatile("s_waitcnt vmcnt(0)" ::: "memory")
#define VMWN(n) asm volatile("s_waitcnt vmcnt(%0)" :: "i"(n) : "memory")
#define SLOAD_H(Kp, Vp, k0) do { S.st_v0 = load8<TIn>(ROW(Vp, k0, sr)); S.st_v1 = load8<TIn>(ROW(Vp, k0, 32 + sr));              \
                         S.st_k0 = load8<TIn>(ROW(Kp, k0, sr)); S.st_k1 = load8<TIn>(ROW(Kp, k0, 32 + sr)); } while (0)
#define SWRITE_HK(bf) do { *(bf16x8*)(K_lds + (bf) * SHM_K + kws) = S.st_k0; *(bf16x8*)(K_lds + (bf) * SHM_K + kws + 32 * 256) = S.st_k1; } while (0)
#define SWRITE_HV(bf) do { *(bf16x8*)(V_lds + (bf) * SHM_V + vst0) = S.st_v0; *(bf16x8*)(V_lds + (bf) * SHM_V + vst1) = S.st_v1; } while (0)
#define SWRITE_H(bf) do { SWRITE_HV(bf); SWRITE_HK(bf); } while (0)
#define SLOAD_F(p, k0) do { S.sf0 = *(const f32x4*)ROW(p, k0, sr); S.sf1 = *(const f32x4*)(ROW(p, k0, sr) + 4);                \
                            S.sf2 = *(const f32x4*)ROW(p, k0, 32 + sr); S.sf3 = *(const f32x4*)(ROW(p, k0, 32 + sr) + 4); } while (0)
#define SWRITE_KF(bf) do { *(bf16x8*)(K_lds + (bf) * SHM_K + kws) = pack8(S.sf0, S.sf1); *(bf16x8*)(K_lds + (bf) * SHM_K + kws + 32 * 256) = pack8(S.sf2, S.sf3); } while (0)
#define SWRITE_VF(bf) do { *(bf16x8*)(V_lds + (bf) * SHM_V + vst0) = pack8(S.sf0, S.sf1); *(bf16x8*)(V_lds + (bf) * SHM_V + vst1) = pack8(S.sf2, S.sf3); } while (0)
template <class TIn, class TOut>
__device__ __forceinline__ void causal_swa_prime(const BlockRef<TIn, TOut>& cur, int W, char* lds, Seam<TIn>& S) {
    constexpr bool F32 = same_t<TIn, float>::v;
    int tid = threadIdx.x; asm volatile("" : "+v"(tid));
    const int wid = __builtin_amdgcn_readfirstlane(tid >> 6), lane = tid & 63, r32 = lane & 31, hi = lane >> 5;
    const int sr = tid >> 4, sc = (tid & 15) * 8, kws = KSWZ(sr, sc * 2); char* K_lds = lds + 2 * SHM_V;
    const int kb0 = swa_jlo(cur.P0, W) * KVBLK;
    for (int d0 = 0; d0 < 8; ++d0) S.qr[d0] = load8<TIn>(cur.Q + (size_t)(wid * QBLK + r32) * D + d0 * 16 + hi * 8);
    if constexpr (F32) { SLOAD_F((const float*)cur.K, kb0); VMW(); SWRITE_KF(0); SBAR(); SLOAD_F((const float*)cur.V, kb0); }
    else { SLOAD_H(cur.K, cur.V, kb0); VMW(); SWRITE_HK(0); }
    __syncthreads();
}
template <class TIn, class TOut>
__device__ __forceinline__ void causal_swa_block(const BlockRef<TIn, TOut>& cur, const BlockRef<TIn, TOut>& nxt, int skv, int W, char* lds, Seam<TIn>& S, const char* og_base, char* lse_base) {
    constexpr bool F32 = same_t<TIn, float>::v;
    int tid = threadIdx.x; asm volatile("" : "+v"(tid));
    const int wid = __builtin_amdgcn_readfirstlane(tid >> 6), lane = tid & 63, r32 = lane & 31, hi = lane >> 5;
    const int j_lo = swa_jlo(cur.P0, W);
    int j_hi = (cur.P0 + QB - 1) / KVBLK + 1; if (j_hi > skv / KVBLK) j_hi = skv / KVBLK;
    const int NT = j_hi - j_lo;
    const int kbn = swa_jlo(nxt.P0, W) * KVBLK;
    const int qlo = cur.P0 + wid * QBLK, qm = qlo + r32 - 4 * hi;
    char* V_lds = lds; char* K_lds = lds + 2 * SHM_V;
    float* ws = (float*)(lds + 2 * SHM_V + 2 * SHM_K) + wid * 64; float* li_l = ws, * al_l = ws + 32;
    float m_reg = -1e30f, l_reg = 0; f32x16 o[4] = {};
    const int sr = tid >> 4, sc = (tid & 15) * 8, vst0 = v_st(sr, sc), vst1 = v_st(32 + sr, sc), kws = KSWZ(sr, sc * 2);
    const int vb0 = (int)(uintptr_t)V_lds + v_rd_base(lane);
    const TIn* Kh = cur.K; const TIn* Vh = cur.V;
#define RESC(a) do { if (__any((a) < 1.f)) { if (hi == 0) al_l[r32] = (a); asm volatile("s_waitcnt lgkmcnt(0)" ::: "memory");              \
                     for (int d_ = 0; d_ < 4; ++d_) for (int r = 0; r < 16; ++r) o[d_][r] *= al_l[crow(r, hi)]; } } while (0)
#define KBASE(t) ((j_lo + (t)) * KVBLK)
#define ACT(t) (KBASE(t) <= qlo + QBLK - 1 && KBASE(t) + KVBLK - 1 >= qlo - W + 1)
#define MASKT(P0_, P1_, t) do { const int kb_ = KBASE(t); if ((!SK || ACT(t)) && (kb_ + KVBLK - 1 > qlo || kb_ <= qlo + QBLK - 1 - W)) mask_tile(P0_, P1_, qm - kb_, (unsigned)W); } while (0)
    constexpr int NQL = F32 ? 16 : 8;
    constexpr bool SK = WSKIP && !F32;
#define SEAM_K0() do { VMWN(NQL); if constexpr (F32) { SWRITE_KF(0); SBAR(); SLOAD_F((const float*)nxt.V, kbn); } else { SWRITE_HK(0); } SBAR(); } while (0)
    f32x16 pA0, pA1, pB0, pB1; float mnA, mnB, alA, alB; bf16x8 pa0, pa1, pa2, pa3;
    if constexpr (F32) { VMW(); SWRITE_VF(0); SBAR(); } else { SWRITE_HV(0); SBAR(); }
    if (NT > 1) { if constexpr (F32) SLOAD_F((const float*)Kh, KBASE(1)); else SLOAD_H(Kh, Vh, KBASE(1)); }
    SBAR(); qkt<0, SK>(pA0, pA1, K_lds, r32, hi, S.qr, ACT(0));
    if constexpr (F32) { if (NT > 1) { VMW(); SWRITE_KF(1); SBAR(); SLOAD_F((const float*)Vh, KBASE(1)); } }
    MASKT(pA0, pA1, 0); partialSM(pA0, pA1, m_reg, mnA, alA);
    if (NT > 1) { VMW(); if constexpr (F32) { SWRITE_VF(1); SBAR(); if (NT > 2) SLOAD_F((const float*)Kh, KBASE(2)); } else SWRITE_H(1); }
    __syncthreads();
#define HALF_STEP(PX0, PX1, mnX, alX, PY0, PY1, alY, t, KB, VB, SB) do {                                                      \
        SBAR(); qkt<KB, SK>(PX0, PX1, K_lds, r32, hi, S.qr, ACT(t));                                             \
        finishSM(PY0, PY1, alY, l_reg, pa0, pa1, pa2, pa3); SBAR();                                                           \
        if ((t) + 1 < NT) { if constexpr (F32) { VMW(); SWRITE_KF(SB); SBAR(); SLOAD_F((const float*)Vh, KBASE((t) + 1)); }  \
                            else { SLOAD_H(Kh, Vh, KBASE((t) + 1)); } SBAR(); }                                               \
        pv_tile<VB, SK>(o, vb0, pa0, pa1, pa2, pa3, ACT((t) - 1)); MASKT(PX0, PX1, (t)); partialSM(PX0, PX1, m_reg, mnX, alX);                                        \
        __syncthreads();                                                                                                      \
        if ((t) + 1 < NT) { VMW(); if constexpr (F32) { SWRITE_VF(SB); SBAR(); if ((t) + 2 < NT) SLOAD_F((const float*)Kh, KBASE((t) + 2)); } \
                            else { SWRITE_H(SB); } }                                                                          \
        RESC(alX); __syncthreads(); } while (0)
    for (int t = 1; t + 1 < NT; t += 2) {
        HALF_STEP(pB0, pB1, mnB, alB, pA0, pA1, alA, t, 1, 0, 0);
        HALF_STEP(pA0, pA1, mnA, alA, pB0, pB1, alB, t + 1, 0, 1, 1);
    }
    const bool even = (NT & 1) == 0;
    if (even) { SBAR(); qkt<1, SK>(pB0, pB1, K_lds, r32, hi, S.qr, ACT(NT - 1)); SBAR(); }
#define QROW(e) (nxt.Q + (size_t)(wid * QBLK + r32) * D + ((e) >> 1) * 16 + hi * 8 + ((e) & 1) * 4)
    if constexpr (F32) { SLOAD_F((const float*)nxt.K, kbn); SBAR();
#pragma unroll
        for (int e = 0; e < 8; ++e) S.tq[e] = *(const f32x4*)QROW(e); }
    else { SLOAD_H(nxt.K, nxt.V, kbn); SBAR();
#pragma unroll
        for (int d0 = 0; d0 < 8; ++d0) S.qr[d0] = load8<TIn>(nxt.Q + (size_t)(wid * QBLK + r32) * D + d0 * 16 + hi * 8); }
    SBAR();
    finishSM(pA0, pA1, alA, l_reg, pa0, pa1, pa2, pa3); SBAR();
    if constexpr (F32) {
#pragma unroll
        for (int e = 8; e < 16; ++e) S.tq[e] = *(const f32x4*)QROW(e); SBAR(); }
#undef QROW
    pv_tile<0, SK>(o, vb0, pa0, pa1, pa2, pa3, ACT(even ? NT - 2 : NT - 1));
    if (even) { MASKT(pB0, pB1, NT - 1); partialSM(pB0, pB1, m_reg, mnB, alB); __syncthreads(); RESC(alB);
        finishSM(pB0, pB1, alB, l_reg, pa0, pa1, pa2, pa3); SBAR(); pv_tile<1, SK>(o, vb0, pa0, pa1, pa2, pa3, ACT(NT - 1)); }
    SBAR(); SEAM_K0();
    if (hi == 0) { li_l[r32] = l_reg; ((float*)(lse_base + (((const char*)cur.O - og_base) >> 6)))[wid * QBLK + r32] = m_reg * SCALE + __logf(l_reg); } asm volatile("s_waitcnt lgkmcnt(0)" ::: "memory");
    float rli[16];
#pragma unroll
    for (int r = 0; r < 16; ++r) rli[r] = __builtin_amdgcn_rcpf(li_l[crow(r, hi)]);
    TOut* Ow = cur.O + (size_t)(wid * QBLK) * D;
#pragma unroll
    for (int r = 0; r < 16; ++r) { const int orow = crow(r, hi);
#pragma unroll
        for (int d0 = 0; d0 < 4; ++d0) { const float v = o[d0][r] * rli[r];
            if constexpr (same_t<TOut, float>::v) { Ow[(size_t)orow * D + d0 * 32 + r32] = v; }
            else { const float vn = __shfl_xor(v, 1);
                   if ((r32 & 1) == 0) *(unsigned*)(Ow + (size_t)orow * D + d0 * 32 + r32) = cvtpk(v, vn); } } }
    if constexpr (F32) {
#pragma unroll
        for (int d0 = 0; d0 < 8; ++d0) S.qr[d0] = pack8(S.tq[2 * d0], S.tq[2 * d0 + 1]); }
    __syncthreads();
#undef RESC
#undef KBASE
#undef ACT
#undef MASKT
#undef SEAM_K0
#undef HALF_STEP
}
#undef ROW
#undef VMW
#undef VMWN
#undef SLOAD_H
#undef SWRITE_HK
#undef SWRITE_HV
#undef SWRITE_H
#undef SLOAD_F
#undef SWRITE_KF
#undef SWRITE_VF


}
constexpr int NWAVES = 8;
#ifndef MK_PER_PHASE
#define MK_PER_PHASE 0
#endif
constexpr int PH_PER_PAIR = 14, NPHASES = 2 + 2 * PH_PER_PAIR;

constexpr size_t MiB = 1u << 20;
constexpr size_t WS_CTL = 0, CTL_ZERO_BYTES = 1 * MiB;
constexpr size_t WS_MODP = 1 * MiB;
constexpr size_t WS_MODR = 4 * MiB;
constexpr size_t WS_EIDX = 7 * MiB, WS_GATE = 7 * MiB + 256 * 1024, WS_SLOTOF = 7 * MiB + 512 * 1024, WS_STOK = 8 * MiB;
constexpr size_t WS_LSE = 9 * MiB;
constexpr size_t WS_WQKV = 16 * MiB, WS_WO = 52 * MiB, WS_WGU = 56 * MiB, WS_WDN = 78 * MiB, WS_WPOOL = 89 * MiB, WS_WMGU = 90 * MiB, WS_WMDN = 314 * MiB;
constexpr size_t WS_XB = 432 * MiB;
constexpr size_t WS_H = 560 * MiB;
constexpr size_t WS_BIG = 624 * MiB;
constexpr size_t WS_QKVC = WS_BIG, WS_OG = WS_BIG + 576 * MiB;
constexpr size_t WS_ACT = WS_BIG;
constexpr size_t WS_Y = WS_BIG + 480 * MiB;
constexpr size_t WS_END = WS_BIG + 768 * MiB;
constexpr int MAX_TILES = 2 * M_TOK / 256 + N_EXP, MAX_SLOTS = MAX_TILES * 256;
static_assert(WS_ACT + (size_t)MAX_SLOTS * D_FFE * 2 <= WS_Y && WS_Y + (size_t)MAX_SLOTS * D_MODEL * 2 <= WS_END && WS_STOK + (size_t)MAX_SLOTS * 4 <= WS_LSE, "d_ws map");
constexpr int CW_BAR = 4096;
constexpr int CW_CNT = 8192, CW_CUR = 12288;

constexpr int RING_OFF = 0, RING_BYTES = 131072;
constexpr int TAB_OFF = RING_BYTES;
constexpr int MISC_OFF = TAB_OFF + 8192;
constexpr int LDS_BYTES = 147456;
static_assert(MISC_OFF + 128 <= LDS_BYTES, "LDS map");

#define GAS __attribute__((address_space(1)))
#define LAS __attribute__((address_space(3)))
typedef unsigned short bf16;
typedef unsigned v4u __attribute__((ext_vector_type(4)));
typedef unsigned v2u __attribute__((ext_vector_type(2)));
typedef int v2i __attribute__((ext_vector_type(2)));
typedef float f32x4 __attribute__((ext_vector_type(4)));
typedef float f32x2 __attribute__((ext_vector_type(2)));
#define LDS_WAIT() asm volatile("s_waitcnt lgkmcnt(0)" ::: "memory")
#define VM_WAIT() asm volatile("s_waitcnt vmcnt(0)" ::: "memory")
__device__ __forceinline__ unsigned pk2(float lo, float hi) { return pg8::cvt_pk_bf16(lo, hi); }
__device__ __forceinline__ float bflo(unsigned w) { return __uint_as_float(w << 16); }
__device__ __forceinline__ float bfhi(unsigned w) { return __uint_as_float(w & 0xffff0000u); }
__device__ __forceinline__ float wave_sum(float v) {
#pragma unroll
    for (int o = 1; o < 64; o <<= 1) v += __shfl_xor(v, o);
    return v;
}
__device__ __forceinline__ int rdlane_i(int v, int l) { return __builtin_amdgcn_readlane(v, l); }
__device__ __forceinline__ float rdlane_f(float v, int l) { return __uint_as_float((unsigned)__builtin_amdgcn_readlane((int)__float_as_uint(v), l)); }

#define XB_TMO      128
#define XB_XCNT(j)  (256  + 64 * (j))
#define XB_XSUB(j)  (1280 + 64 * (j))
#define XB_XGEN(j)  (2304 + 64 * (j))
#define XB_TOP      3328
#define XB_TOPGEN   3392
#define XCD_BAR_WORDS 3456
#define XB_SPIN_CAP (1u << 18)

__device__ __forceinline__ unsigned xb_ld(unsigned* p)              { return __hip_atomic_load(p, __ATOMIC_RELAXED, __HIP_MEMORY_SCOPE_AGENT); }
__device__ __forceinline__ unsigned xb_add(unsigned* p, unsigned v) { return __hip_atomic_fetch_add(p, v, __ATOMIC_RELAXED, __HIP_MEMORY_SCOPE_AGENT); }
__device__ __forceinline__ unsigned xb_xcc_id() { return (unsigned)__builtin_amdgcn_s_getreg((3 << 11) | 20) & 0xFu; }
#define XB_SPIN(cond, bar) do { unsigned _sp = 0; while (cond) { __builtin_amdgcn_s_sleep(1); \
    if ((++_sp & 255u) == 0u) { if (xb_ld(&(bar)[XB_TMO])) break; if (_sp > XB_SPIN_CAP) { atomicAdd(&(bar)[XB_TMO], 1u); break; } } } } while (0)

struct XcdBarrier {
    unsigned* bar; unsigned x;
    volatile LAS unsigned* st;
};

__device__ __forceinline__ XcdBarrier xcd_barrier_post(unsigned* bar, volatile LAS unsigned* st) {
    XcdBarrier b; b.bar = bar; b.x = xb_xcc_id(); b.st = st;
    if (threadIdx.x == 0) (void)xb_add(&bar[XB_XCNT(b.x)], 1u);
    return b;
}
__device__ __forceinline__ void xcd_barrier_complete(unsigned* bar, unsigned x, unsigned& nloc, unsigned& nx) {
    const unsigned G = gridDim.x * gridDim.y * gridDim.z;
    unsigned sum, cnt, mine, sp = 0u;
    for (;;) {
        sum = 0u; cnt = 0u; mine = 0u;
#pragma unroll
        for (unsigned j = 0; j < 16; ++j) { const unsigned c = xb_ld(&bar[XB_XCNT(j)]); sum += c; cnt += (c > 0u) ? 1u : 0u; mine = (j == x) ? c : mine; }
        if (sum == G) break;
        __builtin_amdgcn_s_sleep(1);
        if ((++sp & 255u) == 0u) { if (xb_ld(&bar[XB_TMO])) break; if (sp > XB_SPIN_CAP) { atomicAdd(&bar[XB_TMO], 1u); break; } }
    }
    nloc = mine > 0u ? mine : 1u; nx = cnt > 0u ? cnt : 1u;
}

__device__ __forceinline__ void xcd_barrier(const XcdBarrier& b) {
    asm volatile("s_waitcnt vmcnt(0)" ::: "memory");
    __syncthreads();
    if (threadIdx.x == 0) {
        unsigned* bar = b.bar;
        __builtin_amdgcn_s_waitcnt(0);
        unsigned nloc = b.st[0], nx = b.st[1];
        if (nloc == 0u) { xcd_barrier_complete(bar, b.x, nloc, nx); b.st[0] = nloc; b.st[1] = nx; }
        const unsigned old = xb_add(&bar[XB_XSUB(b.x)], 1u);
        const unsigned gen = old / nloc;
        if (old + 1u == (gen + 1u) * nloc) {
            __builtin_amdgcn_fence(__ATOMIC_RELEASE, "agent");
            asm volatile("s_waitcnt vmcnt(0)" ::: "memory");
            const unsigned og = xb_add(&bar[XB_TOP], 1u);
            const unsigned tg = og / nx;
            if (og + 1u == (tg + 1u) * nx) xb_add(&bar[XB_TOPGEN], 1u);
            else XB_SPIN(xb_ld(&bar[XB_TOPGEN]) == tg, bar);
            __builtin_amdgcn_fence(__ATOMIC_ACQUIRE, "agent");
            xb_add(&bar[XB_XGEN(b.x)], 1u);
            asm volatile("s_waitcnt vmcnt(0)" ::: "memory");
        } else {
            XB_SPIN(xb_ld(&bar[XB_XGEN(b.x)]) == gen, bar);
            __builtin_amdgcn_fence(__ATOMIC_ACQUIRE, "agent");
            asm volatile("s_waitcnt vmcnt(0)" ::: "memory");
        }
    }
    __syncthreads();
}
using pg8::mod4; using pg8::mod4p;
__device__ __forceinline__ int gu_row(int n0, int F) { return n0 < F ? (n0 >> 7) * 256 + (n0 & 127) : ((n0 - F) >> 7) * 256 + 128 + ((n0 - F) & 127); }
struct TrItem { const float* W; bf16* WT; int N, Kd; };
__device__ __forceinline__ void tr_load(const TrItem& t, int lane, f32x4 (&r)[8]) {
    const float* p = t.W + (size_t)(lane >> 3) * t.N + 4 * (lane & 7);
#pragma unroll
    for (int i = 0; i < 8; ++i) r[i] = *(const GAS f32x4*)(p + (size_t)(8 * i) * t.N);
}
__device__ __forceinline__ void tr_store(const TrItem& t, int lane, const f32x4 (&r)[8], LAS float* scr) {
    LAS float* w = scr + (lane >> 3) * 33 + 4 * (lane & 7);
#pragma unroll
    for (int i = 0; i < 8; ++i) { LAS float* q = w + (8 * i) * 33; q[0] = r[i].x; q[1] = r[i].y; q[2] = r[i].z; q[3] = r[i].w; }
    LDS_WAIT(); asm volatile("" ::: "memory");
    const int c = lane & 7;
#pragma unroll
    for (int j = 0; j < 4; ++j) { const int n = (lane >> 3) + 8 * j; const LAS float* s = scr + (8 * c) * 33 + n;
        v4u o; o.x = pk2(s[0 * 33], s[1 * 33]); o.y = pk2(s[2 * 33], s[3 * 33]); o.z = pk2(s[4 * 33], s[5 * 33]); o.w = pk2(s[6 * 33], s[7 * 33]);
        *(GAS v4u*)(t.WT + (size_t)n * t.Kd + 8 * c) = o; }
    LDS_WAIT(); asm volatile("" ::: "memory");
}
struct ProIn { const float *c, *ada_w, *pool_w, *wqkv, *wo, *wgu, *wdn, *mgu, *mdn; const int* pos; };
constexpr int TI_QKV = 2 * 16 * 288, TI_WO = 2 * 16 * 32, TI_GU = 2 * 16 * 176, TI_DN = 2 * 44 * 32, TI_POOL = 8 * 4 * 8, TI_MGU = 16 * 16 * 224, TI_MDN = 16 * 56 * 32;
constexpr int TI_ALL = TI_QKV + TI_WO + TI_GU + TI_DN + TI_POOL + TI_MGU + TI_MDN;
__device__ __forceinline__ TrItem tr_decode(const ProIn& I, unsigned char* ws, int it) {
    const float* W; bf16* WT; int K, N, nblk, r; bool gu = false; int F = 0;
    if (it < TI_QKV) { const int j = it / (16 * 288); r = it % (16 * 288); K = 1024; N = QKV_W; nblk = 288; W = I.wqkv + (size_t)j * 1024 * QKV_W; WT = (bf16*)(ws + WS_WQKV) + (size_t)j * QKV_W * 1024; }
    else { it -= TI_QKV;
    if (it < TI_WO) { const int j = it / 512; r = it % 512; K = 1024; N = 1024; nblk = 32; W = I.wo + (size_t)j * 1024 * 1024; WT = (bf16*)(ws + WS_WO) + (size_t)j * 1024 * 1024; }
    else { it -= TI_WO;
    if (it < TI_GU) { const int j = it / (16 * 176); r = it % (16 * 176); K = 1024; N = 2 * D_FF; nblk = 176; gu = true; F = D_FF; W = I.wgu + (size_t)j * 1024 * 2 * D_FF; WT = (bf16*)(ws + WS_WGU) + (size_t)j * 2 * D_FF * 1024; }
    else { it -= TI_GU;
    if (it < TI_DN) { const int j = it / (44 * 32); r = it % (44 * 32); K = D_FF; N = 1024; nblk = 32; W = I.wdn + (size_t)j * D_FF * 1024; WT = (bf16*)(ws + WS_WDN) + (size_t)j * 1024 * D_FF; }
    else { it -= TI_DN;
    if (it < TI_POOL) { const int jg = it / 32; r = it % 32; K = 256; N = 256; nblk = 8; W = I.pool_w + (size_t)jg * 65536; WT = (bf16*)(ws + WS_WPOOL) + (size_t)jg * 65536; }
    else { it -= TI_POOL;
    if (it < TI_MGU) { const int je = it / (16 * 224); r = it % (16 * 224); K = 1024; N = 2 * D_FFE; nblk = 224; gu = true; F = D_FFE; W = I.mgu + (size_t)je * 1024 * 2 * D_FFE; WT = (bf16*)(ws + WS_WMGU) + (size_t)je * 2 * D_FFE * 1024; }
    else { it -= TI_MGU;
    { const int je = it / (56 * 32); r = it % (56 * 32); K = D_FFE; N = 1024; nblk = 32; W = I.mdn + (size_t)je * D_FFE * 1024; WT = (bf16*)(ws + WS_WMDN) + (size_t)je * 1024 * D_FFE; } } } } } } }
    const int kb = r / nblk, nb = r % nblk, k0 = 64 * kb, n0 = 32 * nb, drow = gu ? gu_row(n0, F) : n0;
    TrItem t; t.W = W + (size_t)k0 * N + n0; t.WT = WT + (size_t)drow * K + k0; t.N = N; t.Kd = K; return t;
}
__device__ __forceinline__ void p0_prologue(const ProIn& I, unsigned char* ws, LAS unsigned char* lds, int gw, int NGW, int wave, int lane) {
    LAS float* scr = (LAS float*)(lds + RING_OFF + wave * 16384);
#ifndef PRO_RPT_A
#define PRO_RPT_A 1
#endif
#ifndef PRO_RPT_C
#define PRO_RPT_C 1
#endif
    for (int rpa = 0; rpa < PRO_RPT_A; ++rpa)
    for (int it = gw; it < DEPTH * 24 * pg8::MOD_KS; it += NGW) {
        const int layer = it / (24 * pg8::MOD_KS), rem = it % (24 * pg8::MOD_KS), chunk = rem / pg8::MOD_KS, ks = rem % pg8::MOD_KS, kb = ks * 128;
#pragma unroll
        for (int q = 0; q < 8; ++q) { const int idx = lane + 64 * q, b = idx >> 7, k = idx & 127; const float cv = I.c[b * D_MODEL + kb + k]; scr[idx] = cv / (1.0f + __expf(-cv)); }
        LDS_WAIT(); asm volatile("" ::: "memory");
        const float* wp = I.ada_w + ((size_t)layer * D_MODEL + kb) * (6 * D_MODEL) + chunk * 256 + 4 * lane;
        f32x4 a0 = {0.f, 0.f, 0.f, 0.f}, a1 = a0, a2 = a0, a3 = a0;
#pragma nounroll
        for (int k = 0; k < 128; k += 16) {
            f32x4 w[16];
#pragma unroll
            for (int j = 0; j < 16; ++j) w[j] = *(const GAS f32x4*)(wp + (size_t)(k + j) * (6 * D_MODEL));
#pragma unroll
            for (int g4 = 0; g4 < 4; ++g4) {
                const f32x4 c0 = *(const LAS f32x4*)(scr + k + 4 * g4), c1 = *(const LAS f32x4*)(scr + 128 + k + 4 * g4), c2 = *(const LAS f32x4*)(scr + 256 + k + 4 * g4), c3 = *(const LAS f32x4*)(scr + 384 + k + 4 * g4);
                const f32x4 w0 = w[4 * g4], w1 = w[4 * g4 + 1], w2 = w[4 * g4 + 2], w3 = w[4 * g4 + 3];
                a0 += w0 * c0.x + w1 * c0.y + w2 * c0.z + w3 * c0.w; a1 += w0 * c1.x + w1 * c1.y + w2 * c1.z + w3 * c1.w;
                a2 += w0 * c2.x + w1 * c2.y + w2 * c2.z + w3 * c2.w; a3 += w0 * c3.x + w1 * c3.y + w2 * c3.z + w3 * c3.w;
            }
        }
        float* mp = (float*)(ws + WS_MODP) + (size_t)ks * pg8::MOD_SZ + (size_t)(layer * BATCH) * (6 * D_MODEL) + chunk * 256 + 4 * lane;
        *(f32x4*)(mp) = a0; *(f32x4*)(mp + 6 * D_MODEL) = a1; *(f32x4*)(mp + 12 * D_MODEL) = a2; *(f32x4*)(mp + 18 * D_MODEL) = a3;
        LDS_WAIT(); asm volatile("" ::: "memory");
    }
    for (int rpc = 0; rpc < PRO_RPT_C; ++rpc) {
        f32x4 ra[8], rb[8]; TrItem ta, tb;
        int it = gw;
        if (it < TI_ALL) {
            ta = tr_decode(I, ws, it); tr_load(ta, lane, ra);
            for (;;) {
                const int itb = it + NGW; tb = tr_decode(I, ws, itb < TI_ALL ? itb : it); tr_load(tb, lane, rb);
                tr_store(ta, lane, ra, scr);
                if (itb >= TI_ALL) break;
                const int itc = itb + NGW; ta = tr_decode(I, ws, itc < TI_ALL ? itc : itb); tr_load(ta, lane, ra);
                tr_store(tb, lane, rb, scr);
                if (itc >= TI_ALL) break;
                it = itc;
            }
        }
    }
}

__device__ __forceinline__ void ld_row(const float* p, int lane, f32x4 (&v)[4]) {
#pragma unroll
    for (int j = 0; j < 4; ++j) v[j] = *(const GAS f32x4*)(p + 4 * lane + 256 * j); }
__device__ __forceinline__ void ld_yrow(const bf16* p, int lane, v2u (&y)[4]) {
#pragma unroll
    for (int j = 0; j < 4; ++j) y[j] = *(const GAS v2u*)(p + 4 * lane + 256 * j); }
__device__ __forceinline__ f32x4 y4(v2u a) { return (f32x4){bflo(a.x), bfhi(a.x), bflo(a.y), bfhi(a.y)}; }
__device__ __forceinline__ float row_rstd(const f32x4 (&v)[4]) {
    float s = 0.f;
#pragma unroll
    for (int j = 0; j < 4; ++j) s += (v[j].x * v[j].x + v[j].y * v[j].y) + (v[j].z * v[j].z + v[j].w * v[j].w);
    return rsqrtf(wave_sum(s) * (1.0f / D_MODEL) + NORM_EPS);
}
__device__ __forceinline__ void st_row_bf16(bf16* p, int lane, const f32x4 (&h)[4]) {
#pragma unroll
    for (int j = 0; j < 4; ++j) { v2u o; o.x = pk2(h[j].x, h[j].y); o.y = pk2(h[j].z, h[j].w); *(GAS v2u*)(p + 4 * lane + 256 * j) = o; } }

template <bool COMBINE>
__device__ __forceinline__ void pool_prep_phase(int gw, int NGW, int wave, int lane, LAS unsigned char* lds, const float* Xprev, float* Xcur, bf16* P, const float* gain, const float* modp, const float* ada_b, float* modr, int layer,
                                                const bf16* Y, const int* slot_of, const float* gatev) {
    if (!COMBINE) {
        for (int i = gw * 64 + lane; i < pg8::MOD_SZ / 4; i += NGW * 64) { const int idx = 4 * i, layer_ = idx / (BATCH * 6 * D_MODEL), col = idx % (6 * D_MODEL);
            f32x4 v = *(const f32x4*)(ada_b + layer_ * (6 * D_MODEL) + col);
#pragma unroll
            for (int ks = 0; ks < pg8::MOD_KS; ++ks) v += *(const f32x4*)(modp + (size_t)ks * pg8::MOD_SZ + idx);
            *(f32x4*)(modr + idx) = v; } }
    LAS v2u* ring = (LAS v2u*)(lds + RING_OFF + wave * 16384) + lane;
    for (int it = gw; it < M_TOK / 16; it += NGW) {
        const int t0 = 16 * it, b = t0 / SEQ; const bool first = (t0 % SEQ) == 0;
        f32x4 A[4], G2[4];
#pragma unroll
        for (int j = 0; j < 4; ++j) { const int col = 4 * lane + 256 * j; A[j] = *(const f32x4*)(gain + col) * ((COMBINE ? mod4(modr, layer, b, 1, col) : mod4p(modp, ada_b, layer, b, 1, col)) + 1.0f); if (COMBINE) G2[j] = mod4(modr, layer - 1, b, 5, col); }
        v2i sl = {0, 0}; f32x2 gt = {0.f, 0.f};
        if (COMBINE) { const int rr = first ? t0 + (lane & 15) : t0 - 16 + (lane & 31); sl = *(const GAS v2i*)(slot_of + 2 * rr); gt = *(const GAS f32x2*)(gatev + 2 * rr); }
#pragma unroll
        for (int q = 0; q < 30; ++q) ring[q * 64] = (v2u){0u, 0u};
        f32x4 s[4];
#pragma unroll
        for (int q = 0; q < 4; ++q) s[q] = (f32x4){0.f, 0.f, 0.f, 0.f};
        const int q0 = first ? 16 : 0; const int rbase = t0 - 16;
        f32x4 xv[4]; v2u ya[4], yb[4];
        { ld_row(Xprev + (size_t)(rbase + q0) * D_MODEL, lane, xv);
          if (COMBINE) { ld_yrow(Y + (size_t)rdlane_i(sl.x, 0) * D_MODEL, lane, ya); ld_yrow(Y + (size_t)rdlane_i(sl.y, 0) * D_MODEL, lane, yb); } }
#pragma nounroll
        for (int q = q0; q < 32; ++q) {
            const int row = rbase + q, li = q - q0, i = q & 15;
            f32x4 v[4];
#pragma unroll
            for (int j = 0; j < 4; ++j) v[j] = xv[j];
            if (COMBINE) { const float g0 = rdlane_f(gt.x, li), g1 = rdlane_f(gt.y, li);
#pragma unroll
                for (int j = 0; j < 4; ++j) v[j] += G2[j] * (y4(ya[j]) * g0 + y4(yb[j]) * g1); }
            { const int nq = q < 31 ? 1 : 0; ld_row(Xprev + (size_t)(row + nq) * D_MODEL, lane, xv);
                if (COMBINE) { ld_yrow(Y + (size_t)rdlane_i(sl.x, li + nq) * D_MODEL, lane, ya); ld_yrow(Y + (size_t)rdlane_i(sl.y, li + nq) * D_MODEL, lane, yb); } }
            if (COMBINE && q >= 16) {
#pragma unroll
                for (int j = 0; j < 4; ++j) *(GAS f32x4*)(Xcur + (size_t)row * D_MODEL + 4 * lane + 256 * j) = v[j]; }
            const float rstd = row_rstd(v);
#pragma unroll
            for (int j = 0; j < 4; ++j) { v[j] *= rstd;
                constexpr int W_[4] = {2, 4, 8, 16}, B_[4] = {0, 2, 6, 14};
                const int slot = B_[j] + (i & (W_[j] - 1));
                v2u nw; nw.x = pk2(v[j].x, v[j].y); nw.y = pk2(v[j].z, v[j].w);
                const v2u od = ring[slot * 64]; ring[slot * 64] = nw;
                s[j] += y4(nw) - y4(od); }
            if (q >= 16) {
                const int n1 = i + 1;
                const float i0 = first ? 1.0f / (float)(n1 < 2 ? n1 : 2) : 0.5f, i1 = first ? 1.0f / (float)(n1 < 4 ? n1 : 4) : 0.25f;
                const float i2 = first ? 1.0f / (float)(n1 < 8 ? n1 : 8) : 0.125f, i3 = first ? 1.0f / (float)n1 : 0.0625f;
                f32x4 h[4]; h[0] = (s[0] * i0 - v[0]) * A[0]; h[1] = (s[1] * i1 - v[1]) * A[1]; h[2] = (s[2] * i2 - v[2]) * A[2]; h[3] = (s[3] * i3 - v[3]) * A[3];
                st_row_bf16(P + (size_t)row * D_MODEL, lane, h);
            }
        }
        LDS_WAIT(); asm volatile("" ::: "memory");
    }
}

template <bool ROUTE>
__device__ __forceinline__ void norm_phase(int gw, int NGW, int lane, const float* X, bf16* H, const float* gain, const float* modr, int layer, int part_sh,
                                           const LAS float* wr_t  , const float* rb, int* eidx, float* gatev, unsigned* cnt) {
    int mycnt = 0;
    for (int it = gw; it < M_TOK / 16; it += NGW) {
        const int t0 = 16 * it, b = t0 / SEQ;
        f32x4 A[4], Bv[4];
#pragma unroll
        for (int j = 0; j < 4; ++j) { const int col = 4 * lane + 256 * j; A[j] = *(const f32x4*)(gain + col) * (mod4(modr, layer, b, part_sh + 1, col) + 1.0f); Bv[j] = mod4(modr, layer, b, part_sh, col); }
        f32x4 xv[4]; ld_row(X + (size_t)t0 * D_MODEL, lane, xv);
#pragma unroll 2
        for (int i = 0; i < 16; ++i) {
            const int row = t0 + i; f32x4 v[4];
#pragma unroll
            for (int j = 0; j < 4; ++j) v[j] = xv[j];
            ld_row(X + (size_t)(i < 15 ? row + 1 : row) * D_MODEL, lane, xv);
            const float rstd = row_rstd(v);
#pragma unroll
            for (int j = 0; j < 4; ++j) v[j] = v[j] * rstd * A[j] + Bv[j];
            st_row_bf16(H + (size_t)row * D_MODEL, lane, v);
            if (ROUTE) {
                float lg[8];
#pragma unroll
                for (int e = 0; e < 8; ++e) { float p = 0.f;
#pragma unroll
                    for (int j = 0; j < 4; ++j) { const f32x4 w = *(const LAS f32x4*)(wr_t + e * D_MODEL + 4 * lane + 256 * j); p += (v[j].x * w.x + v[j].y * w.y) + (v[j].z * w.z + v[j].w * w.w); }
                    lg[e] = wave_sum(p) + rb[e]; }
                int e1 = 0; float v1 = lg[0];
#pragma unroll
                for (int e = 1; e < 8; ++e) if (lg[e] > v1) { v1 = lg[e]; e1 = e; }
                int e2 = -1; float v2 = -__builtin_inff();
#pragma unroll
                for (int e = 0; e < 8; ++e) if (e != e1 && lg[e] > v2) { v2 = lg[e]; e2 = e; }
                const float ex = __expf(v2 - v1), g1 = 1.0f / (1.0f + ex), g2 = ex * g1;
                if (lane == 0) { *(GAS v2i*)(eidx + 2 * row) = (v2i){e1, e2}; *(GAS f32x2*)(gatev + 2 * row) = (f32x2){g1, g2}; }
                mycnt += (lane == e1 || lane == e2) ? 1 : 0;
            }
        }
    }
    if (ROUTE) { if (lane < 8 && mycnt > 0) atomicAdd(cnt + lane * 64, (unsigned)mycnt); }
}

__device__ __forceinline__ void slot_phase(int gw, int NGW, int lane, const int* eidx, const unsigned* cnt, unsigned* cur, int* stok, int* slot_of) {
    int base[8]; { int acc = 0;
#pragma unroll
        for (int e = 0; e < 8; ++e) { base[e] = acc * 256; acc += ((int)__hip_atomic_load(cnt + e * 64, __ATOMIC_RELAXED, __HIP_MEMORY_SCOPE_AGENT) + 255) >> 8; } }
    for (int it = gw; it < M_TOK / 32; it += NGW) {
        const int ent = 64 * it + lane;
        const int e = eidx[ent]; int slot = 0;
#pragma unroll
        for (int x = 0; x < 8; ++x) {
            const unsigned long long mask = __ballot(e == x);
            if (mask) { const int n = __popcll(mask), leader = __ffsll((long long)mask) - 1; unsigned st = 0;
                if (lane == leader) st = atomicAdd(cur + x * 64, (unsigned)n);
                st = (unsigned)rdlane_i((int)st, leader);
                if (e == x) slot = base[x] + (int)st + __popcll(mask & ((1ull << lane) - 1ull)); }
        }
        stok[slot] = ent >> 1; slot_of[ent] = slot;
    }
}

__device__ __forceinline__ void merge_phase(int gw, int NGW, int lane, const bf16* OG, const float* LSE, bf16* AO) {
    for (int it = gw; it < M_TOK / 16; it += NGW) {
#pragma unroll 2
        for (int i = 0; i < 16; ++i) {
            const int m = 16 * it + i, b = m / SEQ, p = m % SEQ;
#pragma unroll
            for (int seg = 0; seg < 2; ++seg) {
                const int col = 512 * seg + 8 * lane, h = col >> 7, e0 = col & 127;
                v4u o[3]; float ls[3];
#pragma unroll
                for (int g = 0; g < 3; ++g) { const int sh = 2 * g, Lg = SEQ >> sh, j = p >> sh, r = p & ((1 << sh) - 1); const size_t ci = (size_t)(((b << sh) | r) * NHEAD + h) * Lg + j;
                    o[g] = *(const GAS v4u*)(OG + (size_t)g * ((size_t)M_TOK * D_MODEL) + ci * HEAD_DIM + e0); ls[g] = LSE[(size_t)g * ((size_t)M_TOK * NHEAD) + ci]; }
                const float mx = fmaxf(ls[0], fmaxf(ls[1], ls[2])); float a0 = __expf(ls[0] - mx), a1 = __expf(ls[1] - mx), a2 = __expf(ls[2] - mx); const float inv = 1.0f / (a0 + a1 + a2); a0 *= inv; a1 *= inv; a2 *= inv;
                v4u w;
#pragma unroll
                for (int q = 0; q < 4; ++q) { const float lo = bflo(o[0][q]) * a0 + bflo(o[1][q]) * a1 + bflo(o[2][q]) * a2, hi = bfhi(o[0][q]) * a0 + bfhi(o[1][q]) * a1 + bfhi(o[2][q]) * a2; w[q] = pk2(lo, hi); }
                *(GAS v4u*)(AO + (size_t)m * D_MODEL + col) = w;
            }
        }
    }
}

__device__ __forceinline__ void final_phase(int gw, int NGW, int lane, const float* X, float* out, const float* modr, int layer, const bf16* Y, const int* slot_of, const float* gatev) {
    for (int it = gw; it < M_TOK / 16; it += NGW) {
        const int t0 = 16 * it, b = t0 / SEQ;
        f32x4 G2[4];
#pragma unroll
        for (int j = 0; j < 4; ++j) G2[j] = mod4(modr, layer, b, 5, 4 * lane + 256 * j);
        const v2i sl = *(const GAS v2i*)(slot_of + 2 * (t0 + (lane & 15))); const f32x2 gt = *(const GAS f32x2*)(gatev + 2 * (t0 + (lane & 15)));
        f32x4 xv[4]; v2u ya[4], yb[4];
        ld_row(X + (size_t)t0 * D_MODEL, lane, xv); ld_yrow(Y + (size_t)rdlane_i(sl.x, 0) * D_MODEL, lane, ya); ld_yrow(Y + (size_t)rdlane_i(sl.y, 0) * D_MODEL, lane, yb);
#pragma unroll
        for (int i = 0; i < 16; ++i) {
            const int row = t0 + i; f32x4 v[4]; const float g0 = rdlane_f(gt.x, i), g1 = rdlane_f(gt.y, i);
#pragma unroll
            for (int j = 0; j < 4; ++j) v[j] = xv[j] + G2[j] * (y4(ya[j]) * g0 + y4(yb[j]) * g1);
            { const int ni = i < 15 ? i + 1 : i; ld_row(X + (size_t)(t0 + ni) * D_MODEL, lane, xv); ld_yrow(Y + (size_t)rdlane_i(sl.x, ni) * D_MODEL, lane, ya); ld_yrow(Y + (size_t)rdlane_i(sl.y, ni) * D_MODEL, lane, yb); }
#pragma unroll
            for (int j = 0; j < 4; ++j) *(GAS f32x4*)(out + (size_t)row * D_MODEL + 4 * lane + 256 * j) = v[j];
        }
    }
}
typedef __hip_bfloat16 hbf;
constexpr size_t SUBT = (size_t)M_TOK * D_MODEL;
constexpr int ATT_ITEMS = 3 * (M_TOK * NHEAD / 256);
__device__ __forceinline__ swa::BlockRef<hbf, hbf> attn_ref(int L, const hbf* qkvc, hbf* og) {
    const int g = L >> 10, rem = L & 1023, sh = 2 * g, lq = 5 - sh, chain = rem >> lq, qb = rem & ((1 << lq) - 1), Lg = SEQ >> sh;
    const size_t co = (size_t)chain * Lg * HEAD_DIM, qo = (size_t)qb * 256 * HEAD_DIM;
    swa::BlockRef<hbf, hbf> r;
    r.Q = qkvc + (size_t)(g * 3 + 0) * SUBT + co + qo; r.K = qkvc + (size_t)(g * 3 + 1) * SUBT + co; r.V = qkvc + (size_t)(g * 3 + 2) * SUBT + co;
    r.O = og + (size_t)g * SUBT + co + qo; r.P0 = qb * 256;
    return r;
}

struct Args { const void* in[19]; float* out; unsigned char* ws; int ph_lo, ph_hi, grid, pad; };
typedef const unsigned char __attribute__((address_space(4)))* kptr_t;
__device__ __forceinline__ kptr_t kargs() { kptr_t p = (kptr_t)__builtin_amdgcn_kernarg_segment_ptr(); asm volatile("" : "+s"(p)); return p; }
#define KIN(T, k) ((const T*)*(const void* const __attribute__((address_space(4)))*)(kp + 8 * (k)))
#define KOUT() ((float*)*(void* const __attribute__((address_space(4)))*)(kp + 152))
#define KWS() ((unsigned char*)*(void* const __attribute__((address_space(4)))*)(kp + 160))
static_assert(sizeof(Args) == 184, "Args layout: in[19] at 0, out at 152, ws at 160, ph_lo 168, ph_hi 172, grid 176");
#define KINT(off) (*(const int __attribute__((address_space(4)))*)(kp + (off)))
__device__ __forceinline__ bool ph_in(int k) { const kptr_t kp = kargs(); return KINT(168) <= k && k < KINT(172); }
__global__ void __launch_bounds__(NWAVES * 64, 2) mk_fwd(Args args) {
    extern __shared__ __attribute__((aligned(16))) unsigned char lds_raw[];
    LAS unsigned char* lds = (LAS unsigned char*)lds_raw;
    for (int u = threadIdx.x; u < (LDS_BYTES - MISC_OFF) / 4; u += NWAVES * 64) ((LAS unsigned*)(lds + MISC_OFF))[u] = 0u;
    __syncthreads();
    if (args.ph_hi - args.ph_lo > 1) (void)xcd_barrier_post((unsigned*)(args.ws + WS_CTL) + CW_BAR, (volatile LAS unsigned*)(lds + MISC_OFF) + 8);
#ifndef DBG_MASK
#define DBG_MASK 0xFFFF
#endif
#define EN(t) (((DBG_MASK) >> (t)) & 1)
#ifndef RPT_MASK
#define RPT_MASK 0
#endif
#define PHASE(t, k) for (int rep_ = 0, nrep_ = (EN(t) && IN(k)) ? 1 + (((RPT_MASK) >> (t)) & 1) : 0; rep_ < nrep_; ++rep_)
#define IN(k) ph_in(k)
#define SEAM(k) do { if (IN(k) && IN((k) + 1)) { const kptr_t kp = kargs(); XcdBarrier bar_; bar_.bar = (unsigned*)(KWS() + WS_CTL) + CW_BAR; bar_.x = xb_xcc_id(); bar_.st = (volatile LAS unsigned*)(lds + MISC_OFF) + 8; xcd_barrier(bar_); } } while (0)
#define PH_SETUP() const kptr_t kp = kargs(); unsigned char* ws = KWS(); int tid = threadIdx.x; asm volatile("" : "+v"(tid)); const int lane = tid & 63, wave = __builtin_amdgcn_readfirstlane(tid >> 6); \
    const int G = KINT(176), bx = blockIdx.x, vcu = (G % 8 == 0) ? (bx % 8) * (G / 8) + bx / 8 : bx, gw = vcu * NWAVES + wave, NGW = G * NWAVES; (void)tid; (void)lane; (void)vcu; (void)gw; (void)NGW; (void)ws
#define MODP() ((const float*)(ws + WS_MODP))
#define MODR() ((float*)(ws + WS_MODR))
#define ADAB() KIN(float, 6)
#define XCUR() ((lp == 0) ? KOUT() : (float*)(ws + WS_XB))
#define CNT() ((unsigned*)(ws + WS_CTL) + CW_CNT + lp * 8 * 64)

    PHASE(0, 0) { PH_SETUP(); ProIn I; I.c = KIN(float, 1); I.ada_w = KIN(float, 5); I.pool_w = KIN(float, 7); I.wqkv = KIN(float, 9); I.wo = KIN(float, 10);
        I.wgu = KIN(float, 13); I.wdn = KIN(float, 14); I.mgu = KIN(float, 17); I.mdn = KIN(float, 18); I.pos = KIN(int, 2);
        p0_prologue(I, ws, lds, gw, NGW, wave, lane); }
    SEAM(0);
    for (int lp = 0; lp < 2; ++lp) {
        const int pb = 1 + PH_PER_PAIR * lp;
        PHASE(1, pb + 0) { PH_SETUP(); bf16* H = (bf16*)(ws + WS_H);
            if (lp == 0) pool_prep_phase<false>(gw, NGW, wave, lane, lds, KIN(float, 0), nullptr, H, KIN(float, 3), MODP(), ADAB(), MODR(), 0, nullptr, nullptr, nullptr);
            else pool_prep_phase<true>(gw, NGW, wave, lane, lds, KOUT(), (float*)(ws + WS_XB), H, KIN(float, 3) + 2 * D_MODEL, nullptr, nullptr, MODR(), 2, (const bf16*)(ws + WS_Y), (const int*)(ws + WS_SLOTOF), (const float*)(ws + WS_GATE)); }
        SEAM(pb + 0);
        PHASE(2, pb + 1) { PH_SETUP();
            pg8::SchedPlain S; S.init(ws + WS_H, (const bf16*)(ws + WS_WPOOL) + (size_t)lp * D_MODEL * 256, M_TOK, D_MODEL, 256, D_MODEL, 512, G, bx);
            pg8::EpiResid E{lp == 0 ? KIN(float, 0) : (const float*)(ws + WS_XB), XCUR(), MODR(), KIN(float, 8) + lp * D_MODEL, 2 * lp, 2};
            pg8::gemm_phase<pg8::EpiResid, pg8::SchedPlain, true>(lds + RING_OFF, 256, S, E); }
        SEAM(pb + 1);
        PHASE(3, pb + 2) { PH_SETUP();
            norm_phase<false>(gw, NGW, lane, XCUR(), (bf16*)(ws + WS_H), KIN(float, 4) + 2 * lp * D_MODEL, MODR(), 2 * lp, 3, nullptr, nullptr, nullptr, nullptr, nullptr); }
        SEAM(pb + 2);
        PHASE(4, pb + 3) { PH_SETUP();
            pg8::SchedPlain S; S.init(ws + WS_H, (const bf16*)(ws + WS_WGU) + (size_t)lp * 2 * D_FF * D_MODEL, M_TOK, 2 * D_FF, D_MODEL, D_MODEL, 0, G, bx);
            pg8::EpiSwiglu E{(bf16*)(ws + WS_ACT), D_FF};
            pg8::gemm_phase<pg8::EpiSwiglu, pg8::SchedPlain, true>(lds + RING_OFF, D_MODEL, S, E); }
        SEAM(pb + 3);
        PHASE(5, pb + 4) { PH_SETUP();
            pg8::SchedPlain S; S.init(ws + WS_ACT, (const bf16*)(ws + WS_WDN) + (size_t)lp * D_MODEL * D_FF, M_TOK, D_MODEL, D_FF, D_FF, 0, G, bx);
            float* Xc = XCUR(); pg8::EpiResid E{Xc, Xc, MODR(), nullptr, 2 * lp, 5};
            pg8::gemm_phase<pg8::EpiResid, pg8::SchedPlain, true>(lds + RING_OFF, D_FF, S, E); }
        SEAM(pb + 4);
        PHASE(6, pb + 5) { PH_SETUP();
            norm_phase<false>(gw, NGW, lane, XCUR(), (bf16*)(ws + WS_H), KIN(float, 3) + (2 * lp + 1) * D_MODEL, MODR(), 2 * lp + 1, 0, nullptr, nullptr, nullptr, nullptr, nullptr); }
        SEAM(pb + 5);
        PHASE(7, pb + 6) { PH_SETUP();
            pg8::SchedPlain S; S.init(ws + WS_H, (const bf16*)(ws + WS_WQKV) + (size_t)lp * QKV_W * D_MODEL, M_TOK, QKV_W, D_MODEL, D_MODEL, 0, G, bx);
            pg8::EpiQKV E{(bf16*)(ws + WS_QKVC), KIN(float, 11) + lp * 3 * HEAD_DIM, KIN(float, 12) + lp * 3 * HEAD_DIM, KIN(int, 2), (LAS float*)(lds + TAB_OFF)};
            pg8::gemm_phase<pg8::EpiQKV, pg8::SchedPlain, true>(lds + RING_OFF, D_MODEL, S, E); }
        SEAM(pb + 6);
        PHASE(8, pb + 7) { PH_SETUP();
            const hbf* qkvc = (const hbf*)(ws + WS_QKVC); hbf* og = (hbf*)(ws + WS_OG); float* lse = (float*)(ws + WS_LSE);
            int L = vcu;
            if (L < ATT_ITEMS) {
                swa::BlockRef<hbf, hbf> cb = attn_ref(L, qkvc, og); swa::Seam<hbf> S;
                swa::causal_swa_prime<hbf, hbf>(cb, 129, (char*)lds_raw, S);
                for (;;) {
                    const bool more = L + G < ATT_ITEMS;
                    const swa::BlockRef<hbf, hbf> nb = more ? attn_ref(L + G, qkvc, og) : cb;
                    swa::causal_swa_block<hbf, hbf>(cb, nb, SEQ >> (2 * (L >> 10)), 129, (char*)lds_raw, S, (const char*)og, (char*)lse);
                    if (!more) break;
                    cb = nb; L += G;
                }
            }
        }
        SEAM(pb + 7);
        PHASE(9, pb + 8) { PH_SETUP(); merge_phase(gw, NGW, lane, (const bf16*)(ws + WS_OG), (const float*)(ws + WS_LSE), (bf16*)(ws + WS_H)); }
        SEAM(pb + 8);
        PHASE(10, pb + 9) { PH_SETUP();
            pg8::SchedPlain S; S.init(ws + WS_H, (const bf16*)(ws + WS_WO) + (size_t)lp * D_MODEL * D_MODEL, M_TOK, D_MODEL, D_MODEL, D_MODEL, 0, G, bx);
            float* Xc = XCUR(); pg8::EpiResid E{Xc, Xc, MODR(), nullptr, 2 * lp + 1, 2};
            pg8::gemm_phase<pg8::EpiResid, pg8::SchedPlain, true>(lds + RING_OFF, D_MODEL, S, E); }
        SEAM(pb + 9);
        PHASE(11, pb + 10) { PH_SETUP();
            LAS float* wr_t = (LAS float*)(lds + RING_OFF); const float* router_w = KIN(float, 15); int* stok = (int*)(ws + WS_STOK);
            for (int idx = tid; idx < D_MODEL * N_EXP; idx += NWAVES * 64) wr_t[(idx & 7) * D_MODEL + (idx >> 3)] = router_w[(size_t)lp * D_MODEL * N_EXP + idx];
            for (int i = gw * 64 + lane; i < MAX_SLOTS; i += NGW * 64) stok[i] = 0;
            __syncthreads();
            norm_phase<true>(gw, NGW, lane, XCUR(), (bf16*)(ws + WS_H), KIN(float, 4) + (2 * lp + 1) * D_MODEL, MODR(), 2 * lp + 1, 3, wr_t, KIN(float, 16) + lp * N_EXP, (int*)(ws + WS_EIDX), (float*)(ws + WS_GATE), CNT());
        }
        SEAM(pb + 10);
        PHASE(12, pb + 11) { PH_SETUP();
            slot_phase(gw, NGW, lane, (const int*)(ws + WS_EIDX), CNT(), (unsigned*)(ws + WS_CTL) + CW_CUR + lp * 8 * 64, (int*)(ws + WS_STOK), (int*)(ws + WS_SLOTOF)); }
        SEAM(pb + 11);
        PHASE(13, pb + 12) { PH_SETUP(); const unsigned* cnt = CNT();
            pg8::SchedMoE<true> S; { int acc = 0;
#pragma unroll
                for (int e = 0; e < 8; ++e) { S.tb[e] = acc; acc += ((int)__hip_atomic_load(cnt + e * 64, __ATOMIC_RELAXED, __HIP_MEMORY_SCOPE_AGENT) + 255) >> 8; } S.tb[8] = acc; }
            S.init_order(S.tb[8], 2 * D_FFE / 256, G, bx); S.A = (const char*)(ws + WS_H); S.B = (const char*)((const bf16*)(ws + WS_WMGU) + (size_t)lp * N_EXP * 2 * D_FFE * D_MODEL); S.lda = D_MODEL;
            S.b_exp = (size_t)2 * D_FFE * D_MODEL * 2; S.b_tile = (size_t)256 * D_MODEL * 2; S.tok = (const int*)(ws + WS_STOK);
            pg8::EpiSwiglu E{(bf16*)(ws + WS_ACT), D_FFE};
            pg8::gemm_phase<pg8::EpiSwiglu, pg8::SchedMoE<true>, true>(lds + RING_OFF, D_MODEL, S, E); }
        SEAM(pb + 12);
        PHASE(14, pb + 13) { PH_SETUP(); const unsigned* cnt = CNT();
            pg8::SchedMoE<false> S; { int acc = 0;
#pragma unroll
                for (int e = 0; e < 8; ++e) { S.tb[e] = acc; acc += ((int)__hip_atomic_load(cnt + e * 64, __ATOMIC_RELAXED, __HIP_MEMORY_SCOPE_AGENT) + 255) >> 8; } S.tb[8] = acc; }
            S.init_order(S.tb[8], D_MODEL / 256, G, bx); S.A = (const char*)(ws + WS_ACT); S.B = (const char*)((const bf16*)(ws + WS_WMDN) + (size_t)lp * N_EXP * D_MODEL * D_FFE); S.lda = D_FFE;
            S.b_exp = (size_t)D_MODEL * D_FFE * 2; S.b_tile = (size_t)256 * D_FFE * 2; S.tok = nullptr;
            pg8::EpiBf16 E{(bf16*)(ws + WS_Y), D_MODEL};
            pg8::gemm_phase<pg8::EpiBf16, pg8::SchedMoE<false>, true>(lds + RING_OFF, D_FFE, S, E); }
        SEAM(pb + 13);
    }
    PHASE(15, NPHASES - 1) { PH_SETUP();
        final_phase(gw, NGW, lane, (const float*)(ws + WS_XB), KOUT(), MODR(), DEPTH - 1, (const bf16*)(ws + WS_Y), (const int*)(ws + WS_SLOTOF), (const float*)(ws + WS_GATE)); }
#undef IN
#undef SEAM
#undef EN
#undef PHASE
#undef MODP
#undef MODR
#undef ADAB
#undef XCUR
#undef CNT
#undef PH_SETUP
}

extern "C" void kernel_launch(void* const* d_in, const int* in_sizes, int n_in, void* d_out, int out_size, void* d_ws, size_t ws_size, hipStream_t stream) {
    static int grid = 0;
    if (grid == 0) {
        if (n_in != 19 || in_sizes[0] != M_TOK * D_MODEL || out_size != M_TOK * D_MODEL || ws_size < WS_END) { fprintf(stderr, "kernel_launch: unexpected shapes (n_in %d, in0 %d, out %d, ws %zu < %zu); nothing launched\n", n_in, n_in > 0 ? in_sizes[0] : -1, out_size, ws_size, (size_t)WS_END); grid = -1; return; }
        int dev = 0, cus = 0, per_cu = 0;
        if (hipGetDevice(&dev) != hipSuccess || hipDeviceGetAttribute(&cus, hipDeviceAttributeMultiprocessorCount, dev) != hipSuccess) { fprintf(stderr, "kernel_launch: device query failed\n"); grid = -1; return; }
        if (hipFuncSetAttribute((const void*)mk_fwd, hipFuncAttributeMaxDynamicSharedMemorySize, LDS_BYTES) != hipSuccess) { fprintf(stderr, "kernel_launch: hipFuncSetAttribute failed\n"); grid = -1; return; }
        if (hipOccupancyMaxActiveBlocksPerMultiprocessor(&per_cu, (const void*)mk_fwd, NWAVES * 64, LDS_BYTES) != hipSuccess || per_cu < 1) fprintf(stderr, "kernel_launch: note: occupancy query reports %d workgroups per CU\n", per_cu);
        (void)hipGetLastError();
        grid = cus;
    }
    if (grid < 0) return;
    if (hipMemsetAsync((char*)d_ws + WS_CTL, 0, CTL_ZERO_BYTES, stream) != hipSuccess) { fprintf(stderr, "kernel_launch: hipMemsetAsync failed\n"); return; }
    Args a{};
    for (int i = 0; i < 19; ++i) a.in[i] = d_in[i];
    a.out = (float*)d_out; a.ws = (unsigned char*)d_ws; a.grid = grid; a.pad = 0;
#if MK_PER_PHASE
    for (int k = 0; k < NPHASES; ++k) { a.ph_lo = k; a.ph_hi = k + 1; hipLaunchKernelGGL(mk_fwd, dim3(grid), dim3(NWAVES * 64), LDS_BYTES, stream, a); }
#else
    a.ph_lo = 0; a.ph_hi = NPHASES; hipLaunchKernelGGL(mk_fwd, dim3(grid), dim3(NWAVES * 64), LDS_BYTES, stream, a);
#endif
    const hipError_t le = hipPeekAtLastError();
    if (le != hipSuccess) fprintf(stderr, "kernel_launch: launch failed: %s\n", hipGetErrorName(le));
}
```

```cpp
#include <hip/hip_runtime.h>
#include <hip/hip_bf16.h>
#include <cstdio>
#include <cstdint>

constexpr int D_MODEL = 1024, BATCH = 4, SEQ = 8192, DEPTH = 4, M_TOK = BATCH * SEQ;
constexpr int QKV_W = 9216, D_FF = 2816, N_EXP = 8, D_FFE = 3584, HEAD_DIM = 128, NHEAD = 8;
constexpr float NORM_EPS = 1e-6f;

namespace pg8 {
#define PG8_LAS __attribute__((address_space(3)))
typedef unsigned short bf16_t;
typedef short bf16x8 __attribute__((ext_vector_type(8)));
typedef float f32x4 __attribute__((ext_vector_type(4)));
typedef float f32x2 __attribute__((ext_vector_type(2)));
typedef unsigned u32x4 __attribute__((ext_vector_type(4)));
typedef unsigned u32x2 __attribute__((ext_vector_type(2)));
typedef int v4i_t __attribute__((ext_vector_type(4)));
typedef int v8i_t __attribute__((ext_vector_type(8)));
typedef int v2i_t __attribute__((ext_vector_type(2)));
constexpr int BM = 256, BK = 64, HALF = 128, HTB = HALF * BK * 2  , STAGE_BYTES = 8 * HTB, NXCD = 8, WGM = 8;

__host__ __device__ __forceinline__ int lds_byte(int r, int c) { const int st = (r >> 4) * 2 + (c >> 5), rr = r & 15, cc = c & 31, ob = rr * 64 + cc * 2; return st * 1024 + (ob ^ (((ob >> 9) & 1) << 5)); }
__host__ __device__ __forceinline__ void stage_rc(int b, int& R, int& C) { const int st = b / 1024, sb = b % 1024, swz = sb ^ (((sb >> 9) & 1) << 5); R = (st >> 1) * 16 + swz / 64; C = (st & 1) * 32 + (swz % 64) / 2; }
__host__ __device__ __forceinline__ int perm32(int rho) { const int n = rho >> 4, i = rho & 15; return 8 * (i >> 2) + 4 * n + (i & 3); }
__device__ __forceinline__ unsigned cvt_pk_bf16(float lo, float hi) { unsigned r; asm volatile("v_cvt_pk_bf16_f32 %0, %1, %2" : "=v"(r) : "v"(lo), "v"(hi)); return r; }

struct Unit { int pm, pn; };

struct OrderBase {
    int nM, nN, nwg, G, c;
    __device__ __forceinline__ void init_order(int nM_, int nN_, int G_, int c_) { nM = nM_; nN = nN_; nwg = nM * nN; G = G_; c = c_; }
    __device__ __forceinline__ bool next(int i, Unit& u) const {
        const long L = (long)i * G + c; if (L >= nwg) return false;
        int wgid = (int)L; { const int q = nwg / NXCD, r = nwg % NXCD, xcd = wgid % NXCD, off = wgid / NXCD; wgid = (xcd < r ? xcd * (q + 1) : r * (q + 1) + (xcd - r) * q) + off; }
        const int nig = WGM * nN, gid = wgid / nig, fm = gid * WGM, gsz = (nM - fm) < WGM ? (nM - fm) : WGM;
        u.pm = fm + ((wgid % nig) % gsz); u.pn = (wgid % nig) / gsz; return true;
    }
};
struct SchedPlain : OrderBase {
    static constexpr int KIND = 0;
    const char* A; const char* B; int lda; int a_pn_step; size_t a_tile, b_tile;
    __device__ __forceinline__ void init(const void* A_, const void* B_, int M, int N, int K, int lda_, int a_pn_step_, int G_, int c_) {
        init_order(M / BM, N / BM, G_, c_); A = (const char*)A_; B = (const char*)B_; lda = lda_; a_pn_step = a_pn_step_; a_tile = (size_t)BM * lda_ * 2; b_tile = (size_t)BM * K * 2; }
    __device__ __forceinline__ const char* a_base(const Unit& u) const { return A + (size_t)u.pm * a_tile + (size_t)u.pn * a_pn_step; }
    __device__ __forceinline__ const char* b_base(const Unit& u) const { return B + (size_t)u.pn * b_tile; }
    __device__ __forceinline__ void a_offs(const Unit&, const int (&R)[2], const int (&C)[2], unsigned (&v)[2][2]) const {
#pragma unroll
        for (int h = 0; h < 2; ++h)
#pragma unroll
            for (int i = 0; i < 2; ++i) v[h][i] = (unsigned)((h * HALF + R[i]) * lda + C[i]) * 2u; }
};
template <bool GATHER> struct SchedMoE : OrderBase {
    static constexpr int KIND = GATHER ? 2 : 1;
    int tb[9]; const char* A; const char* B; int lda; size_t b_exp, b_tile; const int* tok;
    __device__ __forceinline__ int expert(int pm) const { int e = 0;
#pragma unroll
        for (int j = 1; j < 8; ++j) e += (pm >= tb[j]) ? 1 : 0; return e; }
    __device__ __forceinline__ const char* a_base(const Unit& u) const { return GATHER ? A : A + (size_t)u.pm * BM * lda * 2; }
    __device__ __forceinline__ const char* b_base(const Unit& u) const { return B + (size_t)expert(u.pm) * b_exp + (size_t)u.pn * b_tile; }
    __device__ __forceinline__ void a_offs(const Unit& u, const int (&R)[2], const int (&C)[2], unsigned (&v)[2][2]) const {
#pragma unroll
        for (int h = 0; h < 2; ++h)
#pragma unroll
            for (int i = 0; i < 2; ++i) { const int row = GATHER ? tok[u.pm * BM + h * HALF + R[i]] : (h * HALF + R[i]); v[h][i] = (unsigned)(row * lda + C[i]) * 2u; } }
};

template <class Epi, class Sched, bool ALIGN_EPI, int MODE = 0  >
__device__ __forceinline__ void gemm_phase(PG8_LAS unsigned char* lds, const int K, const Sched& S, const Epi& E, const unsigned stagger_ticks = 0u) {
    if (stagger_ticks) { const unsigned long long t0 = __builtin_amdgcn_s_memrealtime(); while (__builtin_amdgcn_s_memrealtime() - t0 < (unsigned long long)stagger_ticks) __builtin_amdgcn_s_sleep(16); }
    constexpr bool FP8 = (MODE == 1), I8 = (MODE == 2), FP6 = (MODE == 3);
    int tid = threadIdx.x; asm volatile("" : "+v"(tid));
    const int wid = __builtin_amdgcn_readfirstlane(tid >> 6), lane = tid & 63, wr = wid >> 2, wc = wid & 3, fr = lane & 15, fq = lane >> 4;
    const int nt = K / BK;
    int RA[2], CA[2]; unsigned voffB[2];
#pragma unroll
    for (int i = 0; i < 2; ++i) { int R, C; stage_rc(tid * 16 + i * 8192, R, C); const int Rb = (Epi::PERM && (Epi::PERM0 || ((R >> 5) & 3) != 0)) ? ((R & ~31) + perm32(R & 31)) : R; RA[i] = R; CA[i] = C; voffB[i] = (unsigned)(Rb * K + C) * 2u; }
    const size_t kstep = (size_t)(BK * 2);
    const size_t hstep = (size_t)HALF * K * 2;
    const unsigned ldsw = (unsigned)wid * 1024u;
    const int aoff = lds_byte(wr * 64 + fr, fq * 8), boff = lds_byte(wc * 32 + fr, fq * 8);
#define PG8_SA(b, h) (((b) * 2 + (h)) * HTB)
#define PG8_SB(b, h) ((4 + (b) * 2 + (h)) * HTB)
#define PG8_STAGE2(bufoff, gbase, v0, v1) do { \
        __builtin_amdgcn_global_load_lds((const unsigned*)((const char*)(gbase) + (v0)), (PG8_LAS unsigned*)(lds + (bufoff) + ldsw), 16, 0, 0); \
        __builtin_amdgcn_global_load_lds((const unsigned*)((const char*)(gbase) + (v1)), (PG8_LAS unsigned*)(lds + (bufoff) + ldsw + 8192), 16, 0, 0); } while (0)
#define PG8_STAGEB(bufoff, gbase) PG8_STAGE2(bufoff, gbase, voffB[0], voffB[1])
#define PG8_LD1(d, addr) do { if constexpr (MODE == 3) { d.lo = *(const PG8_LAS v4i_t*)(addr); const v2i_t h_ = *(const PG8_LAS v2i_t*)((addr) + 1024); d[4] = h_.x; d[5] = h_.y; d[7] = *(const PG8_LAS int*)((addr) + 1036); } \
        else { d.lo = *(const PG8_LAS v4i_t*)(addr); d.hi = *(const PG8_LAS v4i_t*)((addr) + 1024); } } while (0)
#define PG8_LDA(dst, b, h) do { _Pragma("unroll") for (int m = 0; m < 4; ++m) PG8_LD1(dst[m], lds + PG8_SA(b, h) + aoff + m * 2048); } while (0)
#define PG8_LDB(dst, b, h) do { _Pragma("unroll") for (int n = 0; n < 2; ++n) PG8_LD1(dst[n], lds + PG8_SB(b, h) + boff + n * 2048); } while (0)
#define PG8_MMA(ai, bj, At, Bt) do { __builtin_amdgcn_s_setprio(1); _Pragma("unroll") for (int m = 0; m < 4; ++m) _Pragma("unroll") for (int n = 0; n < 2; ++n) { \
        const v4i_t bl_ = Bt[n].lo, bh_ = Bt[n].hi, al_ = At[m].lo, ah_ = At[m].hi;     \
        acc[ai][bj][m][n] = __builtin_amdgcn_mfma_f32_16x16x32_bf16(__builtin_bit_cast(bf16x8, bl_), __builtin_bit_cast(bf16x8, al_), acc[ai][bj][m][n], 0, 0, 0); \
        acc[ai][bj][m][n] = __builtin_amdgcn_mfma_f32_16x16x32_bf16(__builtin_bit_cast(bf16x8, bh_), __builtin_bit_cast(bf16x8, ah_), acc[ai][bj][m][n], 0, 0, 0); } __builtin_amdgcn_s_setprio(0); } while (0)
#define PG8_MMA8(ai, bj, At, Bt) do { __builtin_amdgcn_s_setprio(1); _Pragma("unroll") for (int m = 0; m < 4; ++m) _Pragma("unroll") for (int n = 0; n < 2; ++n) \
        asm volatile("v_mfma_f32_16x16x128_f8f6f4 %0, %1, %2, %0" : "+v"(acc[ai][bj][m][n]) : "v"(Bt[n]), "v"(At[m])); __builtin_amdgcn_s_setprio(0); } while (0)
#define PG8_MMAI(ai, bj, At, Bt) do { __builtin_amdgcn_s_setprio(1); _Pragma("unroll") for (int m = 0; m < 4; ++m) _Pragma("unroll") for (int n = 0; n < 2; ++n) { \
        const v4i_t bl_ = Bt[n].lo, bh_ = Bt[n].hi, al_ = At[m].lo, ah_ = At[m].hi; v4i_t c_ = __builtin_bit_cast(v4i_t, acc[ai][bj][m][n]); \
        c_ = __builtin_amdgcn_mfma_i32_16x16x64_i8(bl_, al_, c_, 0, 0, 0); c_ = __builtin_amdgcn_mfma_i32_16x16x64_i8(bh_, ah_, c_, 0, 0, 0); acc[ai][bj][m][n] = __builtin_bit_cast(f32x4, c_); } __builtin_amdgcn_s_setprio(0); } while (0)
    typedef int v6i_t __attribute__((ext_vector_type(6)));
#define PG8_MMA6(ai, bj, At, Bt) do { __builtin_amdgcn_s_setprio(1); _Pragma("unroll") for (int m = 0; m < 4; ++m) _Pragma("unroll") for (int n = 0; n < 2; ++n) { \
        const v6i_t b6_ = __builtin_shufflevector(Bt[n], Bt[n], 0, 1, 2, 3, 4, 5), a6_ = __builtin_shufflevector(At[m], At[m], 0, 1, 2, 3, 4, 5); const int sb_ = Bt[n][7], sa_ = At[m][7]; \
        asm volatile("v_mfma_scale_f32_16x16x128_f8f6f4 %0, %1, %2, %0, %3, %4 op_sel:[0,0,0] op_sel_hi:[0,0,0] cbsz:2 blgp:2" : "+v"(acc[ai][bj][m][n]) : "v"(b6_), "v"(a6_), "v"(sb_), "v"(sa_)); } __builtin_amdgcn_s_setprio(0); } while (0)
#define PG8_MM(ai, bj, At, Bt) do { if constexpr (FP6) PG8_MMA6(ai, bj, At, Bt); else if constexpr (FP8) PG8_MMA8(ai, bj, At, Bt); else if constexpr (I8) PG8_MMAI(ai, bj, At, Bt); else PG8_MMA(ai, bj, At, Bt); } while (0)
#define PG8_WAIT_V(n) asm volatile("s_waitcnt vmcnt(" #n ")" ::: "memory")
#define PG8_WAIT_L(n) asm volatile("s_waitcnt lgkmcnt(" #n ")" ::: "memory")
#define PG8_WAIT_VR() asm volatile("s_waitcnt vmcnt(%0)" :: "n"((8 + Epi::NOPS) > 63 ? 63 : (8 + Epi::NOPS)) : "memory")
#define PG8_BAR __builtin_amdgcn_s_barrier()
#define PG8_SCHED __builtin_amdgcn_sched_barrier(0)
    int tpm, tpn; { Unit u_; const bool ok_ = S.next(lane, u_); tpm = ok_ ? u_.pm : -1; tpn = ok_ ? u_.pn : 0; }
#define PG8_UNIT(i, u) (u.pm = __builtin_amdgcn_readlane(tpm, (i)), u.pn = __builtin_amdgcn_readlane(tpn, (i)), u.pm >= 0)
    Unit cur, nxt; int ui = 0;
    if (!PG8_UNIT(0, cur)) return;
    f32x4 acc[2][2][4][2];
#pragma unroll
    for (int a = 0; a < 2; ++a)
#pragma unroll
        for (int b = 0; b < 2; ++b)
#pragma unroll
            for (int m = 0; m < 4; ++m)
#pragma unroll
                for (int n = 0; n < 2; ++n) acc[a][b][m][n] = (f32x4){0.f, 0.f, 0.f, 0.f};
    v8i_t At[4], B0[2], B1[2];
    unsigned vA[2][2], vN[2][2];
    const char* cA = S.a_base(cur); const char* cB = S.b_base(cur);
    S.a_offs(cur, RA, CA, vA);
#pragma unroll
    for (int h = 0; h < 2; ++h)
#pragma unroll
        for (int i = 0; i < 2; ++i) vN[h][i] = vA[h][i];
    PG8_STAGEB(PG8_SB(0, 0), cB); PG8_STAGEB(PG8_SB(0, 1), cB + hstep); PG8_STAGE2(PG8_SA(0, 0), cA, vA[0][0], vA[0][1]); PG8_STAGE2(PG8_SA(0, 1), cA, vA[1][0], vA[1][1]);
    if (wr == 1) PG8_BAR;
    PG8_WAIT_V(2); PG8_BAR;
    PG8_STAGEB(PG8_SB(1, 0), cB + kstep); PG8_STAGE2(PG8_SA(1, 0), cA + kstep, vA[0][0], vA[0][1]); PG8_STAGEB(PG8_SB(1, 1), cB + hstep + kstep);
    PG8_WAIT_V(6); PG8_BAR;
    for (;;) {
        const bool has_next = (ui + 1 < 64) && PG8_UNIT(ui + 1, nxt);
        const char* nA = has_next ? S.a_base(nxt) : cA; const char* nB = has_next ? S.b_base(nxt) : cB;
#ifndef GEMM_KREP
#define GEMM_KREP 1
#endif
        #ifndef KREP_KIND
#define KREP_KIND 2
#endif
        constexpr int KREP = ((FP8 || FP6) && Sched::KIND == KREP_KIND) ? GEMM_KREP : 1;
        for (int krep = 0; krep < KREP; ++krep) {
        const bool kfin = (krep == KREP - 1);
#pragma nounroll
        for (int t = 0; t < nt; t += 2) {
            const bool last = (t == nt - 2), lastf = last && kfin;
            const char* a1 = cA + (size_t)(t + 1) * kstep;
            if (lastf && has_next) S.a_offs(nxt, RA, CA, vN);
            const char* a2 = last ? (kfin ? nA : cA) : cA + (size_t)(t + 2) * kstep; const char* b2 = last ? (kfin ? nB : cB) : cB + (size_t)(t + 2) * kstep;
            const char* a3 = a2 + kstep; const char* b3 = b2 + kstep;
            const unsigned u00 = lastf ? vN[0][0] : vA[0][0], u01 = lastf ? vN[0][1] : vA[0][1], u10 = lastf ? vN[1][0] : vA[1][0], u11 = lastf ? vN[1][1] : vA[1][1];
            const bool relax = (t == 0) && (ui > 0) && (krep == 0);
            PG8_LDB(B0, 0, 0); PG8_LDB(B1, 0, 1); PG8_SCHED; PG8_LDA(At, 0, 0); PG8_STAGE2(PG8_SA(1, 1), a1, vA[1][0], vA[1][1]);
            if (relax) PG8_WAIT_VR(); else PG8_WAIT_V(8); PG8_WAIT_L(0); PG8_BAR; PG8_MM(0, 0, At, B0); PG8_MM(0, 1, At, B1); PG8_BAR; PG8_SCHED;
            PG8_LDA(At, 0, 1); PG8_STAGEB(PG8_SB(0, 0), b2); PG8_STAGEB(PG8_SB(0, 1), b2 + hstep); PG8_STAGE2(PG8_SA(0, 0), a2, u00, u01);
            if (relax) PG8_WAIT_VR(); else PG8_WAIT_V(8); PG8_WAIT_L(0); PG8_BAR; PG8_MM(1, 0, At, B0); PG8_MM(1, 1, At, B1); PG8_BAR; PG8_SCHED;
            PG8_LDB(B0, 1, 0); PG8_LDB(B1, 1, 1); PG8_SCHED; PG8_LDA(At, 1, 0); PG8_STAGE2(PG8_SA(0, 1), a2, u10, u11);
            PG8_WAIT_V(8); PG8_WAIT_L(0); PG8_BAR; PG8_MM(0, 0, At, B0); PG8_MM(0, 1, At, B1); PG8_BAR; PG8_SCHED;
            PG8_LDA(At, 1, 1); PG8_STAGEB(PG8_SB(1, 0), b3); PG8_STAGEB(PG8_SB(1, 1), b3 + hstep); PG8_STAGE2(PG8_SA(1, 0), a3, u00, u01);
            PG8_WAIT_V(8); PG8_WAIT_L(0); PG8_BAR; PG8_MM(1, 0, At, B0); PG8_MM(1, 1, At, B1); PG8_BAR; PG8_SCHED;
        }
        }
        if (KREP > 1) {
#pragma unroll
            for (int a = 0; a < 2; ++a)
#pragma unroll
                for (int b = 0; b < 2; ++b)
#pragma unroll
                    for (int m = 0; m < 4; ++m)
#pragma unroll
                        for (int n = 0; n < 2; ++n) acc[a][b][m][n] *= (1.0f / KREP); }
        if constexpr (FP8 || FP6) asm volatile("s_nop 7\n\ts_nop 7\n\ts_nop 7" ::: "memory");
        if constexpr (ALIGN_EPI) { if (wr == 0) PG8_BAR; }
#ifndef EPI_RPT
#define EPI_RPT 1
#endif
        for (int er = 0; er < (Epi::NOPS == 8 ? EPI_RPT : 1); ++er)
        E(acc, cur, wr, wc, fr, fq);
        if (!has_next) break;
#pragma unroll
        for (int a = 0; a < 2; ++a)
#pragma unroll
            for (int b = 0; b < 2; ++b)
#pragma unroll
                for (int m = 0; m < 4; ++m)
#pragma unroll
                    for (int n = 0; n < 2; ++n) acc[a][b][m][n] = (f32x4){0.f, 0.f, 0.f, 0.f};
        cur = nxt; cA = nA; cB = nB; ++ui;
#pragma unroll
        for (int h = 0; h < 2; ++h)
#pragma unroll
            for (int i = 0; i < 2; ++i) vA[h][i] = vN[h][i];
        if constexpr (ALIGN_EPI) { if (wr == 1) PG8_BAR; }
    }
    PG8_WAIT_V(0);
    if constexpr (!ALIGN_EPI) { if (wr == 0) PG8_BAR; }
    PG8_BAR;
#undef PG8_UNIT
#undef PG8_SA
#undef PG8_SB
#undef PG8_STAGE2
#undef PG8_STAGEB
#undef PG8_LDA
#undef PG8_LD1
#undef PG8_LDB
#undef PG8_MMA
#undef PG8_MMA8
#undef PG8_MMA6
#undef PG8_MMAI
#undef PG8_MM
#undef PG8_WAIT_V
#undef PG8_WAIT_L
#undef PG8_WAIT_VR
#undef PG8_BAR
#undef PG8_SCHED
}
}
namespace pg8 {
constexpr int MOD_SZ = DEPTH * BATCH * 6 * D_MODEL;
constexpr int MOD_KS = 8;
__device__ __forceinline__ f32x4 mod4p(const float* modp, const float* ada_b, int layer, int b, int part, int col) {
    const int o = part * D_MODEL + col; const float* p = modp + (size_t)(layer * BATCH + b) * (6 * D_MODEL) + o;
    f32x4 v = *(const f32x4*)(ada_b + layer * (6 * D_MODEL) + o);
#pragma unroll
    for (int ks = 0; ks < MOD_KS; ++ks) v += *(const f32x4*)(p + (size_t)ks * MOD_SZ);
    return v;
}
__device__ __forceinline__ f32x4 mod4(const float* modr, int layer, int b, int part, int col) { return *(const f32x4*)(modr + (size_t)(layer * BATCH + b) * (6 * D_MODEL) + part * D_MODEL + col); }
template <bool XIN16  > struct EpiResid {
    static constexpr bool PERM = false, PERM0 = false; static constexpr int NOPS = 64;
    const void* xin; bf16_t* xout; const float* modr; const float* colscale; int layer, part; float scale;
    __device__ __forceinline__ void operator()(const f32x4 (&acc)[2][2][4][2], const Unit& u, int wr, int wc, int fr, int fq) const {
        const int row0 = u.pm * BM + wr * 64 + fr, col0 = u.pn * BM + wc * 32 + 4 * fq, b = (u.pm * BM) / SEQ;
        f32x4 gs[2][2];
#pragma unroll
        for (int bj = 0; bj < 2; ++bj)
#pragma unroll
            for (int n = 0; n < 2; ++n) { const int c = col0 + bj * HALF + n * 16; gs[bj][n] = mod4(modr, layer, b, part, c) * scale; if (colscale) gs[bj][n] *= *(const f32x4*)(colscale + c); }
#pragma unroll
        for (int ai = 0; ai < 2; ++ai)
#pragma unroll
            for (int m = 0; m < 4; ++m) { const size_t off = (size_t)(row0 + ai * HALF + m * 16) * D_MODEL + col0;
#pragma unroll
                for (int bj = 0; bj < 2; ++bj)
#pragma unroll
                    for (int n = 0; n < 2; ++n) { f32x4 xv;
                        if constexpr (XIN16) { const u32x2 w = *(const u32x2*)((const bf16_t*)xin + off + bj * HALF + n * 16); xv = (f32x4){__uint_as_float(w.x << 16), __uint_as_float(w.x & 0xffff0000u), __uint_as_float(w.y << 16), __uint_as_float(w.y & 0xffff0000u)}; }
                        else xv = *(const f32x4*)((const float*)xin + off + bj * HALF + n * 16);
                        const f32x4 r = xv + gs[bj][n] * acc[ai][bj][m][n]; u32x2 o; o.x = cvt_pk_bf16(r[0], r[1]); o.y = cvt_pk_bf16(r[2], r[3]);
                        *(u32x2*)(xout + off + bj * HALF + n * 16) = o; }
                asm volatile("" ::: "memory"); }
    }
};
__device__ __forceinline__ unsigned cvt4_fp8(float a, float b, float c, float d) { unsigned w = 0u; w = __builtin_amdgcn_cvt_pk_fp8_f32(a, b, w, false); w = __builtin_amdgcn_cvt_pk_fp8_f32(c, d, w, true); return w; }
template <bool OUT8> struct EpiSwigluT {
    static constexpr bool PERM = true, PERM0 = true; static constexpr int NOPS = 8;
    void* O; int ldo; float scale;
    __device__ __forceinline__ void operator()(const f32x4 (&acc)[2][2][4][2], const Unit& u, int wr, int wc, int fr, int fq) const {
        const int row0 = u.pm * BM + wr * 64 + fr, col0 = u.pn * HALF + wc * 32 + 8 * fq;
        const float c1 = -1.4426950408889634f * scale, c2i = 1.0f / (scale * scale);
#pragma unroll
        for (int ai = 0; ai < 2; ++ai)
#pragma unroll
            for (int m = 0; m < 4; ++m) { const size_t off = (size_t)(row0 + ai * HALF + m * 16) * ldo + col0; float v[8];
#pragma unroll
                for (int n = 0; n < 2; ++n)
#pragma unroll
                    for (int j = 0; j < 4; j += 2) {
                        const f32x2 g2 = {acc[ai][0][m][n][j], acc[ai][0][m][n][j + 1]}, u2 = {acc[ai][1][m][n][j], acc[ai][1][m][n][j + 1]};
                        const f32x2 p2 = g2 * u2, t2 = g2 * c1; const f32x2 d2 = (f32x2){__builtin_amdgcn_exp2f(t2.x), __builtin_amdgcn_exp2f(t2.y)} * c2i + c2i;
                        const f32x2 o2 = p2 * (f32x2){__builtin_amdgcn_rcpf(d2.x), __builtin_amdgcn_rcpf(d2.y)}; v[n * 4 + j] = o2.x; v[n * 4 + j + 1] = o2.y; }
                if constexpr (OUT8) { u32x2 w; w.x = cvt4_fp8(v[0], v[1], v[2], v[3]); w.y = cvt4_fp8(v[4], v[5], v[6], v[7]); *(u32x2*)((unsigned char*)O + off) = w; }
                else { u32x4 w; w.x = cvt_pk_bf16(v[0], v[1]); w.y = cvt_pk_bf16(v[2], v[3]); w.z = cvt_pk_bf16(v[4], v[5]); w.w = cvt_pk_bf16(v[6], v[7]); *(u32x4*)((bf16_t*)O + off) = w; } }
    }
};
template <bool OUT8  > struct EpiSwigluI8 {
    static constexpr bool PERM = true, PERM0 = true; static constexpr int NOPS = 8;
    void* O; int ldo; const float* rs; const float* cmax; int F;
    __device__ __forceinline__ void operator()(const f32x4 (&acc)[2][2][4][2], const Unit& u, int wr, int wc, int fr, int fq) const {
        const int row0 = u.pm * BM + wr * 64 + fr, col0 = u.pn * HALF + wc * 32 + 8 * fq;
        f32x4 cg[2], cu[2];
#pragma unroll
        for (int n = 0; n < 2; ++n) { cg[n] = *(const f32x4*)(cmax + col0 + 4 * n) * (1.0f / 127.0f); cu[n] = *(const f32x4*)(cmax + F + col0 + 4 * n) * (1.0f / 127.0f); }
#pragma unroll
        for (int ai = 0; ai < 2; ++ai)
#pragma unroll
            for (int m = 0; m < 4; ++m) { const int row = row0 + ai * HALF + m * 16; const float rsv = rs[row]; float v[8];
#pragma unroll
                for (int n = 0; n < 2; ++n)
#pragma unroll
                    for (int j = 0; j < 4; j += 2) {
                        const f32x2 gi = {(float)__float_as_int(acc[ai][0][m][n][j]), (float)__float_as_int(acc[ai][0][m][n][j + 1])}, ui = {(float)__float_as_int(acc[ai][1][m][n][j]), (float)__float_as_int(acc[ai][1][m][n][j + 1])};
                        const f32x2 g2 = gi * ((f32x2){cg[n][j], cg[n][j + 1]} * rsv), u2 = ui * ((f32x2){cu[n][j], cu[n][j + 1]} * rsv);
                        const f32x2 p2 = g2 * u2, t2 = g2 * -1.4426950408889634f; const f32x2 d2 = (f32x2){__builtin_amdgcn_exp2f(t2.x), __builtin_amdgcn_exp2f(t2.y)} + 1.0f;
                        const f32x2 o2 = p2 * (f32x2){__builtin_amdgcn_rcpf(d2.x), __builtin_amdgcn_rcpf(d2.y)}; v[n * 4 + j] = o2.x; v[n * 4 + j + 1] = o2.y; }
                if constexpr (OUT8) { u32x2 w; w.x = cvt4_fp8(v[0], v[1], v[2], v[3]); w.y = cvt4_fp8(v[4], v[5], v[6], v[7]); *(u32x2*)((unsigned char*)O + (size_t)row * ldo + col0) = w; }
                else { u32x4 w; w.x = cvt_pk_bf16(v[0], v[1]); w.y = cvt_pk_bf16(v[2], v[3]); w.z = cvt_pk_bf16(v[4], v[5]); w.w = cvt_pk_bf16(v[6], v[7]);
                    *(u32x4*)((bf16_t*)O + (size_t)row * ldo + col0) = w; } }
    }
};
struct EpiResidI8 {
    static constexpr bool PERM = false, PERM0 = false; static constexpr int NOPS = 64;
    const bf16_t* xin; bf16_t* xout; const float* modr; const float* rs; const float* cmax; int layer, part;
    __device__ __forceinline__ void operator()(const f32x4 (&acc)[2][2][4][2], const Unit& u, int wr, int wc, int fr, int fq) const {
        const int row0 = u.pm * BM + wr * 64 + fr, col0 = u.pn * BM + wc * 32 + 4 * fq, b = (u.pm * BM) / SEQ;
        f32x4 gs[2][2];
#pragma unroll
        for (int bj = 0; bj < 2; ++bj)
#pragma unroll
            for (int n = 0; n < 2; ++n) { const int c = col0 + bj * HALF + n * 16; gs[bj][n] = mod4(modr, layer, b, part, c) * *(const f32x4*)(cmax + c) * (1.0f / 127.0f); }
#pragma unroll
        for (int ai = 0; ai < 2; ++ai)
#pragma unroll
            for (int m = 0; m < 4; ++m) { const int row = row0 + ai * HALF + m * 16; const float rsv = rs[row]; const size_t off = (size_t)row * D_MODEL + col0;
#pragma unroll
                for (int bj = 0; bj < 2; ++bj)
#pragma unroll
                    for (int n = 0; n < 2; ++n) { const u32x2 w = *(const u32x2*)(xin + off + bj * HALF + n * 16); const f32x4 a = acc[ai][bj][m][n];
                        const f32x4 xv = {__uint_as_float(w.x << 16), __uint_as_float(w.x & 0xffff0000u), __uint_as_float(w.y << 16), __uint_as_float(w.y & 0xffff0000u)};
                        const f32x4 af = {(float)__float_as_int(a[0]), (float)__float_as_int(a[1]), (float)__float_as_int(a[2]), (float)__float_as_int(a[3])};
                        const f32x4 r = xv + gs[bj][n] * rsv * af; u32x2 o; o.x = cvt_pk_bf16(r[0], r[1]); o.y = cvt_pk_bf16(r[2], r[3]);
                        *(u32x2*)(xout + off + bj * HALF + n * 16) = o; }
                asm volatile("" ::: "memory"); }
    }
};
typedef EpiSwigluT<false> EpiSwiglu;
typedef EpiSwigluT<true> EpiSwiglu8;
struct EpiBf16 {
    static constexpr bool PERM = true, PERM0 = true; static constexpr int NOPS = 16;
    bf16_t* O; int ldo; float scale;
    __device__ __forceinline__ void operator()(const f32x4 (&acc)[2][2][4][2], const Unit& u, int wr, int wc, int fr, int fq) const {
        const int row0 = u.pm * BM + wr * 64 + fr, col0 = u.pn * BM + wc * 32 + 8 * fq;
#pragma unroll
        for (int ai = 0; ai < 2; ++ai)
#pragma unroll
            for (int m = 0; m < 4; ++m) { bf16_t* rowp = O + (size_t)(row0 + ai * HALF + m * 16) * ldo + col0;
#pragma unroll
                for (int bj = 0; bj < 2; ++bj) { const f32x4 v0 = acc[ai][bj][m][0] * scale, v1 = acc[ai][bj][m][1] * scale;
                    u32x4 w; w.x = cvt_pk_bf16(v0[0], v0[1]); w.y = cvt_pk_bf16(v0[2], v0[3]); w.z = cvt_pk_bf16(v1[0], v1[1]); w.w = cvt_pk_bf16(v1[2], v1[3]);
                    *(u32x4*)(rowp + bj * HALF) = w; } }
    }
};
constexpr unsigned ROPE_IFB[16] = {0x3f800000u, 0x3ee177bbu, 0x3e4693afu, 0x3daee4adu, 0x3d1a08c8u, 0x3c87a9c2u, 0x3beef74eu, 0x3b52771fu, 0x3ab95d22u, 0x3a23418cu, 0x398fc8f8u, 0x38fd45c2u, 0x385f10c5u, 0x37c47611u, 0x372d07a8u, 0x369864a7u};
typedef __fp16 h2_t __attribute__((ext_vector_type(2)));
__device__ __forceinline__ float xsum16(float s) { const auto r = __builtin_amdgcn_permlane16_swap(__float_as_uint(s), __float_as_uint(s), false, false); return __uint_as_float(r[0]) + __uint_as_float(r[1]); }
__device__ __forceinline__ float xsum32(float s) { const auto r = __builtin_amdgcn_permlane32_swap(__float_as_uint(s), __float_as_uint(s), false, false); return __uint_as_float(r[0]) + __uint_as_float(r[1]); }
struct EpiQKV {
    static constexpr bool PERM = true, PERM0 = false; static constexpr int NOPS = 16;
    bf16_t* qkvc; const float* qg; const float* kg; const int* pos; PG8_LAS float* tab; float scale; const unsigned* rope;
    __device__ __forceinline__ void operator()(f32x4 (&acc)[2][2][4][2], const Unit& u, int wr, int wc, int fr, int fq) const {
        if (scale != 1.0f) {
#pragma unroll
            for (int ai = 0; ai < 2; ++ai)
#pragma unroll
                for (int bj = 0; bj < 2; ++bj)
#pragma unroll
                    for (int m = 0; m < 4; ++m) { acc[ai][bj][m][0] *= scale; acc[ai][bj][m][1] *= scale; } }
        const int g = u.pn / 12, which = (u.pn % 12) >> 2, hp = u.pn & 3, sh = 2 * g, d = 1 << sh;
        const int b = (u.pm * BM) / SEQ, p0 = (u.pm * BM) % SEQ + wr * 64 + fr;
        if (which < 2) {
            u32x4 cst[2][4];
#pragma unroll
            for (int ai = 0; ai < 2; ++ai)
#pragma unroll
                for (int m = 0; m < 4; ++m) cst[ai][m] = *(const u32x4*)(rope + (size_t)(b * SEQ + p0 + ai * HALF + m * 16) * 16 + 4 * fq);
            const float* gain = (which == 0 ? qg : kg) + g * HEAD_DIM + (wc == 0 ? 4 * fq : wc * 32 + 8 * fq);
            const f32x4 g0 = *(const f32x4*)gain, g1 = *(const f32x4*)(gain + (wc == 0 ? 16 : 4));
#pragma unroll
            for (int ai = 0; ai < 2; ++ai)
#pragma unroll
                for (int bj = 0; bj < 2; ++bj) { float sq[4];
#pragma unroll
                    for (int m = 0; m < 4; ++m) { const f32x4 a = acc[ai][bj][m][0], c = acc[ai][bj][m][1]; const f32x4 q = a * a + c * c; sq[m] = (q[0] + q[1]) + (q[2] + q[3]); }
                    const auto r01 = __builtin_amdgcn_permlane16_swap(__float_as_uint(sq[0]), __float_as_uint(sq[1]), false, false); const float z = __uint_as_float(r01[0]) + __uint_as_float(r01[1]);
                    const auto r23 = __builtin_amdgcn_permlane16_swap(__float_as_uint(sq[2]), __float_as_uint(sq[3]), false, false); const float w = __uint_as_float(r23[0]) + __uint_as_float(r23[1]);
                    const auto rr = __builtin_amdgcn_permlane32_swap(__float_as_uint(z), __float_as_uint(w), false, false);
                    tab[((((ai * 2 + bj) * 4 + fq) * 2 + wr) * 16 + fr) * 4 + wc] = __uint_as_float(rr[0]) + __uint_as_float(rr[1]); }
            asm volatile("s_waitcnt lgkmcnt(0)" ::: "memory"); __builtin_amdgcn_s_barrier(); asm volatile("" ::: "memory");
#pragma unroll
            for (int ai = 0; ai < 2; ++ai)
#pragma unroll
                for (int m = 0; m < 4; ++m) {
#pragma unroll
                    for (int bj = 0; bj < 2; ++bj) { const f32x4 t = *(const PG8_LAS f32x4*)(tab + ((((ai * 2 + bj) * 4 + m) * 2 + wr) * 16 + fr) * 4);
                        const float rstd = __builtin_amdgcn_rsqf(((t[0] + t[1]) + (t[2] + t[3])) * (1.0f / HEAD_DIM) + NORM_EPS);
                        acc[ai][bj][m][0] = acc[ai][bj][m][0] * rstd * g0; acc[ai][bj][m][1] = acc[ai][bj][m][1] * rstd * g1; }
                    if (wc == 0) {
                        const u32x4 cw = cst[ai][m];
#pragma unroll
                        for (int j = 0; j < 4; j += 2) { const unsigned w0 = cw[j], w1 = cw[j + 1]; const h2_t h0 = __builtin_bit_cast(h2_t, w0), h1 = __builtin_bit_cast(h2_t, w1);
                            const f32x2 cs = {(float)h0[0], (float)h1[0]}, sn = {(float)h0[1], (float)h1[1]};
#pragma unroll
                            for (int bj = 0; bj < 2; ++bj) { const f32x2 x1 = {acc[ai][bj][m][0][j], acc[ai][bj][m][0][j + 1]}, x2 = {acc[ai][bj][m][1][j], acc[ai][bj][m][1][j + 1]};
                                const f32x2 o1 = x1 * cs - x2 * sn, o2 = x2 * cs + x1 * sn;
                                acc[ai][bj][m][0][j] = o1.x; acc[ai][bj][m][0][j + 1] = o1.y; acc[ai][bj][m][1][j] = o2.x; acc[ai][bj][m][1][j + 1] = o2.y; } }
                    }
                }
            asm volatile("" :: "v"(cst[0][0]), "v"(cst[0][1]), "v"(cst[0][2]), "v"(cst[0][3]), "v"(cst[1][0]), "v"(cst[1][1]), "v"(cst[1][2]), "v"(cst[1][3]));
        }
        bf16_t* base = qkvc + (size_t)(g * 3 + which) * ((size_t)M_TOK * D_MODEL) + (wc == 0 ? 4 * fq : wc * 32 + 8 * fq);
        const int Lg = SEQ >> sh;
#ifndef QKV_ST_RPT
#define QKV_ST_RPT 1
#endif
        for (int strp = 0; strp < QKV_ST_RPT; ++strp)
#pragma unroll
        for (int ai = 0; ai < 2; ++ai)
#pragma unroll
            for (int m = 0; m < 4; ++m) { const int p = p0 + ai * HALF + m * 16, j = p >> sh, r = p & (d - 1);
#pragma unroll
                for (int bj = 0; bj < 2; ++bj) { const int h = 2 * hp + bj; const f32x4 v0 = acc[ai][bj][m][0], v1 = acc[ai][bj][m][1];
                    u32x4 w; w.x = cvt_pk_bf16(v0[0], v0[1]); w.y = cvt_pk_bf16(v0[2], v0[3]); w.z = cvt_pk_bf16(v1[0], v1[1]); w.w = cvt_pk_bf16(v1[2], v1[3]);
                    bf16_t* dst = base + ((size_t)(((b << sh) | r) * NHEAD + h) * Lg + j) * HEAD_DIM;
                    if (wc == 0) { *(u32x2*)dst = (u32x2){w.x, w.y}; *(u32x2*)(dst + 16) = (u32x2){w.z, w.w}; } else *(u32x4*)dst = w; } }
    }
};
}
namespace swa {
constexpr int D = 128;
constexpr float THR = 8.f;
constexpr bool WSKIP = true;
constexpr float SCALE = 0.08838834764831845f;
constexpr int NW = 8, QBLK = 32, KVBLK = 64, QB = NW * QBLK;
constexpr int SHM_V = KVBLK * D * 2, SHM_K = KVBLK * D * 2;
constexpr int LDS_BYTES = 2 * SHM_V + 2 * SHM_K + NW * 64 * 4;
constexpr int O_STAGE_OFF = 69632, O_STAGE_BYTES = NW * QBLK * D * 2;
using bf16 = __hip_bfloat16;
typedef short bf16x8 __attribute__((ext_vector_type(8)));
typedef short s16x4 __attribute__((ext_vector_type(4)));
typedef float f32x16 __attribute__((ext_vector_type(16)));
typedef float f32x4 __attribute__((ext_vector_type(4)));
typedef unsigned u32x4 __attribute__((ext_vector_type(4)));
template <class A, class Bt> struct same_t { static constexpr bool v = false; };
template <class A> struct same_t<A, A> { static constexpr bool v = true; };

#define KSWZ(row, colB) ((row) * 256 + ((colB) ^ (((row) & 7) << 4)))
#define SBAR() __builtin_amdgcn_sched_barrier(0)
__device__ __forceinline__ int v_st(int k, int c) { const int kk = (k & ~0xC) | ((k & 4) << 1) | ((k & 8) >> 1); return ((kk >> 3) * 4 + (c >> 5)) * 512 + ((kk & 7) * 32 + (c & 31)) * 2; }
__device__ __forceinline__ int v_rd_base(int lane) { return ((lane & 3) << 3) | (((lane >> 2) & 3) << 6) | (((lane >> 4) & 1) << 5) | (((lane >> 5) & 1) << 8); }
constexpr int v_rd_off(int d0, int ks, int half) { return d0 * 512 + ks * 4096 + half * 2048; }
__device__ __forceinline__ int crow(int r, int hi) { return (r & 3) + 8 * (r >> 2) + 4 * hi; }
__device__ __forceinline__ unsigned cvtpk(float lo, float hi) {
    unsigned r; asm volatile("v_cvt_pk_bf16_f32 %0, %1, %2" : "=v"(r) : "v"(lo), "v"(hi)); return r;
}
__device__ __forceinline__ bf16x8 pack8(f32x4 a, f32x4 b) {
    u32x4 w = {cvtpk(a[0], a[1]), cvtpk(a[2], a[3]), cvtpk(b[0], b[1]), cvtpk(b[2], b[3])};
    return *reinterpret_cast<bf16x8*>(&w);
}
template <class T> __device__ __forceinline__ bf16x8 load8(const T* p) {
    if constexpr (same_t<T, float>::v) { return pack8(*(const f32x4*)p, *(const f32x4*)(p + 4)); }
    else { return *reinterpret_cast<const bf16x8*>(p); }
}
__device__ __forceinline__ void mask_tile(f32x16& p0, f32x16& p1, int dq, unsigned W) {
    const float NEG = -__builtin_inff();
#pragma unroll
    for (int r = 0; r < 16; ++r) {
        const int c = (r & 3) + 8 * (r >> 2);
        if ((unsigned)(dq - c) >= W) p0[r] = NEG;
        if ((unsigned)(dq - c - 32) >= W) p1[r] = NEG;
    }
}
__device__ __forceinline__ void partialSM(f32x16& p0, f32x16& p1, float& m_reg, float& mn, float& alpha) {
    float pmax = p0[0]; for (int r = 1; r < 16; ++r) pmax = fmaxf(pmax, p0[r]); for (int r = 0; r < 16; ++r) pmax = fmaxf(pmax, p1[r]);
    { auto rr = __builtin_amdgcn_permlane32_swap(__float_as_uint(pmax), __float_as_uint(pmax), false, false);
      pmax = fmaxf(__uint_as_float(rr[0]), __uint_as_float(rr[1])); }
    constexpr float C2 = 1.4426950408889634f * SCALE;
    if (__builtin_expect(__all((pmax - m_reg) * SCALE <= THR), 1)) { mn = m_reg; alpha = 1.f; }
    else { mn = fmaxf(m_reg, pmax); alpha = __builtin_amdgcn_exp2f((m_reg - mn) * C2); m_reg = mn; }
    const float mnL = -mn * C2;
    for (int r = 0; r < 16; ++r) p0[r] = fmaf(p0[r], C2, mnL); for (int r = 0; r < 16; ++r) p1[r] = fmaf(p1[r], C2, mnL);
    for (int r = 0; r < 16; ++r) p0[r] = __builtin_amdgcn_exp2f(p0[r]);
}
__device__ __forceinline__ void finishSM(f32x16& p0, f32x16& p1, float alpha, float& l_reg, bf16x8& pa0, bf16x8& pa1, bf16x8& pa2, bf16x8& pa3) {
    for (int r = 0; r < 16; ++r) p1[r] = __builtin_amdgcn_exp2f(p1[r]);
    float ps = 0; for (int r = 0; r < 16; ++r) ps += p0[r]; for (int r = 0; r < 16; ++r) ps += p1[r];
    { auto rr = __builtin_amdgcn_permlane32_swap(__float_as_uint(ps), __float_as_uint(ps), false, false);
      ps = __uint_as_float(rr[0]) + __uint_as_float(rr[1]); }
    l_reg = l_reg * alpha + ps;
#define PK4(P, B_, OUT) do { unsigned a0 = cvtpk(P[B_+0], P[B_+1]), a1 = cvtpk(P[B_+2], P[B_+3]);                          \
        unsigned b0 = cvtpk(P[B_+4], P[B_+5]), b1 = cvtpk(P[B_+6], P[B_+7]);                                             \
        auto r0 = __builtin_amdgcn_permlane32_swap(a0, b0, false, false); auto r1 = __builtin_amdgcn_permlane32_swap(a1, b1, false, false); \
        u32x4 w = {r0[0], r1[0], r0[1], r1[1]}; OUT = *reinterpret_cast<bf16x8*>(&w); } while (0)
    PK4(p0, 0, pa0); PK4(p0, 8, pa1); PK4(p1, 0, pa2); PK4(p1, 8, pa3);
#undef PK4
}
template <int KB, bool SK>
__device__ __forceinline__ void qkt(f32x16& p0, f32x16& p1, const char* K_lds, int r32, int hi, const bf16x8* qr, bool act) {
    if (SK && !act) { const float NEG = -__builtin_inff();
#pragma unroll
        for (int r = 0; r < 16; ++r) { p0[r] = NEG; p1[r] = NEG; } return; }
    p0 = f32x16{}; p1 = f32x16{};
    const char* kb[4];
#pragma unroll
    for (int dd = 0; dd < 4; ++dd) kb[dd] = K_lds + KB * SHM_K + KSWZ(r32, (dd * 16 + hi * 8) * 2);
#pragma unroll
    for (int d0 = 0; d0 < 8; ++d0) { const char* a = kb[d0 & 3] + (d0 >> 2) * 128;
        bf16x8 b0 = *reinterpret_cast<const bf16x8*>(a);
        bf16x8 b1 = *reinterpret_cast<const bf16x8*>(a + 32 * 256);
        p0 = __builtin_amdgcn_mfma_f32_32x32x16_bf16(b0, qr[d0], p0, 0, 0, 0);
        p1 = __builtin_amdgcn_mfma_f32_32x32x16_bf16(b1, qr[d0], p1, 0, 0, 0); }
}
template <int VB, bool SK>
__device__ __forceinline__ void pv_tile(f32x16* o, int vb0, bf16x8 pa0, bf16x8 pa1, bf16x8 pa2, bf16x8 pa3, bool act) {
    if (SK && !act) return;
#define TRRD(dst, off) asm volatile("ds_read_b64_tr_b16 %0, %1 offset:%2" : "=&v"(dst) : "v"(vb0), "i"(off) : "memory")
#define PV_D0(d0) do { s16x4 l0, l1, l2, l3, h0, h1, h2, h3; constexpr int b_ = VB * SHM_V + v_rd_off(d0, 0, 0);     \
        TRRD(l0, b_); TRRD(h0, b_ + 2048); TRRD(l1, b_ + 4096); TRRD(h1, b_ + 6144); TRRD(l2, b_ + 8192); TRRD(h2, b_ + 10240); TRRD(l3, b_ + 12288); TRRD(h3, b_ + 14336); \
        asm volatile("s_waitcnt lgkmcnt(0)" ::: "memory"); SBAR();                 \
        o[d0] = __builtin_amdgcn_mfma_f32_32x32x16_bf16(pa0, (bf16x8){l0[0], l0[1], l0[2], l0[3], h0[0], h0[1], h0[2], h0[3]}, o[d0], 0, 0, 0);   \
        o[d0] = __builtin_amdgcn_mfma_f32_32x32x16_bf16(pa1, (bf16x8){l1[0], l1[1], l1[2], l1[3], h1[0], h1[1], h1[2], h1[3]}, o[d0], 0, 0, 0);   \
        o[d0] = __builtin_amdgcn_mfma_f32_32x32x16_bf16(pa2, (bf16x8){l2[0], l2[1], l2[2], l2[3], h2[0], h2[1], h2[2], h2[3]}, o[d0], 0, 0, 0);   \
        o[d0] = __builtin_amdgcn_mfma_f32_32x32x16_bf16(pa3, (bf16x8){l3[0], l3[1], l3[2], l3[3], h3[0], h3[1], h3[2], h3[3]}, o[d0], 0, 0, 0); } while (0)
    PV_D0(0); PV_D0(1); PV_D0(2); PV_D0(3);
#undef PV_D0
#undef TRRD
}

template <class TIn, class TOut> struct BlockRef { const TIn* Q; const TIn* K; const TIn* V; TOut* O; int P0; };
template <class TIn> struct Seam {
    bf16x8 qr[8];
    bf16x8 st_v0, st_v1, st_k0, st_k1; f32x4 sf0, sf1, sf2, sf3;
    f32x4 tq[16];
};
__device__ __forceinline__ int swa_jlo(int P0, int W) { const int lowk = P0 - W + 1; return lowk > 0 ? lowk / KVBLK : 0; }
#define ROW(p, k0, rr) ((p) + (size_t)((k0) + (rr)) * D + sc)
#define VMW() asm volatile("s_waitcnt vmcnt(0)" ::: "memory")
#define VMWN(n) asm volatile("s_waitcnt vmcnt(%0)" :: "i"(n) : "memory")
#define SLOAD_H(Kp, Vp, k0) do { S.st_v0 = load8<TIn>(ROW(Vp, k0, sr)); S.st_v1 = load8<TIn>(ROW(Vp, k0, 32 + sr));              \
                         S.st_k0 = load8<TIn>(ROW(Kp, k0, sr)); S.st_k1 = load8<TIn>(ROW(Kp, k0, 32 + sr)); } while (0)
#define SWRITE_HK(bf) do { *(bf16x8*)(K_lds + (bf) * SHM_K + kws) = S.st_k0; *(bf16x8*)(K_lds + (bf) * SHM_K + kws + 32 * 256) = S.st_k1; } while (0)
#define SWRITE_HV(bf) do { *(bf16x8*)(V_lds + (bf) * SHM_V + vst0) = S.st_v0; *(bf16x8*)(V_lds + (bf) * SHM_V + vst1) = S.st_v1; } while (0)
#define SWRITE_H(bf) do { SWRITE_HV(bf); SWRITE_HK(bf); } while (0)
#define SLOAD_F(p, k0) do { S.sf0 = *(const f32x4*)ROW(p, k0, sr); S.sf1 = *(const f32x4*)(ROW(p, k0, sr) + 4);                \
                            S.sf2 = *(const f32x4*)ROW(p, k0, 32 + sr); S.sf3 = *(const f32x4*)(ROW(p, k0, 32 + sr) + 4); } while (0)
#define SWRITE_KF(bf) do { *(bf16x8*)(K_lds + (bf) * SHM_K + kws) = pack8(S.sf0, S.sf1); *(bf16x8*)(K_lds + (bf) * SHM_K + kws + 32 * 256) = pack8(S.sf2, S.sf3); } while (0)
#define SWRITE_VF(bf) do { *(bf16x8*)(V_lds + (bf) * SHM_V + vst0) = pack8(S.sf0, S.sf1); *(bf16x8*)(V_lds + (bf) * SHM_V + vst1) = pack8(S.sf2, S.sf3); } while (0)
template <class TIn, class TOut>
__device__ __forceinline__ void causal_swa_prime(const BlockRef<TIn, TOut>& cur, int W, char* lds, Seam<TIn>& S) {
    constexpr bool F32 = same_t<TIn, float>::v;
    int tid = threadIdx.x; asm volatile("" : "+v"(tid));
    const int wid = __builtin_amdgcn_readfirstlane(tid >> 6), lane = tid & 63, r32 = lane & 31, hi = lane >> 5;
    const int sr = tid >> 4, sc = (tid & 15) * 8, kws = KSWZ(sr, sc * 2); char* K_lds = lds + 2 * SHM_V;
    const int kb0 = swa_jlo(cur.P0, W) * KVBLK;
    for (int d0 = 0; d0 < 8; ++d0) S.qr[d0] = load8<TIn>(cur.Q + (size_t)(wid * QBLK + r32) * D + d0 * 16 + hi * 8);
    if constexpr (F32) { SLOAD_F((const float*)cur.K, kb0); VMW(); SWRITE_KF(0); SBAR(); SLOAD_F((const float*)cur.V, kb0); }
    else { SLOAD_H(cur.K, cur.V, kb0); VMW(); SWRITE_HK(0); }
    __syncthreads();
}
template <class TIn, class TOut>
__device__ __forceinline__ void causal_swa_block(const BlockRef<TIn, TOut>& cur, const BlockRef<TIn, TOut>& nxt, int skv, int W, char* lds, Seam<TIn>& S, const char* og_base, char* lse_base) {
    constexpr bool F32 = same_t<TIn, float>::v;
    int tid = threadIdx.x; asm volatile("" : "+v"(tid));
    const int wid = __builtin_amdgcn_readfirstlane(tid >> 6), lane = tid & 63, r32 = lane & 31, hi = lane >> 5;
    const int j_lo = swa_jlo(cur.P0, W);
    int j_hi = (cur.P0 + QB - 1) / KVBLK + 1; if (j_hi > skv / KVBLK) j_hi = skv / KVBLK;
    const int NT = j_hi - j_lo;
    const int kbn = swa_jlo(nxt.P0, W) * KVBLK;
    const int qlo = cur.P0 + wid * QBLK, qm = qlo + r32 - 4 * hi;
    char* V_lds = lds; char* K_lds = lds + 2 * SHM_V;
    float* ws = (float*)(lds + 2 * SHM_V + 2 * SHM_K) + wid * 64; float* li_l = ws, * al_l = ws + 32;
    float m_reg = -1e30f, l_reg = 0; f32x16 o[4] = {};
    const int sr = tid >> 4, sc = (tid & 15) * 8, vst0 = v_st(sr, sc), vst1 = v_st(32 + sr, sc), kws = KSWZ(sr, sc * 2);
    const int vb0 = (int)(uintptr_t)V_lds + v_rd_base(lane);
    const TIn* Kh = cur.K; const TIn* Vh = cur.V;
#define RESC(a) do { if (__any((a) < 1.f)) { if (hi == 0) al_l[r32] = (a); asm volatile("s_waitcnt lgkmcnt(0)" ::: "memory");              \
                     for (int d_ = 0; d_ < 4; ++d_) for (int r = 0; r < 16; ++r) o[d_][r] *= al_l[crow(r, hi)]; } } while (0)
#define KBASE(t) ((j_lo + (t)) * KVBLK)
#define ACT(t) (KBASE(t) <= qlo + QBLK - 1 && KBASE(t) + KVBLK - 1 >= qlo - W + 1)
#define MASKT(P0_, P1_, t) do { const int kb_ = KBASE(t); if ((!SK || ACT(t)) && (kb_ + KVBLK - 1 > qlo || kb_ <= qlo + QBLK - 1 - W)) mask_tile(P0_, P1_, qm - kb_, (unsigned)W); } while (0)
    constexpr int NQL = F32 ? 16 : 8;
    constexpr bool SK = WSKIP && !F32;
#define SEAM_K0() do { VMWN(NQL); if constexpr (F32) { SWRITE_KF(0); SBAR(); SLOAD_F((const float*)nxt.V, kbn); } else { SWRITE_HK(0); } SBAR(); } while (0)
    f32x16 pA0, pA1, pB0, pB1; float mnA, mnB, alA, alB; bf16x8 pa0, pa1, pa2, pa3;
    if constexpr (F32) { VMW(); SWRITE_VF(0); SBAR(); } else { SWRITE_HV(0); SBAR(); }
    if (NT > 1) { if constexpr (F32) SLOAD_F((const float*)Kh, KBASE(1)); else SLOAD_H(Kh, Vh, KBASE(1)); }
    SBAR(); qkt<0, SK>(pA0, pA1, K_lds, r32, hi, S.qr, ACT(0));
    if constexpr (F32) { if (NT > 1) { VMW(); SWRITE_KF(1); SBAR(); SLOAD_F((const float*)Vh, KBASE(1)); } }
    MASKT(pA0, pA1, 0); partialSM(pA0, pA1, m_reg, mnA, alA);
    if (NT > 1) { VMW(); if constexpr (F32) { SWRITE_VF(1); SBAR(); if (NT > 2) SLOAD_F((const float*)Kh, KBASE(2)); } else SWRITE_H(1); }
    __syncthreads();
#define HALF_STEP(PX0, PX1, mnX, alX, PY0, PY1, alY, t, KB, VB, SB) do {                                                      \
        SBAR(); qkt<KB, SK>(PX0, PX1, K_lds, r32, hi, S.qr, ACT(t));                                             \
        finishSM(PY0, PY1, alY, l_reg, pa0, pa1, pa2, pa3); SBAR();                                                           \
        if ((t) + 1 < NT) { if constexpr (F32) { VMW(); SWRITE_KF(SB); SBAR(); SLOAD_F((const float*)Vh, KBASE((t) + 1)); }  \
                            else { SLOAD_H(Kh, Vh, KBASE((t) + 1)); } SBAR(); }                                               \
        pv_tile<VB, SK>(o, vb0, pa0, pa1, pa2, pa3, ACT((t) - 1)); MASKT(PX0, PX1, (t)); partialSM(PX0, PX1, m_reg, mnX, alX);                                        \
        __syncthreads();                                                                                                      \
        if ((t) + 1 < NT) { VMW(); if constexpr (F32) { SWRITE_VF(SB); SBAR(); if ((t) + 2 < NT) SLOAD_F((const float*)Kh, KBASE((t) + 2)); } \
                            else { SWRITE_H(SB); } }                                                                          \
        RESC(alX); __syncthreads(); } while (0)
    for (int t = 1; t + 1 < NT; t += 2) {
        HALF_STEP(pB0, pB1, mnB, alB, pA0, pA1, alA, t, 1, 0, 0);
        HALF_STEP(pA0, pA1, mnA, alA, pB0, pB1, alB, t + 1, 0, 1, 1);
    }
    const bool even = (NT & 1) == 0;
    if (even) { SBAR(); qkt<1, SK>(pB0, pB1, K_lds, r32, hi, S.qr, ACT(NT - 1)); SBAR(); }
#define QROW(e) (nxt.Q + (size_t)(wid * QBLK + r32) * D + ((e) >> 1) * 16 + hi * 8 + ((e) & 1) * 4)
    if constexpr (F32) { SLOAD_F((const float*)nxt.K, kbn); SBAR();
#pragma unroll
        for (int e = 0; e < 8; ++e) S.tq[e] = *(const f32x4*)QROW(e); }
    else { SLOAD_H(nxt.K, nxt.V, kbn); SBAR();
#pragma unroll
        for (int d0 = 0; d0 < 8; ++d0) S.qr[d0] = load8<TIn>(nxt.Q + (size_t)(wid * QBLK + r32) * D + d0 * 16 + hi * 8); }
    SBAR();
    finishSM(pA0, pA1, alA, l_reg, pa0, pa1, pa2, pa3); SBAR();
    if constexpr (F32) {
#pragma unroll
        for (int e = 8; e < 16; ++e) S.tq[e] = *(const f32x4*)QROW(e); SBAR(); }
#undef QROW
    pv_tile<0, SK>(o, vb0, pa0, pa1, pa2, pa3, ACT(even ? NT - 2 : NT - 1));
    if (even) { MASKT(pB0, pB1, NT - 1); partialSM(pB0, pB1, m_reg, mnB, alB); __syncthreads(); RESC(alB);
        finishSM(pB0, pB1, alB, l_reg, pa0, pa1, pa2, pa3); SBAR(); pv_tile<1, SK>(o, vb0, pa0, pa1, pa2, pa3, ACT(NT - 1)); }
    SBAR(); SEAM_K0();
    if (hi == 0) { li_l[r32] = l_reg; ((float*)(lse_base + (((const char*)cur.O - og_base) >> 6)))[wid * QBLK + r32] = m_reg * SCALE + __logf(l_reg); } asm volatile("s_waitcnt lgkmcnt(0)" ::: "memory");
    float rli[16];
#pragma unroll
    for (int r = 0; r < 16; ++r) rli[r] = __builtin_amdgcn_rcpf(li_l[crow(r, hi)]);
    TOut* Ow = cur.O + (size_t)(wid * QBLK) * D;
    unsigned short* ostg = (unsigned short*)(lds + O_STAGE_OFF) + wid * (QBLK * D);
#pragma unroll
    for (int r = 0; r < 16; ++r) { const int orow = crow(r, hi);
#pragma unroll
        for (int d0 = 0; d0 < 4; ++d0) { const float v = o[d0][r] * rli[r];
            if constexpr (same_t<TOut, float>::v) { Ow[(size_t)orow * D + d0 * 32 + r32] = v; }
            else { ostg[orow * D + d0 * 32 + r32] = (unsigned short)cvtpk(v, v); } } }
    if constexpr (!same_t<TOut, float>::v) {
#pragma unroll
        for (int i = 0; i < 8; ++i) { const int row = i * 4 + (lane >> 4), ch = lane & 15; const u32x4 w = *(const u32x4*)(ostg + row * D + ch * 8); *(u32x4*)(Ow + (size_t)row * D + ch * 8) = w; } }
    if constexpr (F32) {
#pragma unroll
        for (int d0 = 0; d0 < 8; ++d0) S.qr[d0] = pack8(S.tq[2 * d0], S.tq[2 * d0 + 1]); }
    __syncthreads();
#undef RESC
#undef KBASE
#undef ACT
#undef MASKT
#undef SEAM_K0
#undef HALF_STEP
}
#undef ROW
#undef VMW
#undef VMWN
#undef SLOAD_H
#undef SWRITE_HK
#undef SWRITE_HV
#undef SWRITE_H
#undef SLOAD_F
#undef SWRITE_KF
#undef SWRITE_VF


}
namespace att2 {
typedef short bf16x8 __attribute__((ext_vector_type(8)));
typedef short s16x4 __attribute__((ext_vector_type(4)));
typedef float f32x4 __attribute__((ext_vector_type(4)));
typedef unsigned u32x2 __attribute__((ext_vector_type(2)));
#define A2_LAS __attribute__((address_space(3)))
constexpr int SLOT_BYTES = 128 * 256, K_OFF = 0, V_OFF = 2 * SLOT_BYTES;
constexpr float SCALE = 0.08838834764831845f, C2 = 1.4426950408889634f * SCALE;
__device__ __forceinline__ unsigned off_b(unsigned row, unsigned ch) { return 256u * row + 16u * (ch ^ (((row & 3u) << 2) | ((row >> 2) & 3u))); }
struct Item { size_t e; int g, blk; };
__device__ __forceinline__ Item decode(int I) {
    const int g = I >> 11, rem = I & 2047, lb = 6 - 2 * g, chain = rem >> lb, blk = rem & ((1 << lb) - 1), Lg = SEQ >> (2 * g);
    Item it; it.e = (size_t)chain * Lg * HEAD_DIM + (size_t)blk * 128 * HEAD_DIM; it.g = g; it.blk = blk; return it;
}
constexpr size_t SUB = (size_t)M_TOK * D_MODEL;
#define A2_Q(it) (qkvc + (size_t)((it).g * 3 + 0) * SUB + (it).e)
#define A2_K(it) (qkvc + (size_t)((it).g * 3 + 1) * SUB + (it).e)
#define A2_V(it) (qkvc + (size_t)((it).g * 3 + 2) * SUB + (it).e)
__device__ __forceinline__ void ld_block(const unsigned short* blk, int tid, bf16x8 (&r)[4]) {
#pragma unroll
    for (int i = 0; i < 4; ++i) { const int piece = 512 * i + tid; r[i] = *(const bf16x8*)(blk + (size_t)(piece >> 4) * HEAD_DIM + (piece & 15) * 8); }
}
__device__ __forceinline__ void st_block(A2_LAS unsigned char* slot, int tid, const bf16x8 (&r)[4]) {
#pragma unroll
    for (int i = 0; i < 4; ++i) { const int piece = 512 * i + tid; *(A2_LAS bf16x8*)(slot + off_b((unsigned)(piece >> 4), (unsigned)(piece & 15))) = r[i]; }
}
__device__ __forceinline__ unsigned cvtpk(float lo, float hi) { unsigned r; asm volatile("v_cvt_pk_bf16_f32 %0, %1, %2" : "=v"(r) : "v"(lo), "v"(hi)); return r; }
__device__ __forceinline__ float xmax16(float v) { const auto r = __builtin_amdgcn_permlane16_swap(__float_as_uint(v), __float_as_uint(v), false, false); return fmaxf(__uint_as_float(r[0]), __uint_as_float(r[1])); }
__device__ __forceinline__ float xmax32(float v) { const auto r = __builtin_amdgcn_permlane32_swap(__float_as_uint(v), __float_as_uint(v), false, false); return fmaxf(__uint_as_float(r[0]), __uint_as_float(r[1])); }
__device__ __forceinline__ float xadd16(float v) { const auto r = __builtin_amdgcn_permlane16_swap(__float_as_uint(v), __float_as_uint(v), false, false); return __uint_as_float(r[0]) + __uint_as_float(r[1]); }
__device__ __forceinline__ float xadd32(float v) { const auto r = __builtin_amdgcn_permlane32_swap(__float_as_uint(v), __float_as_uint(v), false, false); return __uint_as_float(r[0]) + __uint_as_float(r[1]); }
#define A2_WAITV(n) asm volatile("s_waitcnt vmcnt(" #n ")" ::: "memory")
#define A2_BAR() do { asm volatile("s_waitcnt lgkmcnt(0)" ::: "memory"); __builtin_amdgcn_s_barrier(); asm volatile("" ::: "memory"); } while (0)

__device__ __forceinline__ void attn_phase(A2_LAS unsigned char* lds, const unsigned short* qkvc, unsigned short* og, float* lse, int I0, int I1) {
    int tid = threadIdx.x; asm volatile("" : "+v"(tid));
    const int wid = __builtin_amdgcn_readfirstlane(tid >> 6), lane = tid & 63, li = lane & 15, g = lane >> 4;
    if (I0 >= I1) return;
    Item cur = decode(I0);
    bf16x8 kr[4], vr[4], qf[4], qn[4];
    { ld_block(A2_K(cur), tid, kr); ld_block(A2_V(cur), tid, vr); st_block(lds + K_OFF, tid, kr); st_block(lds + V_OFF, tid, vr);
      if (cur.blk > 0) { ld_block(A2_K(cur) - 128 * HEAD_DIM, tid, kr); ld_block(A2_V(cur) - 128 * HEAD_DIM, tid, vr); }
      else {
#pragma unroll
          for (int i = 0; i < 4; ++i) { kr[i] = (bf16x8){0, 0, 0, 0, 0, 0, 0, 0}; vr[i] = kr[i]; } }
      st_block(lds + K_OFF + SLOT_BYTES, tid, kr); st_block(lds + V_OFF + SLOT_BYTES, tid, vr);
#pragma unroll
      for (int s = 0; s < 4; ++s) qf[s] = *(const bf16x8*)(A2_Q(cur) + (size_t)(16 * wid + li) * HEAD_DIM + 32 * s + 8 * g); }
    Item nxt = (I0 + 1 < I1) ? decode(I0 + 1) : cur;
    ld_block(A2_K(nxt), tid, kr); ld_block(A2_V(nxt), tid, vr);
#pragma unroll
    for (int s = 0; s < 4; ++s) qn[s] = *(const bf16x8*)(A2_Q(nxt) + (size_t)(16 * wid + li) * HEAD_DIM + 32 * s + 8 * g);
    for (int I = I0, n = 0; I < I1; ++I, ++n) {
        const int cs = n & 1;
        const bool more = I + 1 < I1; const Item nn = (I + 2 < I1) ? decode(I + 2) : nxt;
        A2_BAR();
        f32x4 st[9];
#ifndef A2_QK_RPT
#define A2_QK_RPT 1
#endif
        for (int qrep = 0; qrep < A2_QK_RPT; ++qrep)
#pragma unroll
        for (int t = 0; t < 9; ++t) { const int T = wid + t; const unsigned prow = (unsigned)((((T >> 3) ^ cs ^ 1) << 7) + ((16 * T + li) & 127));
            const unsigned k0 = 256u * prow + ((((unsigned)g) ^ (((prow & 3u) << 2) | ((prow >> 2) & 3u))) << 4);
            f32x4 acc = {0.f, 0.f, 0.f, 0.f};
#pragma unroll
            for (int s = 0; s < 4; ++s) { const bf16x8 kf = *(const A2_LAS bf16x8*)(lds + K_OFF + (k0 ^ ((unsigned)s << 6))); acc = __builtin_amdgcn_mfma_f32_16x16x32_bf16(kf, qf[s], acc, 0, 0, 0); }
            st[t] = acc; }
#pragma unroll
        for (int r = 0; r < 4; ++r) { st[0][r] = (4 * g + r >= li) ? st[0][r] : -__builtin_inff(); st[8][r] = (4 * g + r <= li) ? st[8][r] : -__builtin_inff(); }
        if (cur.blk == 0) {
#pragma unroll
            for (int t = 0; t < 9; ++t) { const float lim = (wid + t < 8) ? -__builtin_inff() : __builtin_inff();
                st[t] = __builtin_elementwise_min(st[t], (f32x4){lim, lim, lim, lim}); } }
        float mx = -1e30f;
#pragma unroll
        for (int t = 0; t < 9; ++t) mx = fmaxf(mx, fmaxf(fmaxf(st[t][0], st[t][1]), fmaxf(st[t][2], st[t][3])));
        mx = xmax32(xmax16(mx));
        float lsum = 0.f; const float mb = -mx * C2;
        f32x4 ls4 = {0.f, 0.f, 0.f, 0.f};
#pragma unroll
        for (int t = 0; t < 9; ++t) { const f32x4 a = st[t] * C2 + mb;
            st[t] = (f32x4){__builtin_amdgcn_exp2f(a[0]), __builtin_amdgcn_exp2f(a[1]), __builtin_amdgcn_exp2f(a[2]), __builtin_amdgcn_exp2f(a[3])}; ls4 += st[t]; }
        lsum = (ls4[0] + ls4[1]) + (ls4[2] + ls4[3]);
        lsum = xadd32(xadd16(lsum));
        bf16x8 pf[5];
#pragma unroll
        for (int ks = 0; ks < 5; ++ks) { const unsigned a0 = cvtpk(st[2 * ks][0], st[2 * ks][1]), a1 = cvtpk(st[2 * ks][2], st[2 * ks][3]), b0 = ks < 4 ? cvtpk(st[ks < 4 ? 2 * ks + 1 : 0][0], st[ks < 4 ? 2 * ks + 1 : 0][1]) : 0u, b1 = ks < 4 ? cvtpk(st[ks < 4 ? 2 * ks + 1 : 0][2], st[ks < 4 ? 2 * ks + 1 : 0][3]) : 0u;
            const unsigned __attribute__((ext_vector_type(4))) w = {a0, a1, b0, b1}; pf[ks] = __builtin_bit_cast(bf16x8, w); }
        f32x4 o[8];
#pragma unroll
        for (int c = 0; c < 8; ++c) o[c] = (f32x4){0.f, 0.f, 0.f, 0.f};
        const unsigned vbase = (unsigned)(uintptr_t)(lds + V_OFF);
#pragma unroll
        for (int ks = 0; ks < 5; ++ks) {
            unsigned v0a[2];
#pragma unroll
            for (int t2 = 0; t2 < (ks < 4 ? 2 : 1); ++t2) { const int T = wid + 2 * ks + t2; const unsigned row = (unsigned)((((T >> 3) ^ cs ^ 1) << 7) + ((16 * T + 4 * g + (li >> 2)) & 127));
                v0a[t2] = vbase + 256u * row + ((((unsigned)(li & 3) >> 1) ^ (((row & 3u) << 2) | ((row >> 2) & 3u))) << 4) + 8u * (unsigned)(li & 1); }
            s16x4 va[8], vb[8];
#pragma unroll
            for (int c = 0; c < 8; ++c) {
                asm volatile("ds_read_b64_tr_b16 %0, %1" : "=v"(va[c]) : "v"(v0a[0] ^ ((unsigned)c << 5)) : "memory");
                if (ks < 4) asm volatile("ds_read_b64_tr_b16 %0, %1" : "=v"(vb[c]) : "v"(v0a[1] ^ ((unsigned)c << 5)) : "memory"); else vb[c] = (s16x4){0, 0, 0, 0}; }
            asm volatile("s_waitcnt lgkmcnt(0)" : "+v"(va[0]), "+v"(va[1]), "+v"(va[2]), "+v"(va[3]), "+v"(va[4]), "+v"(va[5]), "+v"(va[6]), "+v"(va[7]), "+v"(vb[0]), "+v"(vb[1]), "+v"(vb[2]), "+v"(vb[3]), "+v"(vb[4]), "+v"(vb[5]), "+v"(vb[6]), "+v"(vb[7]) :: "memory");
#pragma unroll
            for (int c = 0; c < 8; ++c) { const bf16x8 vf = {va[c][0], va[c][1], va[c][2], va[c][3], vb[c][0], vb[c][1], vb[c][2], vb[c][3]};
                o[c] = __builtin_amdgcn_mfma_f32_16x16x32_bf16(vf, pf[ks], o[c], 0, 0, 0); }
        }
        A2_BAR();
        st_block(lds + K_OFF + (cs ^ 1) * SLOT_BYTES, tid, kr); ld_block(A2_K(nn), tid, kr);
        st_block(lds + V_OFF + (cs ^ 1) * SLOT_BYTES, tid, vr); ld_block(A2_V(nn), tid, vr);
#pragma unroll
        for (int s = 0; s < 4; ++s) { qf[s] = qn[s]; qn[s] = *(const bf16x8*)(A2_Q(nn) + (size_t)(16 * wid + li) * HEAD_DIM + 32 * s + 8 * g); }
        const float inv = __builtin_amdgcn_rcpf(lsum);
        unsigned short* orow = og + (size_t)cur.g * SUB + cur.e + (size_t)(16 * wid + li) * HEAD_DIM + 4 * g;
#pragma unroll
        for (int c = 0; c < 8; ++c) { const f32x4 ov = o[c] * inv; u32x2 w; w.x = cvtpk(ov[0], ov[1]); w.y = cvtpk(ov[2], ov[3]); *(u32x2*)(orow + 16 * c) = w; }
        if (g == 0) lse[(size_t)cur.g * ((size_t)M_TOK * NHEAD) + (cur.e >> 7) + 16 * wid + li] = mx * SCALE + __logf(lsum);
        (void)more; cur = nxt; nxt = nn;
    }
    A2_BAR();
}
#undef A2_WAITV
#undef A2_BAR
#undef A2_LAS
#undef A2_Q
#undef A2_K
#undef A2_V
}
constexpr int NWAVES = 8;
#ifndef MK_PER_PHASE
#define MK_PER_PHASE 0
#endif
constexpr int PH_PER_PAIR = 14, NPHASES = 2 + 2 * PH_PER_PAIR;

constexpr size_t MiB = 1u << 20;
constexpr size_t WS_CTL = 0, CTL_ZERO_BYTES = 1 * MiB;
constexpr size_t WS_MODP = 1 * MiB;
constexpr size_t WS_MODR = 4 * MiB;
constexpr size_t WS_RS = 5 * MiB;
constexpr size_t WS_EIDX = 7 * MiB, WS_GATE = 7 * MiB + 256 * 1024, WS_SLOTOF = 7 * MiB + 512 * 1024, WS_STOK = 8 * MiB;
constexpr size_t WS_LSE = 9 * MiB;
constexpr size_t WS_ROPE = 12 * MiB;
constexpr size_t WS_WQKV = 16 * MiB, WS_WO = 52 * MiB, WS_WGU = 56 * MiB, WS_WDN = 78 * MiB, WS_WPOOL = 89 * MiB, WS_WMGU = 90 * MiB, WS_WMDN = 314 * MiB;
constexpr size_t WS_XB = 432 * MiB;
constexpr size_t WS_H = 560 * MiB;
constexpr size_t WS_BIG = 624 * MiB;
constexpr size_t WS_QKVC = WS_BIG, WS_OG = WS_BIG + 576 * MiB;
constexpr size_t WS_ACT = WS_BIG;
constexpr size_t WS_Y = WS_BIG + 480 * MiB;
constexpr size_t WS_END = WS_BIG + 768 * MiB;
constexpr int MAX_TILES = 2 * M_TOK / 256 + N_EXP, MAX_SLOTS = MAX_TILES * 256;
static_assert(WS_ACT + (size_t)MAX_SLOTS * D_FFE * 2 <= WS_Y && WS_Y + (size_t)MAX_SLOTS * D_MODEL * 2 <= WS_END && WS_STOK + (size_t)MAX_SLOTS * 4 <= WS_LSE, "d_ws map");
constexpr int CW_BAR = 4096;
constexpr int CW_CMAXO = 90112;
constexpr int CW_CMAX = 65536;
constexpr int CW_CNT = 8192, CW_CUR = 12288;

constexpr int RING_OFF = 0, RING_BYTES = 131072;
constexpr int TAB_OFF = RING_BYTES;
constexpr int MISC_OFF = TAB_OFF + 8192 + 16384;
constexpr int LDS_BYTES = 159744;
static_assert(MISC_OFF + 128 <= LDS_BYTES && LDS_BYTES <= 163840 && 69632 + 65536 <= MISC_OFF, "LDS map (the attention phase stages its O tile at [69632, 135168))");

#define GAS __attribute__((address_space(1)))
#define LAS __attribute__((address_space(3)))
typedef unsigned short bf16;
typedef unsigned v4u __attribute__((ext_vector_type(4)));
typedef unsigned v2u __attribute__((ext_vector_type(2)));
typedef int v2i __attribute__((ext_vector_type(2)));
typedef float f32x4 __attribute__((ext_vector_type(4)));
typedef float f32x2 __attribute__((ext_vector_type(2)));
#define LDS_WAIT() asm volatile("s_waitcnt lgkmcnt(0)" ::: "memory")
#define VM_WAIT() asm volatile("s_waitcnt vmcnt(0)" ::: "memory")
__device__ __forceinline__ unsigned pk2(float lo, float hi) { return pg8::cvt_pk_bf16(lo, hi); }
__device__ __forceinline__ float bflo(unsigned w) { return __uint_as_float(w << 16); }
__device__ __forceinline__ float bfhi(unsigned w) { return __uint_as_float(w & 0xffff0000u); }
#define MK_DPP(v, ctrl) __uint_as_float((unsigned)__builtin_amdgcn_update_dpp(0, (int)__float_as_uint(v), (ctrl), 0xf, 0xf, true))
__device__ __forceinline__ float wave_sum(float v) {
    v += MK_DPP(v, 0xB1); v += MK_DPP(v, 0x4E); v += MK_DPP(v, 0x141); v += MK_DPP(v, 0x140);
    { const auto r = __builtin_amdgcn_permlane16_swap(__float_as_uint(v), __float_as_uint(v), false, false); v = __uint_as_float(r[0]) + __uint_as_float(r[1]); }
    { const auto r = __builtin_amdgcn_permlane32_swap(__float_as_uint(v), __float_as_uint(v), false, false); v = __uint_as_float(r[0]) + __uint_as_float(r[1]); }
    return v;
}
__device__ __forceinline__ float wave_max(float v) {
    v = fmaxf(v, MK_DPP(v, 0xB1)); v = fmaxf(v, MK_DPP(v, 0x4E)); v = fmaxf(v, MK_DPP(v, 0x141)); v = fmaxf(v, MK_DPP(v, 0x140));
    { const auto r = __builtin_amdgcn_permlane16_swap(__float_as_uint(v), __float_as_uint(v), false, false); v = fmaxf(__uint_as_float(r[0]), __uint_as_float(r[1])); }
    { const auto r = __builtin_amdgcn_permlane32_swap(__float_as_uint(v), __float_as_uint(v), false, false); v = fmaxf(__uint_as_float(r[0]), __uint_as_float(r[1])); }
    return v;
}
__device__ __forceinline__ int rdlane_i(int v, int l) { return __builtin_amdgcn_readlane(v, l); }
__device__ __forceinline__ float rdlane_f(float v, int l) { return __uint_as_float((unsigned)__builtin_amdgcn_readlane((int)__float_as_uint(v), l)); }

#define XB_TMO      128
#define XB_XCNT(j)  (256  + 64 * (j))
#define XB_XSUB(j)  (1280 + 64 * (j))
#define XB_XGEN(j)  (2304 + 64 * (j))
#define XB_TOP      3328
#define XB_TOPGEN   3392
#define XCD_BAR_WORDS 3456
#define XB_SPIN_CAP (1u << 18)

__device__ __forceinline__ unsigned xb_ld(unsigned* p)              { return __hip_atomic_load(p, __ATOMIC_RELAXED, __HIP_MEMORY_SCOPE_AGENT); }
__device__ __forceinline__ unsigned xb_add(unsigned* p, unsigned v) { return __hip_atomic_fetch_add(p, v, __ATOMIC_RELAXED, __HIP_MEMORY_SCOPE_AGENT); }
__device__ __forceinline__ unsigned xb_xcc_id() { return (unsigned)__builtin_amdgcn_s_getreg((3 << 11) | 20) & 0xFu; }
#define XB_SPIN(cond, bar) do { unsigned _sp = 0; while (cond) { __builtin_amdgcn_s_sleep(1); \
    if ((++_sp & 255u) == 0u) { if (xb_ld(&(bar)[XB_TMO])) break; if (_sp > XB_SPIN_CAP) { atomicAdd(&(bar)[XB_TMO], 1u); break; } } } } while (0)

struct XcdBarrier {
    unsigned* bar; unsigned x;
    volatile LAS unsigned* st;
};

__device__ __forceinline__ XcdBarrier xcd_barrier_post(unsigned* bar, volatile LAS unsigned* st) {
    XcdBarrier b; b.bar = bar; b.x = xb_xcc_id(); b.st = st;
    if (threadIdx.x == 0) (void)xb_add(&bar[XB_XCNT(b.x)], 1u);
    return b;
}
__device__ __forceinline__ void xcd_barrier_complete(unsigned* bar, unsigned x, unsigned& nloc, unsigned& nx) {
    const unsigned G = gridDim.x * gridDim.y * gridDim.z;
    unsigned sum, cnt, mine, sp = 0u;
    for (;;) {
        sum = 0u; cnt = 0u; mine = 0u;
#pragma unroll
        for (unsigned j = 0; j < 16; ++j) { const unsigned c = xb_ld(&bar[XB_XCNT(j)]); sum += c; cnt += (c > 0u) ? 1u : 0u; mine = (j == x) ? c : mine; }
        if (sum == G) break;
        __builtin_amdgcn_s_sleep(1);
        if ((++sp & 255u) == 0u) { if (xb_ld(&bar[XB_TMO])) break; if (sp > XB_SPIN_CAP) { atomicAdd(&bar[XB_TMO], 1u); break; } }
    }
    nloc = mine > 0u ? mine : 1u; nx = cnt > 0u ? cnt : 1u;
}

template <class F> __device__ __forceinline__ void xcd_barrier(const XcdBarrier& b, F work) {
    asm volatile("s_waitcnt vmcnt(0)" ::: "memory");
    __syncthreads();
    if (threadIdx.x >= 64) work();
    if (threadIdx.x == 0) {
        unsigned* bar = b.bar;
        __builtin_amdgcn_s_waitcnt(0);
        unsigned nloc = b.st[0], nx = b.st[1];
        if (nloc == 0u) { xcd_barrier_complete(bar, b.x, nloc, nx); b.st[0] = nloc; b.st[1] = nx; }
        const unsigned old = xb_add(&bar[XB_XSUB(b.x)], 1u);
        const unsigned gen = old / nloc;
        if (old + 1u == (gen + 1u) * nloc) {
            __builtin_amdgcn_fence(__ATOMIC_RELEASE, "agent");
            asm volatile("s_waitcnt vmcnt(0)" ::: "memory");
            const unsigned og = xb_add(&bar[XB_TOP], 1u);
            const unsigned tg = og / nx;
            if (og + 1u == (tg + 1u) * nx) xb_add(&bar[XB_TOPGEN], 1u);
            else XB_SPIN(xb_ld(&bar[XB_TOPGEN]) == tg, bar);
            __builtin_amdgcn_fence(__ATOMIC_ACQUIRE, "agent");
            xb_add(&bar[XB_XGEN(b.x)], 1u);
            asm volatile("s_waitcnt vmcnt(0)" ::: "memory");
        } else {
            XB_SPIN(xb_ld(&bar[XB_XGEN(b.x)]) == gen, bar);
            __builtin_amdgcn_fence(__ATOMIC_ACQUIRE, "agent");
            asm volatile("s_waitcnt vmcnt(0)" ::: "memory");
        }
    }
    __syncthreads();
}
__device__ __forceinline__ void xcd_barrier(const XcdBarrier& b) { xcd_barrier(b, [] {}); }
using pg8::mod4; using pg8::mod4p;
__device__ __forceinline__ int gu_row(int n0, int F) { return n0 < F ? (n0 >> 7) * 256 + (n0 & 127) : ((n0 - F) >> 7) * 256 + 128 + ((n0 - F) & 127); }
struct TrItem { const float* W; bf16* WT; int N, Kd; };
__device__ __forceinline__ void tr_load(const TrItem& t, int lane, f32x4 (&r)[8]) {
    const float* p = t.W + (size_t)(lane >> 3) * t.N + 4 * (lane & 7);
#pragma unroll
    for (int i = 0; i < 8; ++i) r[i] = *(const GAS f32x4*)(p + (size_t)(8 * i) * t.N);
}
__device__ __forceinline__ void tr_store(const TrItem& t, int lane, const f32x4 (&r)[8], LAS float* scr) {
    LAS float* w = scr + (lane >> 3) * 33 + 4 * (lane & 7);
#pragma unroll
    for (int i = 0; i < 8; ++i) { LAS float* q = w + (8 * i) * 33; q[0] = r[i].x; q[1] = r[i].y; q[2] = r[i].z; q[3] = r[i].w; }
    LDS_WAIT(); asm volatile("" ::: "memory");
    const int c = lane & 7;
#pragma unroll
    for (int j = 0; j < 4; ++j) { const int n = (lane >> 3) + 8 * j; const LAS float* s = scr + (8 * c) * 33 + n;
        v4u o; o.x = pk2(s[0 * 33], s[1 * 33]); o.y = pk2(s[2 * 33], s[3 * 33]); o.z = pk2(s[4 * 33], s[5 * 33]); o.w = pk2(s[6 * 33], s[7 * 33]);
        *(GAS v4u*)(t.WT + (size_t)n * t.Kd + 8 * c) = o; }
    LDS_WAIT(); asm volatile("" ::: "memory");
}
struct TrItem8 { const float* W; unsigned char* WT; int N, Kd, f6; };
__device__ __forceinline__ void tr8_load(const TrItem8& t, int lane, f32x4 (&r)[8]) {
    const float* p = t.W + (size_t)(lane >> 2) * t.N + 4 * (lane & 3);
#pragma unroll
    for (int i = 0; i < 8; ++i) r[i] = *(const GAS f32x4*)(p + (size_t)(16 * i) * t.N);
}
typedef float v16f __attribute__((ext_vector_type(16)));
typedef unsigned v6u __attribute__((ext_vector_type(6)));
__device__ __forceinline__ unsigned f6_scale_byte(float am) { return (__float_as_uint(am * (1.0f / 7.5f)) + 0x7FFFFFu) >> 23; }
__device__ __forceinline__ float f6_inv(unsigned sb) { return __uint_as_float((254u - sb) << 23); }
__device__ __forceinline__ void tr6_store(const TrItem8& t, int lane, const f32x4 (&r)[8], LAS float* scr) {
    LAS float* w = scr + (lane >> 2) * 17 + 4 * (lane & 3);
#pragma unroll
    for (int i = 0; i < 8; ++i) { LAS float* q = w + (16 * i) * 17 + 8 * (i >> 1); q[0] = r[i].x; q[1] = r[i].y; q[2] = r[i].z; q[3] = r[i].w; }
    LDS_WAIT(); asm volatile("" ::: "memory");
    const int n = lane >> 2, fq = lane & 3; const LAS float* s = scr + (32 * fq) * 17 + 8 * fq + n;
    v16f s0, s1; float am = 0.f;
#pragma unroll
    for (int i = 0; i < 16; ++i) { const float a = s[i * 17], b = s[(16 + i) * 17]; s0[i] = a; s1[i] = b; am = fmaxf(am, fmaxf(fabsf(a), fabsf(b))); }
    const unsigned sb = f6_scale_byte(am); const float f = f6_inv(sb);
    s0 *= f; s1 *= f;
    const v6u c = __builtin_amdgcn_cvt_scalef32_2xpk16_fp6_f32(s0, s1, 1.0f);
    LAS unsigned char* stg = (LAS unsigned char*)scr + 10240;
    *(LAS v4u*)(stg + n * 144 + 16 * fq) = (v4u){c[0], c[1], c[2], c[3]}; *(LAS v4u*)(stg + n * 144 + 64 + 16 * fq) = (v4u){c[4], c[5], 0u, sb};
    LDS_WAIT(); asm volatile("" ::: "memory");
#pragma unroll
    for (int j = 0; j < 2; ++j) { const int row = (lane >> 3) + 8 * j, ch = lane & 7; *(GAS v4u*)(t.WT + (size_t)row * t.Kd + 16 * ch) = *(const LAS v4u*)(stg + row * 144 + 16 * ch); }
    LDS_WAIT(); asm volatile("" ::: "memory");
}
__device__ __forceinline__ void tr8_store(const TrItem8& t, int lane, const f32x4 (&r)[8], LAS float* scr) {
    LAS float* w = scr + (lane >> 2) * 17 + 4 * (lane & 3);
#pragma unroll
    for (int i = 0; i < 8; ++i) { LAS float* q = w + (16 * i) * 17; q[0] = r[i].x; q[1] = r[i].y; q[2] = r[i].z; q[3] = r[i].w; }
    LDS_WAIT(); asm volatile("" ::: "memory");
    const int c = lane & 7;
#pragma unroll
    for (int j = 0; j < 2; ++j) { const int n = (lane >> 3) + 8 * j; const LAS float* s = scr + (16 * c) * 17 + n; v4u o;
#pragma unroll
        for (int q = 0; q < 4; ++q) o[q] = pg8::cvt4_fp8(64.0f * s[(4 * q) * 17], 64.0f * s[(4 * q + 1) * 17], 64.0f * s[(4 * q + 2) * 17], 64.0f * s[(4 * q + 3) * 17]);
        *(GAS v4u*)(t.WT + (size_t)n * t.Kd + 16 * c) = o; }
    LDS_WAIT(); asm volatile("" ::: "memory");
}
struct ProIn { const float *c, *ada_w, *pool_w, *wqkv, *wo, *wgu, *wdn, *mgu, *mdn; const int* pos; };
#ifndef MOE_FP8
#define MOE_FP8 1
#endif
#ifndef QKV_FP8
#define QKV_FP8 1
#endif
#ifndef QKV_FP6
#define QKV_FP6 1
#endif
#ifndef MGU_FP6
#define MGU_FP6 0
#endif
#ifndef FFN_GU_FP8
#define FFN_GU_FP8 0
#endif
#ifndef FFN_GU_I8
#define FFN_GU_I8 1
#endif
#ifndef WO_I8
#define WO_I8 1
#endif
#ifndef FFN_DN_FP8
#define FFN_DN_FP8 1
#endif
constexpr int TI_QKV = QKV_FP8 ? 0 : 2 * 16 * 288, TI_WO = WO_I8 ? 0 : 2 * 16 * 32, TI_GU = (FFN_GU_FP8 || FFN_GU_I8) ? 0 : 2 * 16 * 176, TI_DN = FFN_DN_FP8 ? 0 : 2 * 44 * 32, TI_POOL = 8 * 4 * 8, TI_MGU = MOE_FP8 ? 0 : 16 * 16 * 224, TI_MDN = MOE_FP8 ? 0 : 16 * 56 * 32;
constexpr int TI_ALL = TI_QKV + TI_WO + TI_GU + TI_DN + TI_POOL + TI_MGU + TI_MDN;
constexpr int T8_MGU = MOE_FP8 ? 16 * 8 * 448 : 0, T8_MDN = MOE_FP8 ? 16 * 28 * 64 : 0, T8_QKV = QKV_FP8 ? 2 * 8 * 576 : 0, T8_GU = (FFN_GU_FP8 && !FFN_GU_I8) ? 2 * 8 * 352 : 0, T8_DN = FFN_DN_FP8 ? 2 * 22 * 64 : 0;
constexpr int T8_ALL = T8_MGU + T8_MDN + T8_QKV + T8_GU + T8_DN;
constexpr size_t MGU8_BYTES = (size_t)2 * D_FFE * D_MODEL * (MOE_FP8 ? 1 : 2), MDN8_BYTES = (size_t)D_MODEL * D_FFE * (MOE_FP8 ? 1 : 2);
constexpr size_t WO8_BYTES = (size_t)D_MODEL * D_MODEL * (WO_I8 ? 1 : 2);
constexpr size_t QKV8_BYTES = (size_t)QKV_W * D_MODEL * (QKV_FP8 ? 1 : 2);
constexpr size_t GU8_BYTES = (size_t)2 * D_FF * D_MODEL * ((FFN_GU_FP8 || FFN_GU_I8) ? 1 : 2), DN8_BYTES = (size_t)D_MODEL * D_FF * (FFN_DN_FP8 ? 1 : 2);
__device__ __forceinline__ TrItem8 tr8_decode(const ProIn& I, unsigned char* ws, int it) {
    TrItem8 t;
    if (it < T8_MGU) { const int je = it / (8 * 448), r = it % (8 * 448), kb = r / 448, nb = r % 448, k0 = 128 * kb, n0 = 16 * nb;
        t.f6 = MGU_FP6; t.W = I.mgu + (size_t)je * 1024 * 2 * D_FFE + (size_t)k0 * (2 * D_FFE) + n0; t.WT = ws + WS_WMGU + (size_t)je * MGU8_BYTES + (size_t)gu_row(n0, D_FFE) * D_MODEL + k0; t.N = 2 * D_FFE; t.Kd = D_MODEL; }
    else { it -= T8_MGU;
    if (it < T8_MDN) { const int je = it / (28 * 64), r = it % (28 * 64), kb = r / 64, nb = r % 64, k0 = 128 * kb, n0 = 16 * nb;
        t.f6 = 0; t.W = I.mdn + (size_t)je * D_FFE * 1024 + (size_t)k0 * 1024 + n0; t.WT = ws + WS_WMDN + (size_t)je * MDN8_BYTES + (size_t)n0 * D_FFE + k0; t.N = 1024; t.Kd = D_FFE; }
    else { it -= T8_MDN;
    if (it < T8_QKV) { const int j = it / (8 * 576), r = it % (8 * 576), kb = r / 576, nb = r % 576, k0 = 128 * kb, n0 = 16 * nb;
        t.f6 = QKV_FP6; t.W = I.wqkv + (size_t)j * 1024 * QKV_W + (size_t)k0 * QKV_W + n0; t.WT = ws + WS_WQKV + (size_t)j * QKV8_BYTES + (size_t)n0 * D_MODEL + k0; t.N = QKV_W; t.Kd = D_MODEL; }
    else { it -= T8_QKV;
    if (it < T8_GU) { const int j = it / (8 * 352), r = it % (8 * 352), kb = r / 352, nb = r % 352, k0 = 128 * kb, n0 = 16 * nb;
        t.f6 = 0; t.W = I.wgu + (size_t)j * 1024 * 2 * D_FF + (size_t)k0 * (2 * D_FF) + n0; t.WT = ws + WS_WGU + (size_t)j * GU8_BYTES + (size_t)gu_row(n0, D_FF) * D_MODEL + k0; t.N = 2 * D_FF; t.Kd = D_MODEL; }
    else { t.f6 = 0; it -= T8_GU; const int j = it / (22 * 64), r = it % (22 * 64), kb = r / 64, nb = r % 64, k0 = 128 * kb, n0 = 16 * nb;
        t.W = I.wdn + (size_t)j * D_FF * 1024 + (size_t)k0 * 1024 + n0; t.WT = ws + WS_WDN + (size_t)j * DN8_BYTES + (size_t)n0 * D_FF + k0; t.N = 1024; t.Kd = D_FF; } } } }
    return t;
}
__device__ __forceinline__ TrItem tr_decode(const ProIn& I, unsigned char* ws, int it) {
    const float* W; bf16* WT; int K, N, nblk, r; bool gu = false; int F = 0;
    if (it < TI_QKV) { const int j = it / (16 * 288); r = it % (16 * 288); K = 1024; N = QKV_W; nblk = 288; W = I.wqkv + (size_t)j * 1024 * QKV_W; WT = (bf16*)(ws + WS_WQKV) + (size_t)j * QKV_W * 1024; }
    else { it -= TI_QKV;
    if (it < TI_WO) { const int j = it / 512; r = it % 512; K = 1024; N = 1024; nblk = 32; W = I.wo + (size_t)j * 1024 * 1024; WT = (bf16*)(ws + WS_WO) + (size_t)j * 1024 * 1024; }
    else { it -= TI_WO;
    if (it < TI_GU) { const int j = it / (16 * 176); r = it % (16 * 176); K = 1024; N = 2 * D_FF; nblk = 176; gu = true; F = D_FF; W = I.wgu + (size_t)j * 1024 * 2 * D_FF; WT = (bf16*)(ws + WS_WGU) + (size_t)j * 2 * D_FF * 1024; }
    else { it -= TI_GU;
    if (it < TI_DN) { const int j = it / (44 * 32); r = it % (44 * 32); K = D_FF; N = 1024; nblk = 32; W = I.wdn + (size_t)j * D_FF * 1024; WT = (bf16*)(ws + WS_WDN) + (size_t)j * 1024 * D_FF; }
    else { it -= TI_DN;
    if (it < TI_POOL) { const int jg = it / 32; r = it % 32; K = 256; N = 256; nblk = 8; W = I.pool_w + (size_t)jg * 65536; WT = (bf16*)(ws + WS_WPOOL) + (size_t)jg * 65536; }
    else { it -= TI_POOL;
    if (it < TI_MGU) { const int je = it / (16 * 224); r = it % (16 * 224); K = 1024; N = 2 * D_FFE; nblk = 224; gu = true; F = D_FFE; W = I.mgu + (size_t)je * 1024 * 2 * D_FFE; WT = (bf16*)(ws + WS_WMGU) + (size_t)je * 2 * D_FFE * 1024; }
    else { it -= TI_MGU;
    { const int je = it / (56 * 32); r = it % (56 * 32); K = D_FFE; N = 1024; nblk = 32; W = I.mdn + (size_t)je * D_FFE * 1024; WT = (bf16*)(ws + WS_WMDN) + (size_t)je * 1024 * D_FFE; } } } } } } }
    const int kb = r / nblk, nb = r % nblk, k0 = 64 * kb, n0 = 32 * nb, drow = gu ? gu_row(n0, F) : n0;
    TrItem t; t.W = W + (size_t)k0 * N + n0; t.WT = WT + (size_t)drow * K + k0; t.N = N; t.Kd = K; return t;
}
__device__ __forceinline__ unsigned pack4_i8(float a, float b, float c, float d) {
    const int ia = __float2int_rn(a), ib = __float2int_rn(b), ic = __float2int_rn(c), id = __float2int_rn(d);
    return ((unsigned)ia & 255u) | (((unsigned)ib & 255u) << 8) | (((unsigned)ic & 255u) << 16) | ((unsigned)id << 24);
}
__device__ __forceinline__ void tri8_store(const TrItem8& t, int lane, const f32x4 (&r)[8], LAS float* scr, const float* cm) {
    LAS float* w = scr + (lane >> 2) * 17 + 4 * (lane & 3);
#pragma unroll
    for (int i = 0; i < 8; ++i) { LAS float* q = w + (16 * i) * 17; q[0] = r[i].x; q[1] = r[i].y; q[2] = r[i].z; q[3] = r[i].w; }
    LDS_WAIT(); asm volatile("" ::: "memory");
    const int c = lane & 7;
#pragma unroll
    for (int j = 0; j < 2; ++j) { const int n = (lane >> 3) + 8 * j; const float cmv = cm[n], sc = cmv > 0.f ? 127.0f / cmv : 0.f; const LAS float* s = scr + (16 * c) * 17 + n; v4u o;
#pragma unroll
        for (int q = 0; q < 4; ++q) o[q] = pack4_i8(sc * s[(4 * q) * 17], sc * s[(4 * q + 1) * 17], sc * s[(4 * q + 2) * 17], sc * s[(4 * q + 3) * 17]);
        *(GAS v4u*)(t.WT + (size_t)n * t.Kd + 16 * c) = o; }
    LDS_WAIT(); asm volatile("" ::: "memory");
}
constexpr int TQ_GU = FFN_GU_I8 ? 2 * 8 * 352 : 0, TQ_WO = WO_I8 ? 2 * 8 * 64 : 0;
__device__ __forceinline__ void ffn_gu_quant_phase(int gw, int NGW, int wave, int lane, LAS unsigned char* lds, const float* wgu, unsigned char* ws, const float* cmax, const float* wo, const float* cmaxo) {
    LAS float* scr = (LAS float*)(lds + RING_OFF + wave * 16384);
    for (int it = gw; it < TQ_GU; it += NGW) {
        const int j = it / (8 * 352), r = it % (8 * 352), kb = r / 352, nb = r % 352, k0 = 128 * kb, n0 = 16 * nb;
        TrItem8 t; t.f6 = 0; t.W = wgu + (size_t)j * 1024 * 2 * D_FF + (size_t)k0 * (2 * D_FF) + n0; t.WT = ws + WS_WGU + (size_t)j * GU8_BYTES + (size_t)gu_row(n0, D_FF) * D_MODEL + k0; t.N = 2 * D_FF; t.Kd = D_MODEL;
        f32x4 rr[8]; tr8_load(t, lane, rr); tri8_store(t, lane, rr, scr, cmax + j * 2 * D_FF + n0);
    }
    for (int it = gw; it < TQ_WO; it += NGW) {
        const int j = it / (8 * 64), r = it % (8 * 64), kb = r / 64, nb = r % 64, k0 = 128 * kb, n0 = 16 * nb;
        TrItem8 t; t.f6 = 0; t.W = wo + (size_t)j * D_MODEL * D_MODEL + (size_t)k0 * D_MODEL + n0; t.WT = ws + WS_WO + (size_t)j * WO8_BYTES + (size_t)n0 * D_MODEL + k0; t.N = D_MODEL; t.Kd = D_MODEL;
        f32x4 rr[8]; tr8_load(t, lane, rr); tri8_store(t, lane, rr, scr, cmaxo + j * D_MODEL + n0);
    }
}
constexpr int T8_MGUH = T8_MGU / 2, T8_MDNH = T8_MDN / 2, T8_QKVH = T8_QKV / 2, T8_DNH = T8_DN / 2, T8_PEREXP = 8 * 448;
constexpr int T8_IDLE_LO = T8_MGUH + 2 * T8_PEREXP, T8_IDLE_N = MOE_FP8 ? 6 * T8_PEREXP : 0;
constexpr int T8_PERSEAM = 256 * 7 * 2;
constexpr int T8_SEAM_A = T8_MGUH + T8_MDNH;
constexpr int T8_SEAM_B = T8_DNH + T8_QKVH + (MOE_FP8 ? 2 * T8_PEREXP : 0) + T8_MDNH, T8_SEAM_N = T8_SEAM_A + T8_SEAM_B, T8_PRO_N = T8_ALL - T8_IDLE_N - T8_SEAM_N, T8_SEAMS = 20;
static_assert(T8_SEAM_A == 12 * T8_PERSEAM && T8_SEAM_N <= T8_SEAMS * T8_PERSEAM, "barrier-slack share (written for 256 workgroups; deadlines: part A gate/up by barrier 11, its down by 12; part B from barrier 12: dense down by 17, QKV by 19, MoE gate/up by 25, MoE down by 26)");
static_assert(T8_GU == 0 && MOE_FP8 != 0, "t8_map is written for this configuration");
__device__ __forceinline__ int t8_map(int kind, int v) {
    constexpr int oMDN = T8_MGU, oQKV = T8_MGU + T8_MDN, oDN = T8_MGU + T8_MDN + T8_QKV + T8_GU;
    if (kind == 1) return T8_IDLE_LO + v;
    if (kind == 0) { if (v < T8_QKVH) return oQKV + v; v -= T8_QKVH; return oDN + v; }
    if (v < T8_MGUH) return v; v -= T8_MGUH; if (v < T8_MDNH) return oMDN + v; v -= T8_MDNH;
    if (v < T8_DNH) return oDN + T8_DNH + v; v -= T8_DNH; if (v < T8_QKVH) return oQKV + T8_QKVH + v; v -= T8_QKVH; if (v < 2 * T8_PEREXP) return T8_MGUH + v; v -= 2 * T8_PEREXP; return oMDN + T8_MDNH + v;
}
#ifndef PRO_F6_RPT
#define PRO_F6_RPT 1
#endif
template <int KIND> __device__ __forceinline__ void tr8_run(const ProIn& I, unsigned char* ws, LAS float* scr, int lane, int first, int stride) {
    constexpr int N = KIND == 1 ? T8_IDLE_N : T8_PRO_N;
    f32x4 ra[8], rb[8]; TrItem8 ua, ub; int it = first;
    if (it < N) {
        ua = tr8_decode(I, ws, t8_map(KIND, it)); tr8_load(ua, lane, ra);
        for (;;) {
            const int itb = it + stride; ub = tr8_decode(I, ws, t8_map(KIND, itb < N ? itb : it)); tr8_load(ub, lane, rb);
            if (ua.f6) { for (int r6 = 0; r6 < PRO_F6_RPT; ++r6) tr6_store(ua, lane, ra, scr); } else tr8_store(ua, lane, ra, scr);
            if (itb >= N) break;
            const int itc = itb + stride; ua = tr8_decode(I, ws, t8_map(KIND, itc < N ? itc : itb)); tr8_load(ua, lane, ra);
            if (ub.f6) { for (int r6 = 0; r6 < PRO_F6_RPT; ++r6) tr6_store(ub, lane, rb, scr); } else tr8_store(ub, lane, rb, scr);
            if (itc >= N) break;
            it = itc;
        }
    }
}
__device__ __forceinline__ void seam_convert(const ProIn& I, unsigned char* ws, LAS unsigned char* lds, int seam, int vcu, int G, int wave, int lane) {
    const int v = seam * (G * 14) + (vcu * 7 + (wave - 1)) * 2;
    if (seam < T8_SEAMS && v < T8_SEAM_N) { const TrItem8 u0 = tr8_decode(I, ws, t8_map(2, v)), u1 = tr8_decode(I, ws, t8_map(2, v + 1 < T8_SEAM_N ? v + 1 : v)); f32x4 r0[8], r1[8];
        tr8_load(u0, lane, r0); tr8_load(u1, lane, r1); LAS float* scr = (LAS float*)(lds + RING_OFF + wave * 16384);
        if (u0.f6) tr6_store(u0, lane, r0, scr); else tr8_store(u0, lane, r0, scr);
        if (u1.f6) tr6_store(u1, lane, r1, scr); else tr8_store(u1, lane, r1, scr); }
}
__device__ __forceinline__ void p0_prologue(const ProIn& I, unsigned char* ws, LAS unsigned char* lds, int gw, int NGW, int wave, int lane) {
    LAS float* scr = (LAS float*)(lds + RING_OFF + wave * 16384);
#ifdef PRO_PRETOUCH
    { float acc_ = 0.f; const size_t n1 = (size_t)16 * 1024 * 2 * D_FFE / 1024, n2 = (size_t)16 * D_FFE * 1024 / 1024, n3 = (size_t)2 * 1024 * QKV_W / 1024, n4 = (size_t)DEPTH * 1024 * 6 * D_MODEL / 1024;
      for (size_t i = (size_t)gw * 64 + lane; i < n1; i += (size_t)NGW * 64) acc_ += I.mgu[i * 1024];
      for (size_t i = (size_t)gw * 64 + lane; i < n2; i += (size_t)NGW * 64) acc_ += I.mdn[i * 1024];
      for (size_t i = (size_t)gw * 64 + lane; i < n3; i += (size_t)NGW * 64) acc_ += I.wqkv[i * 1024];
      for (size_t i = (size_t)gw * 64 + lane; i < n4; i += (size_t)NGW * 64) acc_ += I.ada_w[i * 1024];
      if (acc_ == 1.2345e-30f) scr[0] = acc_; }
#endif
    for (int idx = gw * 64 + lane; idx < M_TOK * 4; idx += NGW * 64) { const int tok = idx >> 2, fg = idx & 3; const float pfv = (float)I.pos[tok]; v4u o;
#pragma unroll
        for (int j = 0; j < 4; ++j) { const float inv = __uint_as_float(fg == 0 ? pg8::ROPE_IFB[j] : fg == 1 ? pg8::ROPE_IFB[4 + j] : fg == 2 ? pg8::ROPE_IFB[8 + j] : pg8::ROPE_IFB[12 + j]); const float th = pfv * inv;
            const float k = rintf(th * 0.15915494309189535f); float r = fmaf(-k, 6.2831854820251465f, th); r = fmaf(-k, -1.7484555e-07f, r); const float x = r * 0.15915494309189535f;
            const pg8::h2_t h = {(__fp16)__builtin_amdgcn_cosf(x), (__fp16)__builtin_amdgcn_sinf(x)}; o[j] = __builtin_bit_cast(unsigned, h); }
        *(GAS v4u*)(ws + WS_ROPE + (size_t)idx * 16) = o; }
#ifndef PRO_RPT_A
#define PRO_RPT_A 1
#endif
#ifndef PRO_RPT_C
#define PRO_RPT_C 1
#endif
    for (int rpa = 0; rpa < PRO_RPT_A; ++rpa)
    for (int it = gw; it < DEPTH * 24 * pg8::MOD_KS; it += NGW) {
        const int layer = it / (24 * pg8::MOD_KS), rem = it % (24 * pg8::MOD_KS), chunk = rem / pg8::MOD_KS, ks = rem % pg8::MOD_KS, kb = ks * 128;
#pragma unroll
        for (int q = 0; q < 8; ++q) { const int idx = lane + 64 * q, b = idx >> 7, k = idx & 127; const float cv = I.c[b * D_MODEL + kb + k]; scr[idx] = cv / (1.0f + __expf(-cv)); }
        LDS_WAIT(); asm volatile("" ::: "memory");
        const float* wp = I.ada_w + ((size_t)layer * D_MODEL + kb) * (6 * D_MODEL) + chunk * 256 + 4 * lane;
        f32x4 a0 = {0.f, 0.f, 0.f, 0.f}, a1 = a0, a2 = a0, a3 = a0;
#pragma nounroll
        for (int k = 0; k < 128; k += 16) {
            f32x4 w[16];
#pragma unroll
            for (int j = 0; j < 16; ++j) w[j] = *(const GAS f32x4*)(wp + (size_t)(k + j) * (6 * D_MODEL));
#pragma unroll
            for (int g4 = 0; g4 < 4; ++g4) {
                const f32x4 c0 = *(const LAS f32x4*)(scr + k + 4 * g4), c1 = *(const LAS f32x4*)(scr + 128 + k + 4 * g4), c2 = *(const LAS f32x4*)(scr + 256 + k + 4 * g4), c3 = *(const LAS f32x4*)(scr + 384 + k + 4 * g4);
                const f32x4 w0 = w[4 * g4], w1 = w[4 * g4 + 1], w2 = w[4 * g4 + 2], w3 = w[4 * g4 + 3];
                a0 += w0 * c0.x + w1 * c0.y + w2 * c0.z + w3 * c0.w; a1 += w0 * c1.x + w1 * c1.y + w2 * c1.z + w3 * c1.w;
                a2 += w0 * c2.x + w1 * c2.y + w2 * c2.z + w3 * c2.w; a3 += w0 * c3.x + w1 * c3.y + w2 * c3.z + w3 * c3.w;
            }
        }
        float* mp = (float*)(ws + WS_MODP) + (size_t)ks * pg8::MOD_SZ + (size_t)(layer * BATCH) * (6 * D_MODEL) + chunk * 256 + 4 * lane;
        *(f32x4*)(mp) = a0; *(f32x4*)(mp + 6 * D_MODEL) = a1; *(f32x4*)(mp + 12 * D_MODEL) = a2; *(f32x4*)(mp + 18 * D_MODEL) = a3;
        LDS_WAIT(); asm volatile("" ::: "memory");
    }
    if (FFN_GU_I8) for (int it = gw; it < 2 * 22 * 8; it += NGW) {
        const int j = it / 176, rem = it % 176, chunk = rem >> 3, ks = rem & 7;
        const float* wp = I.wgu + ((size_t)j * D_MODEL + 128 * ks) * (2 * D_FF) + chunk * 256 + 4 * lane;
        f32x4 mx = {0.f, 0.f, 0.f, 0.f};
#pragma nounroll
        for (int k = 0; k < 128; k += 16) {
            f32x4 w[16];
#pragma unroll
            for (int q = 0; q < 16; ++q) w[q] = *(const GAS f32x4*)(wp + (size_t)(k + q) * (2 * D_FF));
#pragma unroll
            for (int q = 0; q < 16; ++q) mx = __builtin_elementwise_max(mx, __builtin_elementwise_abs(w[q]));
        }
        unsigned* cb = (unsigned*)(ws + WS_CTL) + CW_CMAX + j * 2 * D_FF + chunk * 256 + 4 * lane;
#pragma unroll
        for (int q = 0; q < 4; ++q) atomicMax(cb + q, __float_as_uint(mx[q]));
    }
    if (WO_I8) for (int it = gw; it < 2 * 4 * 8; it += NGW) {
        const int j = it / 32, rem = it % 32, chunk = rem >> 3, ks = rem & 7;
        const float* wp = I.wo + ((size_t)j * D_MODEL + 128 * ks) * D_MODEL + chunk * 256 + 4 * lane;
        f32x4 mx = {0.f, 0.f, 0.f, 0.f};
#pragma nounroll
        for (int k = 0; k < 128; k += 16) {
            f32x4 w[16];
#pragma unroll
            for (int q = 0; q < 16; ++q) w[q] = *(const GAS f32x4*)(wp + (size_t)(k + q) * D_MODEL);
#pragma unroll
            for (int q = 0; q < 16; ++q) mx = __builtin_elementwise_max(mx, __builtin_elementwise_abs(w[q]));
        }
        unsigned* cb = (unsigned*)(ws + WS_CTL) + CW_CMAXO + j * D_MODEL + chunk * 256 + 4 * lane;
#pragma unroll
        for (int q = 0; q < 4; ++q) atomicMax(cb + q, __float_as_uint(mx[q]));
    }
    for (int rpc = 0; rpc < PRO_RPT_C; ++rpc) {
        f32x4 ra[8], rb[8]; TrItem ta, tb;
        int it = gw;
        if (it < TI_ALL) {
            ta = tr_decode(I, ws, it); tr_load(ta, lane, ra);
            for (;;) {
                const int itb = it + NGW; tb = tr_decode(I, ws, itb < TI_ALL ? itb : it); tr_load(tb, lane, rb);
                tr_store(ta, lane, ra, scr);
                if (itb >= TI_ALL) break;
                const int itc = itb + NGW; ta = tr_decode(I, ws, itc < TI_ALL ? itc : itb); tr_load(ta, lane, ra);
                tr_store(tb, lane, rb, scr);
                if (itc >= TI_ALL) break;
                it = itc;
            }
        }
        tr8_run<0>(I, ws, scr, lane, gw, NGW);
    }
}

__device__ __forceinline__ void ld_row(const float* p, int lane, f32x4 (&v)[4]) {
#pragma unroll
    for (int j = 0; j < 4; ++j) v[j] = *(const GAS f32x4*)(p + 4 * lane + 256 * j); }
__device__ __forceinline__ void ld_yrow(const bf16* p, int lane, v2u (&y)[4]) {
#pragma unroll
    for (int j = 0; j < 4; ++j) y[j] = *(const GAS v2u*)(p + 4 * lane + 256 * j); }
__device__ __forceinline__ f32x4 y4(v2u a) { return (f32x4){bflo(a.x), bfhi(a.x), bflo(a.y), bfhi(a.y)}; }
__device__ __forceinline__ float row_rstd(const f32x4 (&v)[4]) {
    float s = 0.f;
#pragma unroll
    for (int j = 0; j < 4; ++j) s += (v[j].x * v[j].x + v[j].y * v[j].y) + (v[j].z * v[j].z + v[j].w * v[j].w);
    return __builtin_amdgcn_rsqf(wave_sum(s) * (1.0f / D_MODEL) + NORM_EPS);
}
__device__ __forceinline__ void st_row_bf16(bf16* p, int lane, const f32x4 (&h)[4]) {
#pragma unroll
    for (int j = 0; j < 4; ++j) { v2u o; o.x = pk2(h[j].x, h[j].y); o.y = pk2(h[j].z, h[j].w); *(GAS v2u*)(p + 4 * lane + 256 * j) = o; } }

template <bool COMBINE>
__device__ __forceinline__ void pool_prep_phase(int gw, int NGW, int wave, int lane, LAS unsigned char* lds, const void* Xprev_  , bf16* Xcur, bf16* P, const float* gain, const float* modp, const float* ada_b, float* modr, int layer,
                                                const bf16* Y, const int* slot_of, const float* gatev) {
    const float* Xprev = (const float*)Xprev_; const bf16* XprevH = (const bf16*)Xprev_;
    if (!COMBINE) {
        for (int i = gw * 64 + lane; i < pg8::MOD_SZ / 4; i += NGW * 64) { const int idx = 4 * i, layer_ = idx / (BATCH * 6 * D_MODEL), col = idx % (6 * D_MODEL);
            f32x4 v = *(const f32x4*)(ada_b + layer_ * (6 * D_MODEL) + col);
#pragma unroll
            for (int ks = 0; ks < pg8::MOD_KS; ++ks) v += *(const f32x4*)(modp + (size_t)ks * pg8::MOD_SZ + idx);
            *(f32x4*)(modr + idx) = v; } }
    LAS v2u* ring = (LAS v2u*)(lds + RING_OFF + wave * 16384) + lane;
    constexpr int PP_ROWS = 32, QEND = 16 + PP_ROWS;
    for (int it = (gw & 1) ? M_TOK : (gw >> 1); it < M_TOK / PP_ROWS; it += NGW >> 1) {
        const int t0 = PP_ROWS * it, b = t0 / SEQ; const bool first = (t0 % SEQ) == 0;
        f32x4 A[4], G2[4];
#pragma unroll
        for (int j = 0; j < 4; ++j) { const int col = 4 * lane + 256 * j; A[j] = *(const f32x4*)(gain + col) * ((COMBINE ? mod4(modr, layer, b, 1, col) : mod4p(modp, ada_b, layer, b, 1, col)) + 1.0f); if (COMBINE) G2[j] = mod4(modr, layer - 1, b, 5, col); }
        v2i sl = {0, 0}; f32x2 gt = {0.f, 0.f};
        if (COMBINE) { const int rr = first ? t0 + (lane & 31) : t0 - 16 + (lane < QEND ? lane : QEND - 1); sl = *(const GAS v2i*)(slot_of + 2 * rr); gt = *(const GAS f32x2*)(gatev + 2 * rr); }
        v2u z2; asm volatile("v_mov_b32 %0, 0\n\tv_mov_b32 %1, 0" : "=v"(z2.x), "=v"(z2.y));
#pragma unroll
        for (int q = 0; q < 30; ++q) ring[q * 64] = z2;
        f32x4 s[4];
#pragma unroll
        for (int q = 0; q < 4; ++q) s[q] = (f32x4){0.f, 0.f, 0.f, 0.f};
        const int q0 = first ? 16 : 0; const int rbase = t0 - 16;
        f32x4 xvA[4], xvB[4]; v2u xhA[4], xhB[4], yaA[4], ybA[4], yaB[4], ybB[4];
        { if (COMBINE) { ld_yrow(XprevH + (size_t)(rbase + q0) * D_MODEL, lane, xhA); ld_yrow(XprevH + (size_t)(rbase + q0 + 1) * D_MODEL, lane, xhB); }
          else { ld_row(Xprev + (size_t)(rbase + q0) * D_MODEL, lane, xvA); ld_row(Xprev + (size_t)(rbase + q0 + 1) * D_MODEL, lane, xvB); }
          if (COMBINE) { ld_yrow(Y + (size_t)rdlane_i(sl.x, 0) * D_MODEL, lane, yaA); ld_yrow(Y + (size_t)rdlane_i(sl.y, 0) * D_MODEL, lane, ybA);
                         ld_yrow(Y + (size_t)rdlane_i(sl.x, 1) * D_MODEL, lane, yaB); ld_yrow(Y + (size_t)rdlane_i(sl.y, 1) * D_MODEL, lane, ybB); } }
#pragma nounroll
        for (int q2 = q0; q2 < QEND; q2 += 2) {
#pragma unroll
          for (int hh = 0; hh < 2; ++hh) {
            const int q = q2 + hh, row = rbase + q, li = q - q0, i = q & 15;
            f32x4 v[4];
#pragma unroll
            for (int j = 0; j < 4; ++j) v[j] = COMBINE ? y4(hh ? xhB[j] : xhA[j]) : (hh ? xvB[j] : xvA[j]);
            if (COMBINE) { const float g0 = rdlane_f(gt.x, li), g1 = rdlane_f(gt.y, li);
#pragma unroll
                for (int j = 0; j < 4; ++j) v[j] += G2[j] * (y4(hh ? yaB[j] : yaA[j]) * g0 + y4(hh ? ybB[j] : ybA[j]) * g1); }
            { const int nq = q + 2 < QEND ? 2 : QEND - 1 - q;
                if (COMBINE) { if (hh) ld_yrow(XprevH + (size_t)(row + nq) * D_MODEL, lane, xhB); else ld_yrow(XprevH + (size_t)(row + nq) * D_MODEL, lane, xhA); }
                else { if (hh) ld_row(Xprev + (size_t)(row + nq) * D_MODEL, lane, xvB); else ld_row(Xprev + (size_t)(row + nq) * D_MODEL, lane, xvA); }
                if (COMBINE) { const int s0 = rdlane_i(sl.x, li + nq), s1 = rdlane_i(sl.y, li + nq);
                    if (hh) { ld_yrow(Y + (size_t)s0 * D_MODEL, lane, yaB); ld_yrow(Y + (size_t)s1 * D_MODEL, lane, ybB); } else { ld_yrow(Y + (size_t)s0 * D_MODEL, lane, yaA); ld_yrow(Y + (size_t)s1 * D_MODEL, lane, ybA); } } }
            if (COMBINE && q >= 16) st_row_bf16(Xcur + (size_t)row * D_MODEL, lane, v);
            const float rstd = row_rstd(v);
#pragma unroll
            for (int j = 0; j < 4; ++j) { v[j] *= rstd;
                constexpr int W_[4] = {2, 4, 8, 16}, B_[4] = {0, 2, 6, 14};
                const int slot = B_[j] + (i & (W_[j] - 1));
                v2u nw; nw.x = pk2(v[j].x, v[j].y); nw.y = pk2(v[j].z, v[j].w);
                const v2u od = ring[slot * 64]; ring[slot * 64] = nw;
                s[j] += y4(nw) - y4(od); }
            if (q >= 16) {
                const int n1 = q - 15;
                const float i0 = first ? 1.0f / (float)(n1 < 2 ? n1 : 2) : 0.5f, i1 = first ? 1.0f / (float)(n1 < 4 ? n1 : 4) : 0.25f;
                const float i2 = first ? 1.0f / (float)(n1 < 8 ? n1 : 8) : 0.125f, i3 = first ? 1.0f / (float)(n1 < 16 ? n1 : 16) : 0.0625f;
                f32x4 h[4]; h[0] = (s[0] * i0 - v[0]) * A[0]; h[1] = (s[1] * i1 - v[1]) * A[1]; h[2] = (s[2] * i2 - v[2]) * A[2]; h[3] = (s[3] * i3 - v[3]) * A[3];
                st_row_bf16(P + (size_t)row * D_MODEL, lane, h);
            }
          }
        }
        LDS_WAIT(); asm volatile("" ::: "memory");
    }
}

template <bool ROUTE, int OUT  >
__device__ __forceinline__ void norm_phase(int gw, int NGW, int lane, const bf16* X, bf16* H, float* rs, const float* gain, const float* modr, int layer, int part_sh,
                                           const LAS float* wr_t  , const float* rb, int* eidx, float* gatev, unsigned* cnt, LAS float* sc6 = nullptr  ) {
    int mycnt = 0;
    for (int it = gw; it < M_TOK / 16; it += NGW) {
        const int t0 = 16 * it, b = t0 / SEQ;
        f32x4 A[4], Bv[4];
#pragma unroll
        for (int j = 0; j < 4; ++j) { const int col = 4 * lane + 256 * j; A[j] = *(const f32x4*)(gain + col) * (mod4(modr, layer, b, part_sh + 1, col) + 1.0f); Bv[j] = mod4(modr, layer, b, part_sh, col); }
        v2u xa[4], xb[4]; ld_yrow(X + (size_t)t0 * D_MODEL, lane, xa); ld_yrow(X + (size_t)(t0 + 1) * D_MODEL, lane, xb);
#pragma nounroll
        for (int i2 = 0; i2 < 16; i2 += 2) {
#pragma unroll
          for (int hh = 0; hh < 2; ++hh) {
            const int i = i2 + hh, row = t0 + i; f32x4 v[4];
            if (hh == 0) {
#pragma unroll
                for (int j = 0; j < 4; ++j) v[j] = y4(xa[j]);
                ld_yrow(X + (size_t)(t0 + (i + 2 < 16 ? i + 2 : 15)) * D_MODEL, lane, xa); }
            else {
#pragma unroll
                for (int j = 0; j < 4; ++j) v[j] = y4(xb[j]);
                ld_yrow(X + (size_t)(t0 + (i + 2 < 16 ? i + 2 : 15)) * D_MODEL, lane, xb); }
            const float rstd = row_rstd(v);
#pragma unroll
            for (int j = 0; j < 4; ++j) v[j] = v[j] * rstd * A[j] + Bv[j];
            if (OUT == 2) {
                float am = 0.f;
#pragma unroll
                for (int j = 0; j < 4; ++j) am = fmaxf(am, fmaxf(fmaxf(fabsf(v[j].x), fabsf(v[j].y)), fmaxf(fabsf(v[j].z), fabsf(v[j].w))));
                am = wave_max(am);
                const float sc = am > 0.f ? 127.0f / am : 0.f;
#pragma unroll
                for (int j = 0; j < 4; ++j) *(GAS unsigned*)((unsigned char*)H + (size_t)row * D_MODEL + 4 * lane + 256 * j) = pack4_i8(v[j].x * sc, v[j].y * sc, v[j].z * sc, v[j].w * sc);
                if (lane == 0) rs[row] = am * (1.0f / 127.0f); }
            else if (OUT == 3) {
#pragma unroll
                for (int j = 0; j < 4; ++j) *(LAS f32x4*)(sc6 + 4 * lane + 4 * (lane >> 2) + 320 * j) = v[j];
                f32x4 m4[4];
#pragma unroll
                for (int t = 0; t < 4; ++t) m4[t] = *(const LAS f32x4*)(sc6 + 20 * lane + 4 * t);
                float am = 0.f;
#pragma unroll
                for (int t = 0; t < 4; ++t) am = fmaxf(am, fmaxf(fmaxf(fabsf(m4[t].x), fabsf(m4[t].y)), fmaxf(fabsf(m4[t].z), fabsf(m4[t].w))));
                am = fmaxf(am, MK_DPP(am, 0xB1));
                const unsigned sb = f6_scale_byte(am); const float f = f6_inv(sb);
                v16f mine, oth;
#pragma unroll
                for (int t = 0; t < 4; ++t) { mine[4 * t] = m4[t].x * f; mine[4 * t + 1] = m4[t].y * f; mine[4 * t + 2] = m4[t].z * f; mine[4 * t + 3] = m4[t].w * f; }
#pragma unroll
                for (int i = 0; i < 16; ++i) oth[i] = MK_DPP(mine[i], 0xB1);
                const v6u c = __builtin_amdgcn_cvt_scalef32_2xpk16_fp6_f32(mine, oth, 1.0f);
                const unsigned c4 = (unsigned)__builtin_amdgcn_update_dpp(0, (int)c[4], 0xA0, 0xf, 0xf, true), c5 = (unsigned)__builtin_amdgcn_update_dpp(0, (int)c[5], 0xA0, 0xf, 0xf, true);
                const bool odd = (lane & 1) != 0; const int p = lane >> 1;
                v4u o; o.x = odd ? c4 : c[0]; o.y = odd ? c5 : c[1]; o.z = odd ? 0u : c[2]; o.w = odd ? sb : c[3];
                *(GAS v4u*)((unsigned char*)H + (size_t)row * D_MODEL + 128 * (p >> 2) + 16 * (p & 3) + (odd ? 64 : 0)) = o; }
            else if (OUT == 1) {
#pragma unroll
                for (int j = 0; j < 4; ++j) *(GAS unsigned*)((unsigned char*)H + (size_t)row * D_MODEL + 4 * lane + 256 * j) = pg8::cvt4_fp8(v[j].x, v[j].y, v[j].z, v[j].w); }
            else st_row_bf16(H + (size_t)row * D_MODEL, lane, v);
            if (ROUTE) {
                float lg[8];
#pragma unroll
                for (int e = 0; e < 8; ++e) { float p = 0.f;
#pragma unroll
                    for (int j = 0; j < 4; ++j) { const f32x4 w = *(const LAS f32x4*)(wr_t + e * D_MODEL + 4 * lane + 256 * j); p += (v[j].x * w.x + v[j].y * w.y) + (v[j].z * w.z + v[j].w * w.w); }
                    lg[e] = wave_sum(p) + rb[e]; }
                int e1 = 0; float v1 = lg[0];
#pragma unroll
                for (int e = 1; e < 8; ++e) if (lg[e] > v1) { v1 = lg[e]; e1 = e; }
                int e2 = -1; float v2 = -__builtin_inff();
#pragma unroll
                for (int e = 0; e < 8; ++e) if (e != e1 && lg[e] > v2) { v2 = lg[e]; e2 = e; }
                const float ex = __expf(v2 - v1), g1 = 1.0f / (1.0f + ex), g2 = ex * g1;
                if (lane == 0) { *(GAS v2i*)(eidx + 2 * row) = (v2i){e1, e2}; *(GAS f32x2*)(gatev + 2 * row) = (f32x2){g1, g2}; }
                mycnt += (lane == e1 || lane == e2) ? 1 : 0;
            }
          }
        }
    }
    if (ROUTE) { if (lane < 8 && mycnt > 0) atomicAdd(cnt + lane * 64, (unsigned)mycnt); }
}

__device__ __forceinline__ void slot_phase(int gw, int NGW, int lane, const int* eidx, const unsigned* cnt, unsigned* cur, int* stok, int* slot_of) {
    int base[8]; { int acc = 0;
#pragma unroll
        for (int e = 0; e < 8; ++e) { base[e] = acc * 256; acc += ((int)__hip_atomic_load(cnt + e * 64, __ATOMIC_RELAXED, __HIP_MEMORY_SCOPE_AGENT) + 255) >> 8; } }
    for (int it = gw; it < M_TOK / 32; it += NGW) {
        const int ent = 64 * it + lane;
        const int e = eidx[ent]; int slot = 0;
#pragma unroll
        for (int x = 0; x < 8; ++x) {
            const unsigned long long mask = __ballot(e == x);
            if (mask) { const int n = __popcll(mask), leader = __ffsll((long long)mask) - 1; unsigned st = 0;
                if (lane == leader) st = atomicAdd(cur + x * 64, (unsigned)n);
                st = (unsigned)rdlane_i((int)st, leader);
                if (e == x) slot = base[x] + (int)st + __popcll(mask & ((1ull << lane) - 1ull)); }
        }
        stok[slot] = ent >> 1; slot_of[ent] = slot;
    }
}

template <bool OUT_I8>
__device__ __forceinline__ void merge_phase(int gw, int NGW, int lane, const bf16* OG, const float* LSE, bf16* AO, float* rs) {
    for (int it = gw; it < M_TOK / 16; it += NGW) {
#pragma unroll 2
        for (int i = 0; i < 16; ++i) {
            const int m = 16 * it + i, b = m / SEQ, p = m % SEQ;
            float res[2][8];
#pragma unroll
            for (int seg = 0; seg < 2; ++seg) {
                const int col = 512 * seg + 8 * lane, h = col >> 7, e0 = col & 127;
                v4u o[3]; float ls[3];
#pragma unroll
                for (int g = 0; g < 3; ++g) { const int sh = 2 * g, Lg = SEQ >> sh, j = p >> sh, r = p & ((1 << sh) - 1); const size_t ci = (size_t)(((b << sh) | r) * NHEAD + h) * Lg + j;
                    o[g] = *(const GAS v4u*)(OG + (size_t)g * ((size_t)M_TOK * D_MODEL) + ci * HEAD_DIM + e0); ls[g] = LSE[(size_t)g * ((size_t)M_TOK * NHEAD) + ci]; }
                const float mx = fmaxf(ls[0], fmaxf(ls[1], ls[2])); float a0 = __expf(ls[0] - mx), a1 = __expf(ls[1] - mx), a2 = __expf(ls[2] - mx); const float inv = 1.0f / (a0 + a1 + a2); a0 *= inv; a1 *= inv; a2 *= inv;
#pragma unroll
                for (int q = 0; q < 4; ++q) { res[seg][2 * q] = bflo(o[0][q]) * a0 + bflo(o[1][q]) * a1 + bflo(o[2][q]) * a2; res[seg][2 * q + 1] = bfhi(o[0][q]) * a0 + bfhi(o[1][q]) * a1 + bfhi(o[2][q]) * a2; }
            }
            if (OUT_I8) {
                float am = 0.f;
#pragma unroll
                for (int seg = 0; seg < 2; ++seg)
#pragma unroll
                    for (int q = 0; q < 8; ++q) am = fmaxf(am, fabsf(res[seg][q]));
                am = wave_max(am);
                const float sc = am > 0.f ? 127.0f / am : 0.f;
#pragma unroll
                for (int seg = 0; seg < 2; ++seg) { v2u w; w.x = pack4_i8(res[seg][0] * sc, res[seg][1] * sc, res[seg][2] * sc, res[seg][3] * sc); w.y = pack4_i8(res[seg][4] * sc, res[seg][5] * sc, res[seg][6] * sc, res[seg][7] * sc);
                    *(GAS v2u*)((unsigned char*)AO + (size_t)m * D_MODEL + 512 * seg + 8 * lane) = w; }
                if (lane == 0) rs[m] = am * (1.0f / 127.0f);
            } else {
#pragma unroll
                for (int seg = 0; seg < 2; ++seg) { v4u w;
#pragma unroll
                    for (int q = 0; q < 4; ++q) w[q] = pk2(res[seg][2 * q], res[seg][2 * q + 1]);
                    *(GAS v4u*)(AO + (size_t)m * D_MODEL + 512 * seg + 8 * lane) = w; }
            }
        }
    }
}

__device__ __forceinline__ void final_phase(int gw, int NGW, int lane, const bf16* X, float* out, const float* modr, int layer, const bf16* Y, const int* slot_of, const float* gatev) {
    for (int it = gw; it < M_TOK / 16; it += NGW) {
        const int t0 = 16 * it, b = t0 / SEQ;
        f32x4 G2[4];
#pragma unroll
        for (int j = 0; j < 4; ++j) G2[j] = mod4(modr, layer, b, 5, 4 * lane + 256 * j);
        const v2i sl = *(const GAS v2i*)(slot_of + 2 * (t0 + (lane & 15))); const f32x2 gt = *(const GAS f32x2*)(gatev + 2 * (t0 + (lane & 15)));
        v2u xv[4], ya[4], yb[4];
        ld_yrow(X + (size_t)t0 * D_MODEL, lane, xv); ld_yrow(Y + (size_t)rdlane_i(sl.x, 0) * D_MODEL, lane, ya); ld_yrow(Y + (size_t)rdlane_i(sl.y, 0) * D_MODEL, lane, yb);
#pragma unroll
        for (int i = 0; i < 16; ++i) {
            const int row = t0 + i; f32x4 v[4]; const float g0 = rdlane_f(gt.x, i), g1 = rdlane_f(gt.y, i);
#pragma unroll
            for (int j = 0; j < 4; ++j) v[j] = y4(xv[j]) + G2[j] * (y4(ya[j]) * g0 + y4(yb[j]) * g1);
            { const int ni = i < 15 ? i + 1 : i; ld_yrow(X + (size_t)(t0 + ni) * D_MODEL, lane, xv); ld_yrow(Y + (size_t)rdlane_i(sl.x, ni) * D_MODEL, lane, ya); ld_yrow(Y + (size_t)rdlane_i(sl.y, ni) * D_MODEL, lane, yb); }
#pragma unroll
            for (int j = 0; j < 4; ++j) __builtin_nontemporal_store(v[j], (f32x4*)(out + (size_t)row * D_MODEL + 4 * lane + 256 * j));
        }
    }
}
typedef __hip_bfloat16 hbf;
constexpr size_t SUBT = (size_t)M_TOK * D_MODEL;
constexpr int ATT_ITEMS = 3 * (M_TOK * NHEAD / 256);
__device__ __forceinline__ swa::BlockRef<hbf, hbf> attn_ref(int L, const hbf* qkvc, hbf* og) {
    const int g = L >> 10, rem = L & 1023, sh = 2 * g, lq = 5 - sh, chain = rem >> lq, qb = rem & ((1 << lq) - 1), Lg = SEQ >> sh;
    const size_t co = (size_t)chain * Lg * HEAD_DIM, qo = (size_t)qb * 256 * HEAD_DIM;
    swa::BlockRef<hbf, hbf> r;
    r.Q = qkvc + (size_t)(g * 3 + 0) * SUBT + co + qo; r.K = qkvc + (size_t)(g * 3 + 1) * SUBT + co; r.V = qkvc + (size_t)(g * 3 + 2) * SUBT + co;
    r.O = og + (size_t)g * SUBT + co + qo; r.P0 = qb * 256;
    return r;
}

struct Args { const void* in[19]; float* out; unsigned char* ws; int ph_lo, ph_hi, grid, pad; };
typedef const unsigned char __attribute__((address_space(4)))* kptr_t;
__device__ __forceinline__ kptr_t kargs() { kptr_t p = (kptr_t)__builtin_amdgcn_kernarg_segment_ptr(); asm volatile("" : "+s"(p)); return p; }
#define KIN(T, k) ((const T*)*(const void* const __attribute__((address_space(4)))*)(kp + 8 * (k)))
#define KOUT() ((float*)*(void* const __attribute__((address_space(4)))*)(kp + 152))
#define KWS() ((unsigned char*)*(void* const __attribute__((address_space(4)))*)(kp + 160))
static_assert(sizeof(Args) == 184, "Args layout: in[19] at 0, out at 152, ws at 160, ph_lo 168, ph_hi 172, grid 176");
#define KINT(off) (*(const int __attribute__((address_space(4)))*)(kp + (off)))
__device__ __forceinline__ bool ph_in(int k) { const kptr_t kp = kargs(); return KINT(168) <= k && k < KINT(172); }
__global__ void __launch_bounds__(NWAVES * 64, 2) mk_fwd(Args args) {
    extern __shared__ __attribute__((aligned(16))) unsigned char lds_raw[];
    LAS unsigned char* lds = (LAS unsigned char*)lds_raw;
#ifndef CODE_PAD
#define CODE_PAD 0
#endif
#pragma unroll
    for (int pad_ = 0; pad_ < CODE_PAD; ++pad_) asm volatile("s_nop 0");
    for (int u = threadIdx.x; u < (LDS_BYTES - MISC_OFF) / 4; u += NWAVES * 64) ((LAS unsigned*)(lds + MISC_OFF))[u] = 0u;
    __syncthreads();
    if (args.ph_hi - args.ph_lo > 1) (void)xcd_barrier_post((unsigned*)(args.ws + WS_CTL) + CW_BAR, (volatile LAS unsigned*)(lds + MISC_OFF) + 8);
#ifndef DBG_MASK
#define DBG_MASK 0xFFFF
#endif
#define EN(t) (((DBG_MASK) >> (t)) & 1)
#ifndef RPT_MASK
#define RPT_MASK 0
#endif
#define PHASE(t, k) for (int rep_ = 0, nrep_ = (EN(t) && IN(k)) ? 1 + (((RPT_MASK) >> (t)) & 1) : 0; rep_ < nrep_; ++rep_)
#define IN(k) ph_in(k)
#define SEAM(k) do { if (IN(k) && IN((k) + 1)) { const kptr_t kp = kargs(); XcdBarrier bar_; bar_.bar = (unsigned*)(KWS() + WS_CTL) + CW_BAR; bar_.x = xb_xcc_id(); bar_.st = (volatile LAS unsigned*)(lds + MISC_OFF) + 8; \
        const int sk_ = (k); xcd_barrier(bar_, [&] { if (sk_ < T8_SEAMS) { int tid_ = threadIdx.x; asm volatile("" : "+v"(tid_)); const int G_ = KINT(176), bx_ = blockIdx.x, vcu_ = (G_ % 8 == 0) ? (bx_ % 8) * (G_ / 8) + bx_ / 8 : bx_; \
            ProIn I; I.c = KIN(float, 1); I.ada_w = KIN(float, 5); I.pool_w = KIN(float, 7); I.wqkv = KIN(float, 9); I.wo = KIN(float, 10); I.wgu = KIN(float, 13); I.wdn = KIN(float, 14); I.mgu = KIN(float, 17); I.mdn = KIN(float, 18); I.pos = KIN(int, 2); \
            seam_convert(I, KWS(), lds, sk_, vcu_, G_, __builtin_amdgcn_readfirstlane(tid_ >> 6), tid_ & 63); } }); } } while (0)
#define PH_SETUP() const kptr_t kp = kargs(); unsigned char* ws = KWS(); int tid = threadIdx.x; asm volatile("" : "+v"(tid)); const int lane = tid & 63, wave = __builtin_amdgcn_readfirstlane(tid >> 6); \
    const int G = KINT(176), bx = blockIdx.x, vcu = (G % 8 == 0) ? (bx % 8) * (G / 8) + bx / 8 : bx, gw = vcu * NWAVES + wave, NGW = G * NWAVES; (void)tid; (void)lane; (void)vcu; (void)gw; (void)NGW; (void)ws
#ifndef STAG_Q
#define STAG_Q 0
#endif
#define STAG(v) ((unsigned)(((v) & 3) * STAG_Q))
#define MODP() ((const float*)(ws + WS_MODP))
#define MODR() ((float*)(ws + WS_MODR))
#define ADAB() KIN(float, 6)
#define XCUR() ((bf16*)(ws + WS_XB) + (size_t)lp * ((size_t)M_TOK * D_MODEL))
#define CNT() ((unsigned*)(ws + WS_CTL) + CW_CNT + lp * 8 * 64)

    PHASE(0, 0) { PH_SETUP(); ProIn I; I.c = KIN(float, 1); I.ada_w = KIN(float, 5); I.pool_w = KIN(float, 7); I.wqkv = KIN(float, 9); I.wo = KIN(float, 10);
        I.wgu = KIN(float, 13); I.wdn = KIN(float, 14); I.mgu = KIN(float, 17); I.mdn = KIN(float, 18); I.pos = KIN(int, 2);
        p0_prologue(I, ws, lds, gw, NGW, wave, lane); }
    SEAM(0);
    for (int lp = 0; lp < 2; ++lp) {
        const int pb = 1 + PH_PER_PAIR * lp;
        PHASE(1, pb + 0) { PH_SETUP(); bf16* H = (bf16*)(ws + WS_H);
            if (lp == 0 && (FFN_GU_I8 || WO_I8)) ffn_gu_quant_phase(gw, NGW, wave, lane, lds, KIN(float, 13), ws, (const float*)((const unsigned*)(ws + WS_CTL) + CW_CMAX), KIN(float, 10), (const float*)((const unsigned*)(ws + WS_CTL) + CW_CMAXO));
            if (lp == 0) pool_prep_phase<false>(gw, NGW, wave, lane, lds, KIN(float, 0), nullptr, H, KIN(float, 3), MODP(), ADAB(), MODR(), 0, nullptr, nullptr, nullptr);
            else pool_prep_phase<true>(gw, NGW, wave, lane, lds, (const bf16*)(ws + WS_XB), XCUR(), H, KIN(float, 3) + 2 * D_MODEL, nullptr, nullptr, MODR(), 2, (const bf16*)(ws + WS_Y), (const int*)(ws + WS_SLOTOF), (const float*)(ws + WS_GATE)); }
        SEAM(pb + 0);
        PHASE(2, pb + 1) { PH_SETUP();
            pg8::SchedPlain S; S.init(ws + WS_H, (const bf16*)(ws + WS_WPOOL) + (size_t)lp * D_MODEL * 256, M_TOK, D_MODEL, 256, D_MODEL, 512, G, bx);
            if (lp == 0) { pg8::EpiResid<false> E{KIN(float, 0), XCUR(), MODR(), KIN(float, 8) + lp * D_MODEL, 2 * lp, 2, 1.0f};
                pg8::gemm_phase<pg8::EpiResid<false>, pg8::SchedPlain, true>(lds + RING_OFF, 256, S, E); }
            else { pg8::EpiResid<true> E{XCUR(), XCUR(), MODR(), KIN(float, 8) + lp * D_MODEL, 2 * lp, 2, 1.0f};
                pg8::gemm_phase<pg8::EpiResid<true>, pg8::SchedPlain, true>(lds + RING_OFF, 256, S, E); } }
        SEAM(pb + 1);
        PHASE(3, pb + 2) { PH_SETUP();
            norm_phase<false, FFN_GU_I8 ? 2 : (FFN_GU_FP8 ? 1 : 0)>(gw, NGW, lane, XCUR(), (bf16*)(ws + WS_H), (float*)(ws + WS_RS), KIN(float, 4) + 2 * lp * D_MODEL, MODR(), 2 * lp, 3, nullptr, nullptr, nullptr, nullptr, nullptr); }
        SEAM(pb + 2);
        PHASE(4, pb + 3) { PH_SETUP();
            constexpr int KU = (FFN_GU_FP8 || FFN_GU_I8) ? D_MODEL / 2 : D_MODEL;
            pg8::SchedPlain S; S.init(ws + WS_H, ws + WS_WGU + (size_t)lp * GU8_BYTES, M_TOK, 2 * D_FF, KU, KU, 0, G, bx);
            if constexpr (FFN_GU_I8 != 0) { pg8::EpiSwigluI8<FFN_DN_FP8 != 0> E{(void*)(ws + WS_ACT), D_FF, (const float*)(ws + WS_RS), (const float*)((const unsigned*)(ws + WS_CTL) + CW_CMAX) + lp * 2 * D_FF, D_FF};
                pg8::gemm_phase<pg8::EpiSwigluI8<FFN_DN_FP8 != 0>, pg8::SchedPlain, true, 2>(lds + RING_OFF, KU, S, E); }
            else { pg8::EpiSwigluT<FFN_DN_FP8 != 0> E{(void*)(ws + WS_ACT), D_FF, FFN_GU_FP8 ? 0.015625f : 1.0f};
                pg8::gemm_phase<pg8::EpiSwigluT<FFN_DN_FP8 != 0>, pg8::SchedPlain, true, FFN_GU_FP8 ? 1 : 0>(lds + RING_OFF, KU, S, E); } }
        SEAM(pb + 3);
        PHASE(5, pb + 4) { PH_SETUP();
            constexpr int KU = FFN_DN_FP8 ? D_FF / 2 : D_FF;
            pg8::SchedPlain S; S.init(ws + WS_ACT, ws + WS_WDN + (size_t)lp * DN8_BYTES, M_TOK, D_MODEL, KU, KU, 0, G, bx);
            bf16* Xc = XCUR(); pg8::EpiResid<true> E{Xc, Xc, MODR(), nullptr, 2 * lp, 5, FFN_DN_FP8 ? 0.015625f : 1.0f};
            pg8::gemm_phase<pg8::EpiResid<true>, pg8::SchedPlain, true, FFN_DN_FP8 != 0>(lds + RING_OFF, KU, S, E); }
        SEAM(pb + 4);
        PHASE(6, pb + 5) { PH_SETUP();
            norm_phase<false, QKV_FP8 ? (QKV_FP6 ? 3 : 1) : 0>(gw, NGW, lane, XCUR(), (bf16*)(ws + WS_H), nullptr, KIN(float, 3) + (2 * lp + 1) * D_MODEL, MODR(), 2 * lp + 1, 0, nullptr, nullptr, nullptr, nullptr, nullptr, (LAS float*)(lds + RING_OFF + 65536 + wave * 8192)); }
        SEAM(pb + 5);
        PHASE(7, pb + 6) { PH_SETUP();
            constexpr int KU = QKV_FP8 ? D_MODEL / 2 : D_MODEL;
            pg8::SchedPlain S; S.init(ws + WS_H, ws + WS_WQKV + (size_t)lp * QKV8_BYTES, M_TOK, QKV_W, KU, KU, 0, G, bx);
            pg8::EpiQKV E{(bf16*)(ws + WS_QKVC), KIN(float, 11) + lp * 3 * HEAD_DIM, KIN(float, 12) + lp * 3 * HEAD_DIM, KIN(int, 2), (LAS float*)(lds + TAB_OFF), (QKV_FP8 && !QKV_FP6) ? 0.015625f : 1.0f, (const unsigned*)(ws + WS_ROPE)};
            pg8::gemm_phase<pg8::EpiQKV, pg8::SchedPlain, true, QKV_FP8 ? (QKV_FP6 ? 3 : 1) : 0>(lds + RING_OFF, KU, S, E); }
        SEAM(pb + 6);
        PHASE(8, pb + 7) { PH_SETUP();
#ifndef ATT2
#define ATT2 1
#endif
#if ATT2
            { const int per = (6144 + G - 1) / G, I0 = vcu * per, I1 = (I0 + per < 6144) ? I0 + per : 6144;
              att2::attn_phase(lds, (const unsigned short*)(ws + WS_QKVC), (unsigned short*)(ws + WS_OG), (float*)(ws + WS_LSE), I0, I1); }
#else
            const hbf* qkvc = (const hbf*)(ws + WS_QKVC); hbf* og = (hbf*)(ws + WS_OG); float* lse = (float*)(ws + WS_LSE);
            int L = vcu;
            if (L < ATT_ITEMS) {
                swa::BlockRef<hbf, hbf> cb = attn_ref(L, qkvc, og); swa::Seam<hbf> S;
                swa::causal_swa_prime<hbf, hbf>(cb, 129, (char*)lds_raw, S);
                for (;;) {
                    const bool more = L + G < ATT_ITEMS;
                    const swa::BlockRef<hbf, hbf> nb = more ? attn_ref(L + G, qkvc, og) : cb;
                    swa::causal_swa_block<hbf, hbf>(cb, nb, SEQ >> (2 * (L >> 10)), 129, (char*)lds_raw, S, (const char*)og, (char*)lse);
                    if (!more) break;
                    cb = nb; L += G;
                }
            }
#endif
        }
        SEAM(pb + 7);
        PHASE(9, pb + 8) { PH_SETUP(); merge_phase<WO_I8 != 0>(gw, NGW, lane, (const bf16*)(ws + WS_OG), (const float*)(ws + WS_LSE), (bf16*)(ws + WS_H), (float*)(ws + WS_RS)); }
        SEAM(pb + 8);
        PHASE(10, pb + 9) { PH_SETUP();
            constexpr int KU = WO_I8 ? D_MODEL / 2 : D_MODEL;
            pg8::SchedPlain S; S.init(ws + WS_H, ws + WS_WO + (size_t)lp * WO8_BYTES, M_TOK, D_MODEL, KU, KU, 0, G, bx);
            bf16* Xc = XCUR();
            if constexpr (WO_I8 != 0) { pg8::EpiResidI8 E{Xc, Xc, MODR(), (const float*)(ws + WS_RS), (const float*)((const unsigned*)(ws + WS_CTL) + CW_CMAXO) + lp * D_MODEL, 2 * lp + 1, 2};
                pg8::gemm_phase<pg8::EpiResidI8, pg8::SchedPlain, true, 2>(lds + RING_OFF, KU, S, E); }
            else { pg8::EpiResid<true> E{Xc, Xc, MODR(), nullptr, 2 * lp + 1, 2, 1.0f};
                pg8::gemm_phase<pg8::EpiResid<true>, pg8::SchedPlain, true>(lds + RING_OFF, KU, S, E); } }
        SEAM(pb + 9);
        PHASE(11, pb + 10) { PH_SETUP();
            LAS float* wr_t = (LAS float*)(lds + RING_OFF); const float* router_w = KIN(float, 15); int* stok = (int*)(ws + WS_STOK);
            for (int idx = tid; idx < D_MODEL * N_EXP; idx += NWAVES * 64) wr_t[(idx & 7) * D_MODEL + (idx >> 3)] = router_w[(size_t)lp * D_MODEL * N_EXP + idx];
            for (int i = gw * 64 + lane; i < MAX_SLOTS; i += NGW * 64) stok[i] = 0;
            __syncthreads();
            norm_phase<true, MOE_FP8 ? (MGU_FP6 ? 3 : 1) : 0>(gw, NGW, lane, XCUR(), (bf16*)(ws + WS_H), nullptr, KIN(float, 4) + (2 * lp + 1) * D_MODEL, MODR(), 2 * lp + 1, 3, wr_t, KIN(float, 16) + lp * N_EXP, (int*)(ws + WS_EIDX), (float*)(ws + WS_GATE), CNT(), (LAS float*)(lds + RING_OFF + 65536 + wave * 8192));
        }
        SEAM(pb + 10);
        PHASE(12, pb + 11) { PH_SETUP();
            slot_phase(gw, NGW, lane, (const int*)(ws + WS_EIDX), CNT(), (unsigned*)(ws + WS_CTL) + CW_CUR + lp * 8 * 64, (int*)(ws + WS_STOK), (int*)(ws + WS_SLOTOF)); }
        SEAM(pb + 11);
        PHASE(13, pb + 12) { PH_SETUP(); const unsigned* cnt = CNT();
            pg8::SchedMoE<true> S; { int acc = 0;
#pragma unroll
                for (int e = 0; e < 8; ++e) { S.tb[e] = acc; acc += ((int)__hip_atomic_load(cnt + e * 64, __ATOMIC_RELAXED, __HIP_MEMORY_SCOPE_AGENT) + 255) >> 8; } S.tb[8] = acc; }
            constexpr int KU = MOE_FP8 ? D_MODEL / 2 : D_MODEL;
            S.init_order(S.tb[8], 2 * D_FFE / 256, G, bx); S.A = (const char*)(ws + WS_H); S.B = (const char*)(ws + WS_WMGU) + (size_t)lp * N_EXP * MGU8_BYTES; S.lda = KU;
            S.b_exp = MGU8_BYTES; S.b_tile = (size_t)256 * KU * 2; S.tok = (const int*)(ws + WS_STOK);
            pg8::EpiSwigluT<MOE_FP8 != 0> E{(void*)(ws + WS_ACT), D_FFE, (MOE_FP8 && !MGU_FP6) ? 0.015625f : 1.0f};
            pg8::gemm_phase<pg8::EpiSwigluT<MOE_FP8 != 0>, pg8::SchedMoE<true>, true, MOE_FP8 ? (MGU_FP6 ? 3 : 1) : 0>(lds + RING_OFF, KU, S, E, STAG(vcu)); }
        SEAM(pb + 12);
        PHASE(14, pb + 13) { PH_SETUP(); const unsigned* cnt = CNT();
            pg8::SchedMoE<false> S; { int acc = 0;
#pragma unroll
                for (int e = 0; e < 8; ++e) { S.tb[e] = acc; acc += ((int)__hip_atomic_load(cnt + e * 64, __ATOMIC_RELAXED, __HIP_MEMORY_SCOPE_AGENT) + 255) >> 8; } S.tb[8] = acc; }
            constexpr int KU = MOE_FP8 ? D_FFE / 2 : D_FFE;
            S.init_order(S.tb[8], D_MODEL / 256, G, bx); S.A = (const char*)(ws + WS_ACT); S.B = (const char*)(ws + WS_WMDN) + (size_t)lp * N_EXP * MDN8_BYTES; S.lda = KU;
            S.b_exp = MDN8_BYTES; S.b_tile = (size_t)256 * KU * 2; S.tok = nullptr;
            pg8::EpiBf16 E{(bf16*)(ws + WS_Y), D_MODEL, MOE_FP8 ? 0.015625f : 1.0f};
            pg8::gemm_phase<pg8::EpiBf16, pg8::SchedMoE<false>, true, MOE_FP8 != 0>(lds + RING_OFF, KU, S, E);
            if (lp == 0 && T8_IDLE_N > 0) { const int total = S.tb[8] * (D_MODEL / 256), rem = total % G, nidle = rem ? G - rem : G, rank = rem ? bx - rem : bx;
                if (rank >= 0) { ProIn I; I.c = KIN(float, 1); I.ada_w = KIN(float, 5); I.pool_w = KIN(float, 7); I.wqkv = KIN(float, 9); I.wo = KIN(float, 10); I.wgu = KIN(float, 13); I.wdn = KIN(float, 14); I.mgu = KIN(float, 17); I.mdn = KIN(float, 18); I.pos = KIN(int, 2);
                    tr8_run<1>(I, ws, (LAS float*)(lds + RING_OFF + wave * 16384), lane, rank * NWAVES + wave, nidle * NWAVES); } } }
        SEAM(pb + 13);
    }
    PHASE(15, NPHASES - 1) { PH_SETUP();
        final_phase(gw, NGW, lane, (const bf16*)(ws + WS_XB) + (size_t)M_TOK * D_MODEL, KOUT(), MODR(), DEPTH - 1, (const bf16*)(ws + WS_Y), (const int*)(ws + WS_SLOTOF), (const float*)(ws + WS_GATE)); }
#ifdef EXTRA_BARRIERS
    if (IN(0) && IN(1)) for (int eb = 0; eb < EXTRA_BARRIERS; ++eb) { const kptr_t kp = kargs(); XcdBarrier bar_; bar_.bar = (unsigned*)(KWS() + WS_CTL) + CW_BAR; bar_.x = xb_xcc_id(); bar_.st = (volatile LAS unsigned*)(lds + MISC_OFF) + 8; xcd_barrier(bar_); }
#endif
#undef IN
#undef SEAM
#undef EN
#undef PHASE
#undef MODP
#undef STAG
#undef MODR
#undef ADAB
#undef XCUR
#undef CNT
#undef PH_SETUP
}

extern "C" void kernel_launch(void* const* d_in, const int* in_sizes, int n_in, void* d_out, int out_size, void* d_ws, size_t ws_size, hipStream_t stream) {
    static int grid = 0;
    if (grid == 0) {
        if (n_in != 19 || in_sizes[0] != M_TOK * D_MODEL || out_size != M_TOK * D_MODEL || ws_size < WS_END) { fprintf(stderr, "kernel_launch: unexpected shapes (n_in %d, in0 %d, out %d, ws %zu < %zu); nothing launched\n", n_in, n_in > 0 ? in_sizes[0] : -1, out_size, ws_size, (size_t)WS_END); grid = -1; return; }
        int dev = 0, cus = 0, per_cu = 0;
        if (hipGetDevice(&dev) != hipSuccess || hipDeviceGetAttribute(&cus, hipDeviceAttributeMultiprocessorCount, dev) != hipSuccess) { fprintf(stderr, "kernel_launch: device query failed\n"); grid = -1; return; }
        if (hipFuncSetAttribute((const void*)mk_fwd, hipFuncAttributeMaxDynamicSharedMemorySize, LDS_BYTES) != hipSuccess) { fprintf(stderr, "kernel_launch: hipFuncSetAttribute failed\n"); grid = -1; return; }
        if (hipOccupancyMaxActiveBlocksPerMultiprocessor(&per_cu, (const void*)mk_fwd, NWAVES * 64, LDS_BYTES) != hipSuccess || per_cu < 1) fprintf(stderr, "kernel_launch: note: occupancy query reports %d workgroups per CU\n", per_cu);
        (void)hipGetLastError();
        grid = cus;
    }
    if (grid < 0) return;
    if (hipMemsetAsync((char*)d_ws + WS_CTL, 0, CTL_ZERO_BYTES, stream) != hipSuccess) { fprintf(stderr, "kernel_launch: hipMemsetAsync failed\n"); return; }
    Args a{};
    for (int i = 0; i < 19; ++i) a.in[i] = d_in[i];
    a.out = (float*)d_out; a.ws = (unsigned char*)d_ws; a.grid = grid; a.pad = 0;
#if MK_PER_PHASE
    for (int k = 0; k < NPHASES; ++k) { a.ph_lo = k; a.ph_hi = k + 1; hipLaunchKernelGGL(mk_fwd, dim3(grid), dim3(NWAVES * 64), LDS_BYTES, stream, a); }
#else
    a.ph_lo = 0; a.ph_hi = NPHASES; hipLaunchKernelGGL(mk_fwd, dim3(grid), dim3(NWAVES * 64), LDS_BYTES, stream, a);
#endif
    const hipError_t le = hipPeekAtLastError();
    if (le != hipSuccess) fprintf(stderr, "kernel_launch: launch failed: %s\n", hipGetErrorName(le));
}
```

```cpp
#include <hip/hip_runtime.h>
#include <hip/hip_bf16.h>
#include <cstdio>
#include <cstdint>

constexpr int D_MODEL = 1024, BATCH = 4, SEQ = 8192, DEPTH = 4, M_TOK = BATCH * SEQ;
constexpr int QKV_W = 9216, D_FF = 2816, N_EXP = 8, D_FFE = 3584, HEAD_DIM = 128, NHEAD = 8;
constexpr float NORM_EPS = 1e-6f;

namespace pg8 {
#define PG8_LAS __attribute__((address_space(3)))
typedef unsigned short bf16_t;
typedef short bf16x8 __attribute__((ext_vector_type(8)));
typedef float f32x4 __attribute__((ext_vector_type(4)));
typedef float f32x2 __attribute__((ext_vector_type(2)));
typedef unsigned u32x4 __attribute__((ext_vector_type(4)));
typedef unsigned u32x2 __attribute__((ext_vector_type(2)));
typedef int v4i_t __attribute__((ext_vector_type(4)));
typedef int v8i_t __attribute__((ext_vector_type(8)));
typedef int v2i_t __attribute__((ext_vector_type(2)));
constexpr int BM = 256, BK = 64, HALF = 128, HTB = HALF * BK * 2  , STAGE_BYTES = 8 * HTB, NXCD = 8, WGM = 8;

__host__ __device__ __forceinline__ int lds_byte(int r, int c) { const int st = (r >> 4) * 2 + (c >> 5), rr = r & 15, cc = c & 31, ob = rr * 64 + cc * 2; return st * 1024 + (ob ^ (((ob >> 9) & 1) << 5)); }
__host__ __device__ __forceinline__ void stage_rc(int b, int& R, int& C) { const int st = b / 1024, sb = b % 1024, swz = sb ^ (((sb >> 9) & 1) << 5); R = (st >> 1) * 16 + swz / 64; C = (st & 1) * 32 + (swz % 64) / 2; }
__host__ __device__ __forceinline__ int perm32(int rho) { const int n = rho >> 4, i = rho & 15; return 8 * (i >> 2) + 4 * n + (i & 3); }
__device__ __forceinline__ unsigned cvt_pk_bf16(float lo, float hi) { unsigned r; asm volatile("v_cvt_pk_bf16_f32 %0, %1, %2" : "=v"(r) : "v"(lo), "v"(hi)); return r; }

struct Unit { int pm, pn; };

struct OrderBase {
    int nM, nN, nwg, G, c;
    __device__ __forceinline__ void init_order(int nM_, int nN_, int G_, int c_) { nM = nM_; nN = nN_; nwg = nM * nN; G = G_; c = c_; }
    __device__ __forceinline__ bool next(int i, Unit& u) const {
        const long L = (long)i * G + c; if (L >= nwg) return false;
        int wgid = (int)L; { const int q = nwg / NXCD, r = nwg % NXCD, xcd = wgid % NXCD, off = wgid / NXCD; wgid = (xcd < r ? xcd * (q + 1) : r * (q + 1) + (xcd - r) * q) + off; }
        const int nig = WGM * nN, gid = wgid / nig, fm = gid * WGM, gsz = (nM - fm) < WGM ? (nM - fm) : WGM;
        u.pm = fm + ((wgid % nig) % gsz); u.pn = (wgid % nig) / gsz; return true;
    }
};
struct SchedPlain : OrderBase {
    static constexpr int KIND = 0;
    const char* A; const char* B; int lda; int a_pn_step; size_t a_tile, b_tile;
    __device__ __forceinline__ void init(const void* A_, const void* B_, int M, int N, int K, int lda_, int a_pn_step_, int G_, int c_) {
        init_order(M / BM, N / BM, G_, c_); A = (const char*)A_; B = (const char*)B_; lda = lda_; a_pn_step = a_pn_step_; a_tile = (size_t)BM * lda_ * 2; b_tile = (size_t)BM * K * 2; }
    __device__ __forceinline__ const char* a_base(const Unit& u) const { return A + (size_t)u.pm * a_tile + (size_t)u.pn * a_pn_step; }
    __device__ __forceinline__ const char* b_base(const Unit& u) const { return B + (size_t)u.pn * b_tile; }
    __device__ __forceinline__ void a_offs(const Unit&, const int (&R)[2], const int (&C)[2], unsigned (&v)[2][2]) const {
#pragma unroll
        for (int h = 0; h < 2; ++h)
#pragma unroll
            for (int i = 0; i < 2; ++i) v[h][i] = (unsigned)((h * HALF + R[i]) * lda + C[i]) * 2u; }
};
template <bool GATHER> struct SchedMoE : OrderBase {
    static constexpr int KIND = GATHER ? 2 : 1;
    int tb[9]; const char* A; const char* B; int lda; size_t b_exp, b_tile; const int* tok;
    PG8_LAS unsigned* tls;
    __device__ __forceinline__ void pf(const Unit& u, const int (&R)[2], int wid) const {
#pragma unroll
        for (int h = 0; h < 2; ++h)
#pragma unroll
            for (int i = 0; i < 2; ++i) __builtin_amdgcn_global_load_lds((const unsigned*)(tok + u.pm * BM + h * HALF + R[i]), tls + wid * 256 + (h * 2 + i) * 64, 4, 0, 0); }
    __device__ __forceinline__ void a_offs_l(const int (&C)[2], unsigned (&v)[2][2], int wid, int lane) const {
        const unsigned ad = (unsigned)(uintptr_t)(tls + wid * 256 + lane); unsigned r0, r1, r2, r3;
        asm volatile("ds_read_b32 %0, %4\n\tds_read_b32 %1, %4 offset:256\n\tds_read_b32 %2, %4 offset:512\n\tds_read_b32 %3, %4 offset:768\n\ts_waitcnt lgkmcnt(0)" : "=&v"(r0), "=&v"(r1), "=&v"(r2), "=&v"(r3) : "v"(ad) : "memory");
        v[0][0] = (unsigned)((int)r0 * lda + C[0]) * 2u; v[0][1] = (unsigned)((int)r1 * lda + C[1]) * 2u; v[1][0] = (unsigned)((int)r2 * lda + C[0]) * 2u; v[1][1] = (unsigned)((int)r3 * lda + C[1]) * 2u; }
    __device__ __forceinline__ int expert(int pm) const { int e = 0;
#pragma unroll
        for (int j = 1; j < 8; ++j) e += (pm >= tb[j]) ? 1 : 0; return e; }
    __device__ __forceinline__ const char* a_base(const Unit& u) const { return GATHER ? A : A + (size_t)u.pm * BM * lda * 2; }
    __device__ __forceinline__ const char* b_base(const Unit& u) const { return B + (size_t)expert(u.pm) * b_exp + (size_t)u.pn * b_tile; }
    __device__ __forceinline__ void a_offs(const Unit& u, const int (&R)[2], const int (&C)[2], unsigned (&v)[2][2]) const {
#pragma unroll
        for (int h = 0; h < 2; ++h)
#pragma unroll
            for (int i = 0; i < 2; ++i) { const int row = GATHER ? tok[u.pm * BM + h * HALF + R[i]] : (h * HALF + R[i]); v[h][i] = (unsigned)(row * lda + C[i]) * 2u; } }
};

template <class E, class = void> struct epi_stage { static constexpr bool v = false; };
template <class E> struct epi_stage<E, decltype((void)E::STAGE)> { static constexpr bool v = E::STAGE; };
__device__ __forceinline__ f32x4 zero4() { f32x2 lo, hi; asm volatile("v_mov_b64 %0, 0" : "=v"(lo)); asm volatile("v_mov_b64 %0, 0" : "=v"(hi)); return (f32x4){lo.x, lo.y, hi.x, hi.y}; }
template <class Epi, class Sched, bool ALIGN_EPI, int MODE = 0  >
__device__ __forceinline__ void gemm_phase(PG8_LAS unsigned char* lds, const int K, const Sched& S, const Epi& E, const unsigned stagger_ticks = 0u) {
    if (stagger_ticks) { const unsigned long long t0 = __builtin_amdgcn_s_memrealtime(); while (__builtin_amdgcn_s_memrealtime() - t0 < (unsigned long long)stagger_ticks) __builtin_amdgcn_s_sleep(16); }
    constexpr bool FP8 = (MODE == 1), I8 = (MODE == 2), FP6 = (MODE == 3);
    int tid = threadIdx.x; asm volatile("" : "+v"(tid));
    const int wid = __builtin_amdgcn_readfirstlane(tid >> 6), lane = tid & 63, wr = wid >> 2, wc = wid & 3, fr = lane & 15, fq = lane >> 4;
    const int nt = K / BK;
    int RA[2], CA[2]; unsigned voffB[2];
#pragma unroll
    for (int i = 0; i < 2; ++i) { int R, C; stage_rc(tid * 16 + i * 8192, R, C); const int Rb = (Epi::PERM && (Epi::PERM0 || ((R >> 5) & 3) != 0)) ? ((R & ~31) + perm32(R & 31)) : R; RA[i] = R; CA[i] = C; voffB[i] = (unsigned)(Rb * K + C) * 2u; }
    const size_t kstep = (size_t)(BK * 2);
    const size_t hstep = (size_t)HALF * K * 2;
    const unsigned ldsw = (unsigned)wid * 1024u;
    const int aoff = lds_byte(wr * 64 + fr, fq * 8), boff = lds_byte(wc * 32 + fr, fq * 8);
#define PG8_SA(b, h) (((b) * 2 + (h)) * HTB)
#define PG8_SB(b, h) ((4 + (b) * 2 + (h)) * HTB)
#define PG8_STAGE2(bufoff, gbase, v0, v1) do { \
        __builtin_amdgcn_global_load_lds((const unsigned*)((const char*)(gbase) + (v0)), (PG8_LAS unsigned*)(lds + (bufoff) + ldsw), 16, 0, 0); \
        __builtin_amdgcn_global_load_lds((const unsigned*)((const char*)(gbase) + (v1)), (PG8_LAS unsigned*)(lds + (bufoff) + ldsw + 8192), 16, 0, 0); } while (0)
#define PG8_STAGEB(bufoff, gbase) PG8_STAGE2(bufoff, gbase, voffB[0], voffB[1])
#define PG8_LD1(d, addr) do { if constexpr (MODE == 3) { d.lo = *(const PG8_LAS v4i_t*)(addr); const v2i_t h_ = *(const PG8_LAS v2i_t*)((addr) + 1024); d[4] = h_.x; d[5] = h_.y; d[7] = *(const PG8_LAS int*)((addr) + 1036); } \
        else { d.lo = *(const PG8_LAS v4i_t*)(addr); d.hi = *(const PG8_LAS v4i_t*)((addr) + 1024); } } while (0)
#define PG8_LDA(dst, b, h) do { _Pragma("unroll") for (int m = 0; m < 4; ++m) PG8_LD1(dst[m], lds + PG8_SA(b, h) + aoff + m * 2048); } while (0)
#define PG8_LDB(dst, b, h) do { _Pragma("unroll") for (int n = 0; n < 2; ++n) PG8_LD1(dst[n], lds + PG8_SB(b, h) + boff + n * 2048); } while (0)
#define PG8_MMA(ai, bj, At, Bt) do { __builtin_amdgcn_s_setprio(1); _Pragma("unroll") for (int m = 0; m < 4; ++m) _Pragma("unroll") for (int n = 0; n < 2; ++n) { \
        const v4i_t bl_ = Bt[n].lo, bh_ = Bt[n].hi, al_ = At[m].lo, ah_ = At[m].hi;     \
        acc[ai][bj][m][n] = __builtin_amdgcn_mfma_f32_16x16x32_bf16(__builtin_bit_cast(bf16x8, bl_), __builtin_bit_cast(bf16x8, al_), acc[ai][bj][m][n], 0, 0, 0); \
        acc[ai][bj][m][n] = __builtin_amdgcn_mfma_f32_16x16x32_bf16(__builtin_bit_cast(bf16x8, bh_), __builtin_bit_cast(bf16x8, ah_), acc[ai][bj][m][n], 0, 0, 0); } __builtin_amdgcn_s_setprio(0); } while (0)
#define PG8_MMA8(ai, bj, At, Bt) do { __builtin_amdgcn_s_setprio(1); _Pragma("unroll") for (int m = 0; m < 4; ++m) _Pragma("unroll") for (int n = 0; n < 2; ++n) \
        asm volatile("v_mfma_f32_16x16x128_f8f6f4 %0, %1, %2, %0" : "+v"(acc[ai][bj][m][n]) : "v"(Bt[n]), "v"(At[m])); __builtin_amdgcn_s_setprio(0); } while (0)
#define PG8_MMAI(ai, bj, At, Bt) do { __builtin_amdgcn_s_setprio(1); _Pragma("unroll") for (int m = 0; m < 4; ++m) _Pragma("unroll") for (int n = 0; n < 2; ++n) { \
        const v4i_t bl_ = Bt[n].lo, bh_ = Bt[n].hi, al_ = At[m].lo, ah_ = At[m].hi; v4i_t c_ = __builtin_bit_cast(v4i_t, acc[ai][bj][m][n]); \
        c_ = __builtin_amdgcn_mfma_i32_16x16x64_i8(bl_, al_, c_, 0, 0, 0); c_ = __builtin_amdgcn_mfma_i32_16x16x64_i8(bh_, ah_, c_, 0, 0, 0); acc[ai][bj][m][n] = __builtin_bit_cast(f32x4, c_); } __builtin_amdgcn_s_setprio(0); } while (0)
    typedef int v6i_t __attribute__((ext_vector_type(6)));
#define PG8_MMA6(ai, bj, At, Bt) do { __builtin_amdgcn_s_setprio(1); _Pragma("unroll") for (int m = 0; m < 4; ++m) _Pragma("unroll") for (int n = 0; n < 2; ++n) { \
        const v6i_t b6_ = __builtin_shufflevector(Bt[n], Bt[n], 0, 1, 2, 3, 4, 5), a6_ = __builtin_shufflevector(At[m], At[m], 0, 1, 2, 3, 4, 5); const int sb_ = Bt[n][7], sa_ = At[m][7]; \
        asm volatile("v_mfma_scale_f32_16x16x128_f8f6f4 %0, %1, %2, %0, %3, %4 op_sel:[0,0,0] op_sel_hi:[0,0,0] cbsz:2 blgp:2" : "+v"(acc[ai][bj][m][n]) : "v"(b6_), "v"(a6_), "v"(sb_), "v"(sa_)); } __builtin_amdgcn_s_setprio(0); } while (0)
#define PG8_MM(ai, bj, At, Bt) do { if constexpr (FP6) PG8_MMA6(ai, bj, At, Bt); else if constexpr (FP8) PG8_MMA8(ai, bj, At, Bt); else if constexpr (I8) PG8_MMAI(ai, bj, At, Bt); else PG8_MMA(ai, bj, At, Bt); } while (0)
#define PG8_WAIT_V(n) asm volatile("s_waitcnt vmcnt(" #n ")" ::: "memory")
#define PG8_WAIT_L(n) asm volatile("s_waitcnt lgkmcnt(" #n ")" ::: "memory")
#define PG8_WAIT_VR() asm volatile("s_waitcnt vmcnt(%0)" :: "n"((8 + Epi::NOPS + (Sched::KIND == 2 ? 4 : 0)) > 63 ? 63 : (8 + Epi::NOPS + (Sched::KIND == 2 ? 4 : 0))) : "memory")
#define PG8_BAR __builtin_amdgcn_s_barrier()
#define PG8_SCHED __builtin_amdgcn_sched_barrier(0)
    int tpm, tpn; { Unit u_; const bool ok_ = S.next(lane, u_); tpm = ok_ ? u_.pm : -1; tpn = ok_ ? u_.pn : 0; }
#define PG8_UNIT(i, u) (u.pm = __builtin_amdgcn_readlane(tpm, (i)), u.pn = __builtin_amdgcn_readlane(tpn, (i)), u.pm >= 0)
    Unit cur, nxt; int ui = 0;
    if (!PG8_UNIT(0, cur)) return;
    f32x4 acc[2][2][4][2];
#pragma unroll
    for (int a = 0; a < 2; ++a)
#pragma unroll
        for (int b = 0; b < 2; ++b)
#pragma unroll
            for (int m = 0; m < 4; ++m)
#pragma unroll
                for (int n = 0; n < 2; ++n) acc[a][b][m][n] = zero4();
    v8i_t At[4], B0[2], B1[2];
    unsigned vA[2][2], vN[2][2];
    const char* cA = S.a_base(cur); const char* cB = S.b_base(cur);
    S.a_offs(cur, RA, CA, vA);
#pragma unroll
    for (int h = 0; h < 2; ++h)
#pragma unroll
        for (int i = 0; i < 2; ++i) vN[h][i] = vA[h][i];
    if constexpr (epi_stage<Epi>::v) E.stage(cur, 0, wid, lane);
    PG8_STAGEB(PG8_SB(0, 0), cB); PG8_STAGEB(PG8_SB(0, 1), cB + hstep); PG8_STAGE2(PG8_SA(0, 0), cA, vA[0][0], vA[0][1]); PG8_STAGE2(PG8_SA(0, 1), cA, vA[1][0], vA[1][1]);
    if (wr == 1) PG8_BAR;
    PG8_WAIT_V(2); PG8_BAR;
    PG8_STAGEB(PG8_SB(1, 0), cB + kstep); PG8_STAGE2(PG8_SA(1, 0), cA + kstep, vA[0][0], vA[0][1]); PG8_STAGEB(PG8_SB(1, 1), cB + hstep + kstep);
    PG8_WAIT_V(6); PG8_BAR;
    for (;;) {
        const bool has_next = (ui + 1 < 64) && PG8_UNIT(ui + 1, nxt);
        const char* nA = has_next ? S.a_base(nxt) : cA; const char* nB = has_next ? S.b_base(nxt) : cB;
        if constexpr (Sched::KIND == 2) { if (has_next) S.pf(nxt, RA, wid); }
#ifndef GEMM_KREP
#define GEMM_KREP 1
#endif
        #ifndef KREP_KIND
#define KREP_KIND 2
#endif
        constexpr int KREP = ((FP8 || FP6) && Sched::KIND == KREP_KIND) ? GEMM_KREP : 1;
        for (int krep = 0; krep < KREP; ++krep) {
        const bool kfin = (krep == KREP - 1);
#pragma nounroll
        for (int t = 0; t < nt; t += 2) {
            const bool last = (t == nt - 2), lastf = last && kfin;
            const char* a1 = cA + (size_t)(t + 1) * kstep;
            if (lastf && has_next) { if constexpr (Sched::KIND == 2) S.a_offs_l(CA, vN, wid, lane); else S.a_offs(nxt, RA, CA, vN); }
            const char* a2 = last ? (kfin ? nA : cA) : cA + (size_t)(t + 2) * kstep; const char* b2 = last ? (kfin ? nB : cB) : cB + (size_t)(t + 2) * kstep;
            const char* a3 = a2 + kstep; const char* b3 = b2 + kstep;
            const unsigned u00 = lastf ? vN[0][0] : vA[0][0], u01 = lastf ? vN[0][1] : vA[0][1], u10 = lastf ? vN[1][0] : vA[1][0], u11 = lastf ? vN[1][1] : vA[1][1];
            const bool relax = (t == 0) && (ui > 0) && (krep == 0);
            PG8_LDB(B0, 0, 0); PG8_LDB(B1, 0, 1); PG8_SCHED; PG8_LDA(At, 0, 0); PG8_STAGE2(PG8_SA(1, 1), a1, vA[1][0], vA[1][1]);
            if (relax) PG8_WAIT_VR(); else PG8_WAIT_V(8); PG8_WAIT_L(0); PG8_BAR; PG8_MM(0, 0, At, B0); PG8_MM(0, 1, At, B1); PG8_BAR; PG8_SCHED;
            PG8_LDA(At, 0, 1); PG8_STAGEB(PG8_SB(0, 0), b2); PG8_STAGEB(PG8_SB(0, 1), b2 + hstep); PG8_STAGE2(PG8_SA(0, 0), a2, u00, u01);
            if (relax) PG8_WAIT_VR(); else PG8_WAIT_V(8); PG8_WAIT_L(0); PG8_BAR; PG8_MM(1, 0, At, B0); PG8_MM(1, 1, At, B1); PG8_BAR; PG8_SCHED;
            PG8_LDB(B0, 1, 0); PG8_LDB(B1, 1, 1); PG8_SCHED; PG8_LDA(At, 1, 0); PG8_STAGE2(PG8_SA(0, 1), a2, u10, u11);
            PG8_WAIT_V(8); PG8_WAIT_L(0); PG8_BAR; PG8_MM(0, 0, At, B0); PG8_MM(0, 1, At, B1); PG8_BAR; PG8_SCHED;
            PG8_LDA(At, 1, 1); PG8_STAGEB(PG8_SB(1, 0), b3); PG8_STAGEB(PG8_SB(1, 1), b3 + hstep); PG8_STAGE2(PG8_SA(1, 0), a3, u00, u01);
            PG8_WAIT_V(8); PG8_WAIT_L(0); PG8_BAR; PG8_MM(1, 0, At, B0); PG8_MM(1, 1, At, B1); PG8_BAR; PG8_SCHED;
        }
        }
        if (KREP > 1) {
#pragma unroll
            for (int a = 0; a < 2; ++a)
#pragma unroll
                for (int b = 0; b < 2; ++b)
#pragma unroll
                    for (int m = 0; m < 4; ++m)
#pragma unroll
                        for (int n = 0; n < 2; ++n) acc[a][b][m][n] *= (1.0f / KREP); }
        if constexpr (FP8 || FP6) asm volatile("s_nop 7\n\ts_nop 7\n\ts_nop 7" ::: "memory");
        if constexpr (ALIGN_EPI) { if (wr == 0) PG8_BAR; }
#ifndef EPI_RPT
#define EPI_RPT 1
#endif
        for (int er = 0; er < (Epi::NOPS == 8 ? EPI_RPT : 1); ++er)
        if constexpr (epi_stage<Epi>::v) E(acc, cur, wr, wc, fr, fq, ui & 1); else E(acc, cur, wr, wc, fr, fq);
        if (!has_next) break;
#pragma unroll
        for (int a = 0; a < 2; ++a)
#pragma unroll
            for (int b = 0; b < 2; ++b)
#pragma unroll
                for (int m = 0; m < 4; ++m)
#pragma unroll
                    for (int n = 0; n < 2; ++n) acc[a][b][m][n] = zero4();
        cur = nxt; cA = nA; cB = nB; ++ui;
        if constexpr (epi_stage<Epi>::v) E.stage(cur, ui & 1, wid, lane);
#pragma unroll
        for (int h = 0; h < 2; ++h)
#pragma unroll
            for (int i = 0; i < 2; ++i) vA[h][i] = vN[h][i];
        if constexpr (ALIGN_EPI) { if (wr == 1) PG8_BAR; }
    }
    PG8_WAIT_V(0);
    if constexpr (!ALIGN_EPI) { if (wr == 0) PG8_BAR; }
    PG8_BAR;
#undef PG8_UNIT
#undef PG8_SA
#undef PG8_SB
#undef PG8_STAGE2
#undef PG8_STAGEB
#undef PG8_LDA
#undef PG8_LD1
#undef PG8_LDB
#undef PG8_MMA
#undef PG8_MMA8
#undef PG8_MMA6
#undef PG8_MMAI
#undef PG8_MM
#undef PG8_WAIT_V
#undef PG8_WAIT_L
#undef PG8_WAIT_VR
#undef PG8_BAR
#undef PG8_SCHED
}
}
namespace pg8 {
constexpr int MOD_SZ = DEPTH * BATCH * 6 * D_MODEL;
constexpr int MOD_KS = 8;
__device__ __forceinline__ f32x4 mod4p(const float* modp, const float* ada_b, int layer, int b, int part, int col) {
    const int o = part * D_MODEL + col; const float* p = modp + (size_t)(layer * BATCH + b) * (6 * D_MODEL) + o;
    f32x4 v = *(const f32x4*)(ada_b + layer * (6 * D_MODEL) + o);
#pragma unroll
    for (int ks = 0; ks < MOD_KS; ++ks) v += *(const f32x4*)(p + (size_t)ks * MOD_SZ);
    return v;
}
__device__ __forceinline__ f32x4 mod4(const float* modr, int layer, int b, int part, int col) { return *(const f32x4*)(modr + (size_t)(layer * BATCH + b) * (6 * D_MODEL) + part * D_MODEL + col); }
#define EPR_LD4(W, BASE) do { const void* b_ = (const void*)(BASE); \
    asm volatile("global_load_dwordx4 %0, %4, off\n\tglobal_load_dwordx4 %1, %4, off offset:32\n\tglobal_load_dwordx4 %2, %4, off offset:256\n\tglobal_load_dwordx4 %3, %4, off offset:288" \
        : "=&v"(W[0]), "=&v"(W[1]), "=&v"(W[2]), "=&v"(W[3]) : "v"(b_) : "memory"); } while (0)
#define EPR_WAIT(N, W) asm volatile("s_waitcnt vmcnt(" #N ")" : "+v"(W[0]), "+v"(W[1]), "+v"(W[2]), "+v"(W[3]) :: "memory")
template <bool XIN16  > struct EpiResid {
    static constexpr bool PERM = false, PERM0 = false; static constexpr int NOPS = XIN16 ? 32 : 64;
    static constexpr bool STAGE = true;
    const void* xin; bf16_t* xout; const float* modr; const float* colscale; int layer, part; float scale; PG8_LAS float* stg;
    __device__ __forceinline__ void stage(const Unit& u, int par, int wid, int lane) const {
        const float* mv = modr + (size_t)(layer * BATCH + (u.pm * BM) / SEQ) * (6 * D_MODEL) + part * D_MODEL + u.pn * BM + 4 * lane;
        const float* src = (wid == 1 && colscale) ? colscale + u.pn * BM + 4 * lane : mv;
        __builtin_amdgcn_global_load_lds((const unsigned*)src, (PG8_LAS unsigned*)(stg + par * 2048 + wid * 256), 16, 0, 0); }
    __device__ __forceinline__ void operator()(const f32x4 (&acc)[2][2][4][2], const Unit& u, int wr, int wc, int fr, int fq, int par) const {
        const int row0 = u.pm * BM + wr * 64 + fr, col0 = u.pn * BM + wc * 32 + 4 * fq; const PG8_LAS float* sg = stg + par * 2048 + wc * 32 + 4 * fq;
        f32x4 gs[2][2];
#pragma unroll
        for (int bj = 0; bj < 2; ++bj)
#pragma unroll
            for (int n = 0; n < 2; ++n) { const int c = bj * HALF + n * 16; gs[bj][n] = *(const PG8_LAS f32x4*)(sg + c) * scale; if (colscale) gs[bj][n] *= *(const PG8_LAS f32x4*)(sg + 256 + c); }
        if constexpr (XIN16) {
            u32x4 wq[4][4];
#define EPR_OFF(gi) ((size_t)(row0 + ((gi) >> 1) * HALF + ((((gi) & 1) * 2) + (fq & 1)) * 16) * D_MODEL + (col0 - 4 * (fq & 1)))
            EPR_LD4(wq[0], (const bf16_t*)xin + EPR_OFF(0)); EPR_LD4(wq[1], (const bf16_t*)xin + EPR_OFF(1)); EPR_LD4(wq[2], (const bf16_t*)xin + EPR_OFF(2)); EPR_LD4(wq[3], (const bf16_t*)xin + EPR_OFF(3));
#pragma unroll
            for (int gi = 0; gi < 4; ++gi) { const int ai = gi >> 1, mp = (gi & 1) * 2; const size_t off = EPR_OFF(gi);
                EPR_WAIT(12, wq[gi]);
#pragma unroll
                for (int bj = 0; bj < 2; ++bj)
#pragma unroll
                    for (int n = 0; n < 2; ++n) { const u32x4 w = wq[gi][bj * 2 + n];
                        const auto sx = __builtin_amdgcn_permlane16_swap(w.x, w.z, false, false), sy = __builtin_amdgcn_permlane16_swap(w.y, w.w, false, false);
                        const f32x4 x0 = {__uint_as_float(sx[0] << 16), __uint_as_float(sx[0] & 0xffff0000u), __uint_as_float(sy[0] << 16), __uint_as_float(sy[0] & 0xffff0000u)};
                        const f32x4 x1 = {__uint_as_float(sx[1] << 16), __uint_as_float(sx[1] & 0xffff0000u), __uint_as_float(sy[1] << 16), __uint_as_float(sy[1] & 0xffff0000u)};
                        const f32x4 r0 = x0 + gs[bj][n] * acc[ai][bj][mp][n], r1 = x1 + gs[bj][n] * acc[ai][bj][mp + 1][n];
                        const auto tx = __builtin_amdgcn_permlane16_swap(cvt_pk_bf16(r0[0], r0[1]), cvt_pk_bf16(r1[0], r1[1]), false, false), ty = __builtin_amdgcn_permlane16_swap(cvt_pk_bf16(r0[2], r0[3]), cvt_pk_bf16(r1[2], r1[3]), false, false);
                        *(u32x4*)(xout + off + bj * HALF + n * 16) = (u32x4){tx[0], ty[0], tx[1], ty[1]}; }
                asm volatile("" ::: "memory"); }
#undef EPR_OFF
        } else
#pragma unroll
        for (int ai = 0; ai < 2; ++ai)
#pragma unroll
            for (int m = 0; m < 4; ++m) { const size_t off = (size_t)(row0 + ai * HALF + m * 16) * D_MODEL + col0;
#pragma unroll
                for (int bj = 0; bj < 2; ++bj)
#pragma unroll
                    for (int n = 0; n < 2; ++n) { f32x4 xv;
                        if constexpr (XIN16) { const u32x2 w = *(const u32x2*)((const bf16_t*)xin + off + bj * HALF + n * 16); xv = (f32x4){__uint_as_float(w.x << 16), __uint_as_float(w.x & 0xffff0000u), __uint_as_float(w.y << 16), __uint_as_float(w.y & 0xffff0000u)}; }
                        else xv = *(const f32x4*)((const float*)xin + off + bj * HALF + n * 16);
                        const f32x4 r = xv + gs[bj][n] * acc[ai][bj][m][n]; u32x2 o; o.x = cvt_pk_bf16(r[0], r[1]); o.y = cvt_pk_bf16(r[2], r[3]);
                        *(u32x2*)(xout + off + bj * HALF + n * 16) = o; }
                asm volatile("" ::: "memory"); }
    }
};
__device__ __forceinline__ unsigned cvt4_fp8(float a, float b, float c, float d) { unsigned w = 0u; w = __builtin_amdgcn_cvt_pk_fp8_f32(a, b, w, false); w = __builtin_amdgcn_cvt_pk_fp8_f32(c, d, w, true); return w; }
template <bool OUT8> struct EpiSwigluT {
    static constexpr bool PERM = true, PERM0 = true; static constexpr int NOPS = OUT8 ? 4 : 8;
    void* O; int ldo; float scale;
    __device__ __forceinline__ void operator()(const f32x4 (&acc)[2][2][4][2], const Unit& u, int wr, int wc, int fr, int fq) const {
        const int row0 = u.pm * BM + wr * 64 + fr, col0 = u.pn * HALF + wc * 32 + 8 * fq;
        const float c1 = -1.4426950408889634f * scale, c2i = 1.0f / (scale * scale);
        u32x2 wp = {0u, 0u};
#pragma unroll
        for (int ai = 0; ai < 2; ++ai)
#pragma unroll
            for (int m = 0; m < 4; ++m) { const size_t off = (size_t)(row0 + ai * HALF + m * 16) * ldo + col0; float v[8];
#pragma unroll
                for (int n = 0; n < 2; ++n)
#pragma unroll
                    for (int j = 0; j < 4; j += 2) {
                        const f32x2 g2 = {acc[ai][0][m][n][j], acc[ai][0][m][n][j + 1]}, u2 = {acc[ai][1][m][n][j], acc[ai][1][m][n][j + 1]};
                        const f32x2 p2 = g2 * u2, t2 = g2 * c1; const f32x2 d2 = (f32x2){__builtin_amdgcn_exp2f(t2.x), __builtin_amdgcn_exp2f(t2.y)} * c2i + c2i;
                        const f32x2 o2 = p2 * (f32x2){__builtin_amdgcn_rcpf(d2.x), __builtin_amdgcn_rcpf(d2.y)}; v[n * 4 + j] = o2.x; v[n * 4 + j + 1] = o2.y; }
                if constexpr (OUT8) { u32x2 w; w.x = cvt4_fp8(v[0], v[1], v[2], v[3]); w.y = cvt4_fp8(v[4], v[5], v[6], v[7]);
                    if ((m & 1) == 0) wp = w;
                    else { const auto sx = __builtin_amdgcn_permlane16_swap(wp.x, w.x, false, false), sy = __builtin_amdgcn_permlane16_swap(wp.y, w.y, false, false);
                        const u32x4 o = {sx[0], sy[0], sx[1], sy[1]}; const int mrow = (fq & 1) ? m : m - 1;
                        *(u32x4*)((unsigned char*)O + (size_t)(row0 + ai * HALF + mrow * 16) * ldo + (col0 - 8 * (fq & 1))) = o; } }
                else { u32x4 w; w.x = cvt_pk_bf16(v[0], v[1]); w.y = cvt_pk_bf16(v[2], v[3]); w.z = cvt_pk_bf16(v[4], v[5]); w.w = cvt_pk_bf16(v[6], v[7]); *(u32x4*)((bf16_t*)O + off) = w; } }
    }
};
template <bool OUT8  > struct EpiSwigluI8 {
    static constexpr bool PERM = true, PERM0 = true; static constexpr int NOPS = OUT8 ? 4 : 8;
    static constexpr bool STAGE = true;
    void* O; int ldo; const float* rs; const float* cmax; int F; PG8_LAS float* stg;
    __device__ __forceinline__ void stage(const Unit& u, int par, int wid, int lane) const {
        const float* src = (wid == 1) ? (lane < 32 ? cmax + u.pn * HALF + 4 * lane : cmax + F + u.pn * HALF + 4 * (lane - 32)) : rs + u.pm * BM + 4 * lane;
        __builtin_amdgcn_global_load_lds((const unsigned*)src, (PG8_LAS unsigned*)(stg + par * 2048 + wid * 256), 16, 0, 0); }
    __device__ __forceinline__ void operator()(const f32x4 (&acc)[2][2][4][2], const Unit& u, int wr, int wc, int fr, int fq, int par) const {
        const int row0 = u.pm * BM + wr * 64 + fr, col0 = u.pn * HALF + wc * 32 + 8 * fq; const PG8_LAS float* sg = stg + par * 2048;
        f32x4 cg[2], cu[2];
#pragma unroll
        for (int n = 0; n < 2; ++n) { cg[n] = *(const PG8_LAS f32x4*)(sg + 256 + wc * 32 + 8 * fq + 4 * n) * (1.0f / 127.0f); cu[n] = *(const PG8_LAS f32x4*)(sg + 384 + wc * 32 + 8 * fq + 4 * n) * (1.0f / 127.0f); }
        u32x2 wp = {0u, 0u};
#pragma unroll
        for (int ai = 0; ai < 2; ++ai)
#pragma unroll
            for (int m = 0; m < 4; ++m) { const int row = row0 + ai * HALF + m * 16; const float rsv = sg[wr * 64 + fr + ai * HALF + m * 16]; float v[8];
#pragma unroll
                for (int n = 0; n < 2; ++n)
#pragma unroll
                    for (int j = 0; j < 4; j += 2) {
                        const f32x2 gi = {(float)__float_as_int(acc[ai][0][m][n][j]), (float)__float_as_int(acc[ai][0][m][n][j + 1])}, ui = {(float)__float_as_int(acc[ai][1][m][n][j]), (float)__float_as_int(acc[ai][1][m][n][j + 1])};
                        const f32x2 g2 = gi * ((f32x2){cg[n][j], cg[n][j + 1]} * rsv), u2 = ui * ((f32x2){cu[n][j], cu[n][j + 1]} * rsv);
                        const f32x2 p2 = g2 * u2, t2 = g2 * -1.4426950408889634f; const f32x2 d2 = (f32x2){__builtin_amdgcn_exp2f(t2.x), __builtin_amdgcn_exp2f(t2.y)} + 1.0f;
                        const f32x2 o2 = p2 * (f32x2){__builtin_amdgcn_rcpf(d2.x), __builtin_amdgcn_rcpf(d2.y)}; v[n * 4 + j] = o2.x; v[n * 4 + j + 1] = o2.y; }
                if constexpr (OUT8) { u32x2 w; w.x = cvt4_fp8(v[0], v[1], v[2], v[3]); w.y = cvt4_fp8(v[4], v[5], v[6], v[7]);
                    if ((m & 1) == 0) wp = w;
                    else { const auto sx = __builtin_amdgcn_permlane16_swap(wp.x, w.x, false, false), sy = __builtin_amdgcn_permlane16_swap(wp.y, w.y, false, false);
                        const u32x4 o = {sx[0], sy[0], sx[1], sy[1]}; const int mrow = (fq & 1) ? m : m - 1;
                        *(u32x4*)((unsigned char*)O + (size_t)(row0 + ai * HALF + mrow * 16) * ldo + (col0 - 8 * (fq & 1))) = o; } }
                else { u32x4 w; w.x = cvt_pk_bf16(v[0], v[1]); w.y = cvt_pk_bf16(v[2], v[3]); w.z = cvt_pk_bf16(v[4], v[5]); w.w = cvt_pk_bf16(v[6], v[7]);
                    *(u32x4*)((bf16_t*)O + (size_t)row * ldo + col0) = w; } }
    }
};
struct EpiResidI8 {
    static constexpr bool PERM = false, PERM0 = false; static constexpr int NOPS = 32;
    static constexpr bool STAGE = true;
    const bf16_t* xin; bf16_t* xout; const float* modr; const float* rs; const float* cmax; int layer, part; PG8_LAS float* stg;
    __device__ __forceinline__ void stage(const Unit& u, int par, int wid, int lane) const {
        const float* src = (wid == 1) ? cmax + u.pn * BM + 4 * lane : (wid == 2) ? modr + (size_t)(layer * BATCH + (u.pm * BM) / SEQ) * (6 * D_MODEL) + part * D_MODEL + u.pn * BM + 4 * lane : rs + u.pm * BM + 4 * lane;
        __builtin_amdgcn_global_load_lds((const unsigned*)src, (PG8_LAS unsigned*)(stg + par * 2048 + wid * 256), 16, 0, 0); }
    __device__ __forceinline__ void operator()(const f32x4 (&acc)[2][2][4][2], const Unit& u, int wr, int wc, int fr, int fq, int par) const {
        const int row0 = u.pm * BM + wr * 64 + fr, col0 = u.pn * BM + wc * 32 + 4 * fq; const PG8_LAS float* sg = stg + par * 2048;
        f32x4 gs[2][2];
#pragma unroll
        for (int bj = 0; bj < 2; ++bj)
#pragma unroll
            for (int n = 0; n < 2; ++n) { const int c = wc * 32 + 4 * fq + bj * HALF + n * 16; gs[bj][n] = *(const PG8_LAS f32x4*)(sg + 512 + c) * *(const PG8_LAS f32x4*)(sg + 256 + c) * (1.0f / 127.0f); }
        u32x4 wq[4][4];
#define EPR_OFF(gi) ((size_t)(row0 + ((gi) >> 1) * HALF + ((gi) & 1) * 32 + (fq & 1) * 16) * D_MODEL + (col0 - 4 * (fq & 1)))
        EPR_LD4(wq[0], xin + EPR_OFF(0)); EPR_LD4(wq[1], xin + EPR_OFF(1)); EPR_LD4(wq[2], xin + EPR_OFF(2)); EPR_LD4(wq[3], xin + EPR_OFF(3));
#pragma unroll
        for (int gi = 0; gi < 4; ++gi) { const int ai = gi >> 1, mp = (gi & 1) * 2; const float rsv0 = sg[wr * 64 + fr + ai * HALF + mp * 16], rsv1 = sg[wr * 64 + fr + ai * HALF + mp * 16 + 16];
            const size_t off = EPR_OFF(gi);
            EPR_WAIT(12, wq[gi]);
#pragma unroll
            for (int bj = 0; bj < 2; ++bj)
#pragma unroll
                for (int n = 0; n < 2; ++n) { const u32x4 w = wq[gi][bj * 2 + n]; const f32x4 a0 = acc[ai][bj][mp][n], a1 = acc[ai][bj][mp + 1][n];
                    const auto sx = __builtin_amdgcn_permlane16_swap(w.x, w.z, false, false), sy = __builtin_amdgcn_permlane16_swap(w.y, w.w, false, false);
                    const f32x4 x0 = {__uint_as_float(sx[0] << 16), __uint_as_float(sx[0] & 0xffff0000u), __uint_as_float(sy[0] << 16), __uint_as_float(sy[0] & 0xffff0000u)};
                    const f32x4 x1 = {__uint_as_float(sx[1] << 16), __uint_as_float(sx[1] & 0xffff0000u), __uint_as_float(sy[1] << 16), __uint_as_float(sy[1] & 0xffff0000u)};
                    const f32x4 f0 = {(float)__float_as_int(a0[0]), (float)__float_as_int(a0[1]), (float)__float_as_int(a0[2]), (float)__float_as_int(a0[3])};
                    const f32x4 f1 = {(float)__float_as_int(a1[0]), (float)__float_as_int(a1[1]), (float)__float_as_int(a1[2]), (float)__float_as_int(a1[3])};
                    const f32x4 r0 = x0 + gs[bj][n] * rsv0 * f0, r1 = x1 + gs[bj][n] * rsv1 * f1;
                    const auto tx = __builtin_amdgcn_permlane16_swap(cvt_pk_bf16(r0[0], r0[1]), cvt_pk_bf16(r1[0], r1[1]), false, false), ty = __builtin_amdgcn_permlane16_swap(cvt_pk_bf16(r0[2], r0[3]), cvt_pk_bf16(r1[2], r1[3]), false, false);
                    *(u32x4*)(xout + off + bj * HALF + n * 16) = (u32x4){tx[0], ty[0], tx[1], ty[1]}; }
            asm volatile("" ::: "memory"); }
#undef EPR_OFF
    }
};
typedef EpiSwigluT<false> EpiSwiglu;
typedef EpiSwigluT<true> EpiSwiglu8;
struct EpiBf16 {
    static constexpr bool PERM = true, PERM0 = true; static constexpr int NOPS = 16;
    bf16_t* O; int ldo; float scale;
    __device__ __forceinline__ void operator()(const f32x4 (&acc)[2][2][4][2], const Unit& u, int wr, int wc, int fr, int fq) const {
        const int row0 = u.pm * BM + wr * 64 + fr, col0 = u.pn * BM + wc * 32 + 8 * fq;
#pragma unroll
        for (int ai = 0; ai < 2; ++ai)
#pragma unroll
            for (int m = 0; m < 4; ++m) { bf16_t* rowp = O + (size_t)(row0 + ai * HALF + m * 16) * ldo + col0;
#pragma unroll
                for (int bj = 0; bj < 2; ++bj) { const f32x4 v0 = acc[ai][bj][m][0] * scale, v1 = acc[ai][bj][m][1] * scale;
                    u32x4 w; w.x = cvt_pk_bf16(v0[0], v0[1]); w.y = cvt_pk_bf16(v0[2], v0[3]); w.z = cvt_pk_bf16(v1[0], v1[1]); w.w = cvt_pk_bf16(v1[2], v1[3]);
                    *(u32x4*)(rowp + bj * HALF) = w; } }
    }
};
constexpr unsigned ROPE_IFB[16] = {0x3f800000u, 0x3ee177bbu, 0x3e4693afu, 0x3daee4adu, 0x3d1a08c8u, 0x3c87a9c2u, 0x3beef74eu, 0x3b52771fu, 0x3ab95d22u, 0x3a23418cu, 0x398fc8f8u, 0x38fd45c2u, 0x385f10c5u, 0x37c47611u, 0x372d07a8u, 0x369864a7u};
typedef __fp16 h2_t __attribute__((ext_vector_type(2)));
__device__ __forceinline__ float xsum16(float s) { const auto r = __builtin_amdgcn_permlane16_swap(__float_as_uint(s), __float_as_uint(s), false, false); return __uint_as_float(r[0]) + __uint_as_float(r[1]); }
__device__ __forceinline__ float xsum32(float s) { const auto r = __builtin_amdgcn_permlane32_swap(__float_as_uint(s), __float_as_uint(s), false, false); return __uint_as_float(r[0]) + __uint_as_float(r[1]); }
struct EpiQKV {
    static constexpr bool PERM = true, PERM0 = false; static constexpr int NOPS = 16;
    static constexpr bool STAGE = true;
    bf16_t* qkvc; const float* qg; const float* kg; const int* pos; PG8_LAS float* tab; float scale; const unsigned* rope; const PG8_LAS float* gtab; PG8_LAS unsigned* cstg;
    __device__ __forceinline__ void stage(const Unit& u, int par, int wid, int lane) const { (void)par;
        const int which = (u.pn % 12) >> 2, wc = wid & 3, wr = wid >> 2;
        if (which < 2 && wc == 0) { const int fr = lane & 15, fq = lane >> 4, b = (u.pm * BM) / SEQ, p0 = (u.pm * BM) % SEQ + wr * 64 + fr;
#pragma unroll
            for (int ai = 0; ai < 2; ++ai)
#pragma unroll
                for (int m = 0; m < 4; ++m) __builtin_amdgcn_global_load_lds(rope + (size_t)(b * SEQ + p0 + ai * HALF + m * 16) * 16 + 4 * fq, cstg + wr * 2048 + (ai * 4 + m) * 256, 16, 0, 0); } }
    __device__ __forceinline__ void operator()(f32x4 (&acc)[2][2][4][2], const Unit& u, int wr, int wc, int fr, int fq, int par) const { (void)par;
        if (scale != 1.0f) {
#pragma unroll
            for (int ai = 0; ai < 2; ++ai)
#pragma unroll
                for (int bj = 0; bj < 2; ++bj)
#pragma unroll
                    for (int m = 0; m < 4; ++m) { acc[ai][bj][m][0] *= scale; acc[ai][bj][m][1] *= scale; } }
        const int g = u.pn / 12, which = (u.pn % 12) >> 2, hp = u.pn & 3, sh = 2 * g, d = 1 << sh;
        const int b = (u.pm * BM) / SEQ, p0 = (u.pm * BM) % SEQ + wr * 64 + fr;
        bf16_t* base = qkvc + (size_t)(g * 3 + which) * ((size_t)M_TOK * D_MODEL) + (wc == 0 ? 4 * fq : wc * 32 + 8 * fq);
        const int Lg = SEQ >> sh;
        auto store_rows = [&](int ai, int m) __attribute__((always_inline)) { const int p = p0 + ai * HALF + m * 16, j = p >> sh, r = p & (d - 1);
#pragma unroll
            for (int bj = 0; bj < 2; ++bj) { const int h = 2 * hp + bj; const f32x4 v0 = acc[ai][bj][m][0], v1 = acc[ai][bj][m][1];
                u32x4 w; w.x = cvt_pk_bf16(v0[0], v0[1]); w.y = cvt_pk_bf16(v0[2], v0[3]); w.z = cvt_pk_bf16(v1[0], v1[1]); w.w = cvt_pk_bf16(v1[2], v1[3]);
                bf16_t* dst = base + ((size_t)(((b << sh) | r) * NHEAD + h) * Lg + j) * HEAD_DIM;
                if (wc == 0) {
                    const auto sx = __builtin_amdgcn_permlane16_swap(w.x, w.z, false, false), sy = __builtin_amdgcn_permlane16_swap(w.y, w.w, false, false);
                    *(u32x4*)(dst + ((fq & 1) ? 16 - 4 : 0)) = (u32x4){sx[0], sy[0], sx[1], sy[1]}; }
                else *(u32x4*)dst = w; } };
        if (which < 2) {
            const PG8_LAS float* gain = gtab + (which * 3 + g) * HEAD_DIM + (wc == 0 ? 4 * fq : wc * 32 + 8 * fq);
            const f32x4 g0 = *(const PG8_LAS f32x4*)gain, g1 = *(const PG8_LAS f32x4*)(gain + (wc == 0 ? 16 : 4));
#pragma unroll
            for (int ai = 0; ai < 2; ++ai)
#pragma unroll
                for (int bj = 0; bj < 2; ++bj) { float sq[4];
#pragma unroll
                    for (int m = 0; m < 4; ++m) { const f32x4 a = acc[ai][bj][m][0], c = acc[ai][bj][m][1]; const f32x4 q = a * a + c * c; sq[m] = (q[0] + q[1]) + (q[2] + q[3]); }
                    const auto r01 = __builtin_amdgcn_permlane16_swap(__float_as_uint(sq[0]), __float_as_uint(sq[1]), false, false); const float z = __uint_as_float(r01[0]) + __uint_as_float(r01[1]);
                    const auto r23 = __builtin_amdgcn_permlane16_swap(__float_as_uint(sq[2]), __float_as_uint(sq[3]), false, false); const float w = __uint_as_float(r23[0]) + __uint_as_float(r23[1]);
                    const auto rr = __builtin_amdgcn_permlane32_swap(__float_as_uint(z), __float_as_uint(w), false, false);
                    tab[((((ai * 2 + bj) * 4 + fq) * 2 + wr) * 16 + fr) * 4 + wc] = __uint_as_float(rr[0]) + __uint_as_float(rr[1]); }
            asm volatile("s_waitcnt lgkmcnt(0)" ::: "memory"); __builtin_amdgcn_s_barrier(); asm volatile("" ::: "memory");
#pragma unroll
            for (int ai = 0; ai < 2; ++ai)
#pragma unroll
                for (int m = 0; m < 4; ++m) {
#pragma unroll
                    for (int bj = 0; bj < 2; ++bj) { const f32x4 t = *(const PG8_LAS f32x4*)(tab + ((((ai * 2 + bj) * 4 + m) * 2 + wr) * 16 + fr) * 4);
                        const float rstd = __builtin_amdgcn_rsqf(((t[0] + t[1]) + (t[2] + t[3])) * (1.0f / HEAD_DIM) + NORM_EPS);
                        acc[ai][bj][m][0] = acc[ai][bj][m][0] * rstd * g0; acc[ai][bj][m][1] = acc[ai][bj][m][1] * rstd * g1; }
                    if (wc == 0) {
                        const u32x4 cw = *(const PG8_LAS u32x4*)(cstg + wr * 2048 + (ai * 4 + m) * 256 + (fq * 16 + fr) * 4);
#pragma unroll
                        for (int j = 0; j < 4; j += 2) { const unsigned w0 = cw[j], w1 = cw[j + 1]; const h2_t h0 = __builtin_bit_cast(h2_t, w0), h1 = __builtin_bit_cast(h2_t, w1);
                            const f32x2 cs = {(float)h0[0], (float)h1[0]}, sn = {(float)h0[1], (float)h1[1]};
#pragma unroll
                            for (int bj = 0; bj < 2; ++bj) { const f32x2 x1 = {acc[ai][bj][m][0][j], acc[ai][bj][m][0][j + 1]}, x2 = {acc[ai][bj][m][1][j], acc[ai][bj][m][1][j + 1]};
                                const f32x2 o1 = x1 * cs - x2 * sn, o2 = x2 * cs + x1 * sn;
                                acc[ai][bj][m][0][j] = o1.x; acc[ai][bj][m][0][j + 1] = o1.y; acc[ai][bj][m][1][j] = o2.x; acc[ai][bj][m][1][j + 1] = o2.y; } }
                    }
                    store_rows(ai, m);
                }
        } else {
#pragma unroll
            for (int ai = 0; ai < 2; ++ai)
#pragma unroll
                for (int m = 0; m < 4; ++m) store_rows(ai, m); }
    }
};
}
namespace swa {
constexpr int D = 128;
constexpr float THR = 8.f;
constexpr bool WSKIP = true;
constexpr float SCALE = 0.08838834764831845f;
constexpr int NW = 8, QBLK = 32, KVBLK = 64, QB = NW * QBLK;
constexpr int SHM_V = KVBLK * D * 2, SHM_K = KVBLK * D * 2;
constexpr int LDS_BYTES = 2 * SHM_V + 2 * SHM_K + NW * 64 * 4;
constexpr int O_STAGE_OFF = 69632, O_STAGE_BYTES = NW * QBLK * D * 2;
using bf16 = __hip_bfloat16;
typedef short bf16x8 __attribute__((ext_vector_type(8)));
typedef short s16x4 __attribute__((ext_vector_type(4)));
typedef float f32x16 __attribute__((ext_vector_type(16)));
typedef float f32x4 __attribute__((ext_vector_type(4)));
typedef unsigned u32x4 __attribute__((ext_vector_type(4)));
template <class A, class Bt> struct same_t { static constexpr bool v = false; };
template <class A> struct same_t<A, A> { static constexpr bool v = true; };

#define KSWZ(row, colB) ((row) * 256 + ((colB) ^ (((row) & 7) << 4)))
#define SBAR() __builtin_amdgcn_sched_barrier(0)
__device__ __forceinline__ int v_st(int k, int c) { const int kk = (k & ~0xC) | ((k & 4) << 1) | ((k & 8) >> 1); return ((kk >> 3) * 4 + (c >> 5)) * 512 + ((kk & 7) * 32 + (c & 31)) * 2; }
__device__ __forceinline__ int v_rd_base(int lane) { return ((lane & 3) << 3) | (((lane >> 2) & 3) << 6) | (((lane >> 4) & 1) << 5) | (((lane >> 5) & 1) << 8); }
constexpr int v_rd_off(int d0, int ks, int half) { return d0 * 512 + ks * 4096 + half * 2048; }
__device__ __forceinline__ int crow(int r, int hi) { return (r & 3) + 8 * (r >> 2) + 4 * hi; }
__device__ __forceinline__ unsigned cvtpk(float lo, float hi) {
    unsigned r; asm volatile("v_cvt_pk_bf16_f32 %0, %1, %2" : "=v"(r) : "v"(lo), "v"(hi)); return r;
}
__device__ __forceinline__ bf16x8 pack8(f32x4 a, f32x4 b) {
    u32x4 w = {cvtpk(a[0], a[1]), cvtpk(a[2], a[3]), cvtpk(b[0], b[1]), cvtpk(b[2], b[3])};
    return *reinterpret_cast<bf16x8*>(&w);
}
template <class T> __device__ __forceinline__ bf16x8 load8(const T* p) {
    if constexpr (same_t<T, float>::v) { return pack8(*(const f32x4*)p, *(const f32x4*)(p + 4)); }
    else { return *reinterpret_cast<const bf16x8*>(p); }
}
__device__ __forceinline__ void mask_tile(f32x16& p0, f32x16& p1, int dq, unsigned W) {
    const float NEG = -__builtin_inff();
#pragma unroll
    for (int r = 0; r < 16; ++r) {
        const int c = (r & 3) + 8 * (r >> 2);
        if ((unsigned)(dq - c) >= W) p0[r] = NEG;
        if ((unsigned)(dq - c - 32) >= W) p1[r] = NEG;
    }
}
__device__ __forceinline__ void partialSM(f32x16& p0, f32x16& p1, float& m_reg, float& mn, float& alpha) {
    float pmax = p0[0]; for (int r = 1; r < 16; ++r) pmax = fmaxf(pmax, p0[r]); for (int r = 0; r < 16; ++r) pmax = fmaxf(pmax, p1[r]);
    { auto rr = __builtin_amdgcn_permlane32_swap(__float_as_uint(pmax), __float_as_uint(pmax), false, false);
      pmax = fmaxf(__uint_as_float(rr[0]), __uint_as_float(rr[1])); }
    constexpr float C2 = 1.4426950408889634f * SCALE;
    if (__builtin_expect(__all((pmax - m_reg) * SCALE <= THR), 1)) { mn = m_reg; alpha = 1.f; }
    else { mn = fmaxf(m_reg, pmax); alpha = __builtin_amdgcn_exp2f((m_reg - mn) * C2); m_reg = mn; }
    const float mnL = -mn * C2;
    for (int r = 0; r < 16; ++r) p0[r] = fmaf(p0[r], C2, mnL); for (int r = 0; r < 16; ++r) p1[r] = fmaf(p1[r], C2, mnL);
    for (int r = 0; r < 16; ++r) p0[r] = __builtin_amdgcn_exp2f(p0[r]);
}
__device__ __forceinline__ void finishSM(f32x16& p0, f32x16& p1, float alpha, float& l_reg, bf16x8& pa0, bf16x8& pa1, bf16x8& pa2, bf16x8& pa3) {
    for (int r = 0; r < 16; ++r) p1[r] = __builtin_amdgcn_exp2f(p1[r]);
    float ps = 0; for (int r = 0; r < 16; ++r) ps += p0[r]; for (int r = 0; r < 16; ++r) ps += p1[r];
    { auto rr = __builtin_amdgcn_permlane32_swap(__float_as_uint(ps), __float_as_uint(ps), false, false);
      ps = __uint_as_float(rr[0]) + __uint_as_float(rr[1]); }
    l_reg = l_reg * alpha + ps;
#define PK4(P, B_, OUT) do { unsigned a0 = cvtpk(P[B_+0], P[B_+1]), a1 = cvtpk(P[B_+2], P[B_+3]);                          \
        unsigned b0 = cvtpk(P[B_+4], P[B_+5]), b1 = cvtpk(P[B_+6], P[B_+7]);                                             \
        auto r0 = __builtin_amdgcn_permlane32_swap(a0, b0, false, false); auto r1 = __builtin_amdgcn_permlane32_swap(a1, b1, false, false); \
        u32x4 w = {r0[0], r1[0], r0[1], r1[1]}; OUT = *reinterpret_cast<bf16x8*>(&w); } while (0)
    PK4(p0, 0, pa0); PK4(p0, 8, pa1); PK4(p1, 0, pa2); PK4(p1, 8, pa3);
#undef PK4
}
template <int KB, bool SK>
__device__ __forceinline__ void qkt(f32x16& p0, f32x16& p1, const char* K_lds, int r32, int hi, const bf16x8* qr, bool act) {
    if (SK && !act) { const float NEG = -__builtin_inff();
#pragma unroll
        for (int r = 0; r < 16; ++r) { p0[r] = NEG; p1[r] = NEG; } return; }
    p0 = f32x16{}; p1 = f32x16{};
    const char* kb[4];
#pragma unroll
    for (int dd = 0; dd < 4; ++dd) kb[dd] = K_lds + KB * SHM_K + KSWZ(r32, (dd * 16 + hi * 8) * 2);
#pragma unroll
    for (int d0 = 0; d0 < 8; ++d0) { const char* a = kb[d0 & 3] + (d0 >> 2) * 128;
        bf16x8 b0 = *reinterpret_cast<const bf16x8*>(a);
        bf16x8 b1 = *reinterpret_cast<const bf16x8*>(a + 32 * 256);
        p0 = __builtin_amdgcn_mfma_f32_32x32x16_bf16(b0, qr[d0], p0, 0, 0, 0);
        p1 = __builtin_amdgcn_mfma_f32_32x32x16_bf16(b1, qr[d0], p1, 0, 0, 0); }
}
template <int VB, bool SK>
__device__ __forceinline__ void pv_tile(f32x16* o, int vb0, bf16x8 pa0, bf16x8 pa1, bf16x8 pa2, bf16x8 pa3, bool act) {
    if (SK && !act) return;
#define TRRD(dst, off) asm volatile("ds_read_b64_tr_b16 %0, %1 offset:%2" : "=&v"(dst) : "v"(vb0), "i"(off) : "memory")
#define PV_D0(d0) do { s16x4 l0, l1, l2, l3, h0, h1, h2, h3; constexpr int b_ = VB * SHM_V + v_rd_off(d0, 0, 0);     \
        TRRD(l0, b_); TRRD(h0, b_ + 2048); TRRD(l1, b_ + 4096); TRRD(h1, b_ + 6144); TRRD(l2, b_ + 8192); TRRD(h2, b_ + 10240); TRRD(l3, b_ + 12288); TRRD(h3, b_ + 14336); \
        asm volatile("s_waitcnt lgkmcnt(0)" ::: "memory"); SBAR();                 \
        o[d0] = __builtin_amdgcn_mfma_f32_32x32x16_bf16(pa0, (bf16x8){l0[0], l0[1], l0[2], l0[3], h0[0], h0[1], h0[2], h0[3]}, o[d0], 0, 0, 0);   \
        o[d0] = __builtin_amdgcn_mfma_f32_32x32x16_bf16(pa1, (bf16x8){l1[0], l1[1], l1[2], l1[3], h1[0], h1[1], h1[2], h1[3]}, o[d0], 0, 0, 0);   \
        o[d0] = __builtin_amdgcn_mfma_f32_32x32x16_bf16(pa2, (bf16x8){l2[0], l2[1], l2[2], l2[3], h2[0], h2[1], h2[2], h2[3]}, o[d0], 0, 0, 0);   \
        o[d0] = __builtin_amdgcn_mfma_f32_32x32x16_bf16(pa3, (bf16x8){l3[0], l3[1], l3[2], l3[3], h3[0], h3[1], h3[2], h3[3]}, o[d0], 0, 0, 0); } while (0)
    PV_D0(0); PV_D0(1); PV_D0(2); PV_D0(3);
#undef PV_D0
#undef TRRD
}

template <class TIn, class TOut> struct BlockRef { const TIn* Q; const TIn* K; const TIn* V; TOut* O; int P0; };
template <class TIn> struct Seam {
    bf16x8 qr[8];
    bf16x8 st_v0, st_v1, st_k0, st_k1; f32x4 sf0, sf1, sf2, sf3;
    f32x4 tq[16];
};
__device__ __forceinline__ int swa_jlo(int P0, int W) { const int lowk = P0 - W + 1; return lowk > 0 ? lowk / KVBLK : 0; }
#define ROW(p, k0, rr) ((p) + (size_t)((k0) + (rr)) * D + sc)
#define VMW() asm volatile("s_waitcnt vmcnt(0)" ::: "memory")
#define VMWN(n) asm volatile("s_waitcnt vmcnt(%0)" :: "i"(n) : "memory")
#define SLOAD_H(Kp, Vp, k0) do { S.st_v0 = load8<TIn>(ROW(Vp, k0, sr)); S.st_v1 = load8<TIn>(ROW(Vp, k0, 32 + sr));              \
                         S.st_k0 = load8<TIn>(ROW(Kp, k0, sr)); S.st_k1 = load8<TIn>(ROW(Kp, k0, 32 + sr)); } while (0)
#define SWRITE_HK(bf) do { *(bf16x8*)(K_lds + (bf) * SHM_K + kws) = S.st_k0; *(bf16x8*)(K_lds + (bf) * SHM_K + kws + 32 * 256) = S.st_k1; } while (0)
#define SWRITE_HV(bf) do { *(bf16x8*)(V_lds + (bf) * SHM_V + vst0) = S.st_v0; *(bf16x8*)(V_lds + (bf) * SHM_V + vst1) = S.st_v1; } while (0)
#define SWRITE_H(bf) do { SWRITE_HV(bf); SWRITE_HK(bf); } while (0)
#define SLOAD_F(p, k0) do { S.sf0 = *(const f32x4*)ROW(p, k0, sr); S.sf1 = *(const f32x4*)(ROW(p, k0, sr) + 4);                \
                            S.sf2 = *(const f32x4*)ROW(p, k0, 32 + sr); S.sf3 = *(const f32x4*)(ROW(p, k0, 32 + sr) + 4); } while (0)
#define SWRITE_KF(bf) do { *(bf16x8*)(K_lds + (bf) * SHM_K + kws) = pack8(S.sf0, S.sf1); *(bf16x8*)(K_lds + (bf) * SHM_K + kws + 32 * 256) = pack8(S.sf2, S.sf3); } while (0)
#define SWRITE_VF(bf) do { *(bf16x8*)(V_lds + (bf) * SHM_V + vst0) = pack8(S.sf0, S.sf1); *(bf16x8*)(V_lds + (bf) * SHM_V + vst1) = pack8(S.sf2, S.sf3); } while (0)
template <class TIn, class TOut>
__device__ __forceinline__ void causal_swa_prime(const BlockRef<TIn, TOut>& cur, int W, char* lds, Seam<TIn>& S) {
    constexpr bool F32 = same_t<TIn, float>::v;
    int tid = threadIdx.x; asm volatile("" : "+v"(tid));
    const int wid = __builtin_amdgcn_readfirstlane(tid >> 6), lane = tid & 63, r32 = lane & 31, hi = lane >> 5;
    const int sr = tid >> 4, sc = (tid & 15) * 8, kws = KSWZ(sr, sc * 2); char* K_lds = lds + 2 * SHM_V;
    const int kb0 = swa_jlo(cur.P0, W) * KVBLK;
    for (int d0 = 0; d0 < 8; ++d0) S.qr[d0] = load8<TIn>(cur.Q + (size_t)(wid * QBLK + r32) * D + d0 * 16 + hi * 8);
    if constexpr (F32) { SLOAD_F((const float*)cur.K, kb0); VMW(); SWRITE_KF(0); SBAR(); SLOAD_F((const float*)cur.V, kb0); }
    else { SLOAD_H(cur.K, cur.V, kb0); VMW(); SWRITE_HK(0); }
    __syncthreads();
}
template <class TIn, class TOut>
__device__ __forceinline__ void causal_swa_block(const BlockRef<TIn, TOut>& cur, const BlockRef<TIn, TOut>& nxt, int skv, int W, char* lds, Seam<TIn>& S, const char* og_base, char* lse_base) {
    constexpr bool F32 = same_t<TIn, float>::v;
    int tid = threadIdx.x; asm volatile("" : "+v"(tid));
    const int wid = __builtin_amdgcn_readfirstlane(tid >> 6), lane = tid & 63, r32 = lane & 31, hi = lane >> 5;
    const int j_lo = swa_jlo(cur.P0, W);
    int j_hi = (cur.P0 + QB - 1) / KVBLK + 1; if (j_hi > skv / KVBLK) j_hi = skv / KVBLK;
    const int NT = j_hi - j_lo;
    const int kbn = swa_jlo(nxt.P0, W) * KVBLK;
    const int qlo = cur.P0 + wid * QBLK, qm = qlo + r32 - 4 * hi;
    char* V_lds = lds; char* K_lds = lds + 2 * SHM_V;
    float* ws = (float*)(lds + 2 * SHM_V + 2 * SHM_K) + wid * 64; float* li_l = ws, * al_l = ws + 32;
    float m_reg = -1e30f, l_reg = 0; f32x16 o[4] = {};
    const int sr = tid >> 4, sc = (tid & 15) * 8, vst0 = v_st(sr, sc), vst1 = v_st(32 + sr, sc), kws = KSWZ(sr, sc * 2);
    const int vb0 = (int)(uintptr_t)V_lds + v_rd_base(lane);
    const TIn* Kh = cur.K; const TIn* Vh = cur.V;
#define RESC(a) do { if (__any((a) < 1.f)) { if (hi == 0) al_l[r32] = (a); asm volatile("s_waitcnt lgkmcnt(0)" ::: "memory");              \
                     for (int d_ = 0; d_ < 4; ++d_) for (int r = 0; r < 16; ++r) o[d_][r] *= al_l[crow(r, hi)]; } } while (0)
#define KBASE(t) ((j_lo + (t)) * KVBLK)
#define ACT(t) (KBASE(t) <= qlo + QBLK - 1 && KBASE(t) + KVBLK - 1 >= qlo - W + 1)
#define MASKT(P0_, P1_, t) do { const int kb_ = KBASE(t); if ((!SK || ACT(t)) && (kb_ + KVBLK - 1 > qlo || kb_ <= qlo + QBLK - 1 - W)) mask_tile(P0_, P1_, qm - kb_, (unsigned)W); } while (0)
    constexpr int NQL = F32 ? 16 : 8;
    constexpr bool SK = WSKIP && !F32;
#define SEAM_K0() do { VMWN(NQL); if constexpr (F32) { SWRITE_KF(0); SBAR(); SLOAD_F((const float*)nxt.V, kbn); } else { SWRITE_HK(0); } SBAR(); } while (0)
    f32x16 pA0, pA1, pB0, pB1; float mnA, mnB, alA, alB; bf16x8 pa0, pa1, pa2, pa3;
    if constexpr (F32) { VMW(); SWRITE_VF(0); SBAR(); } else { SWRITE_HV(0); SBAR(); }
    if (NT > 1) { if constexpr (F32) SLOAD_F((const float*)Kh, KBASE(1)); else SLOAD_H(Kh, Vh, KBASE(1)); }
    SBAR(); qkt<0, SK>(pA0, pA1, K_lds, r32, hi, S.qr, ACT(0));
    if constexpr (F32) { if (NT > 1) { VMW(); SWRITE_KF(1); SBAR(); SLOAD_F((const float*)Vh, KBASE(1)); } }
    MASKT(pA0, pA1, 0); partialSM(pA0, pA1, m_reg, mnA, alA);
    if (NT > 1) { VMW(); if constexpr (F32) { SWRITE_VF(1); SBAR(); if (NT > 2) SLOAD_F((const float*)Kh, KBASE(2)); } else SWRITE_H(1); }
    __syncthreads();
#define HALF_STEP(PX0, PX1, mnX, alX, PY0, PY1, alY, t, KB, VB, SB) do {                                                      \
        SBAR(); qkt<KB, SK>(PX0, PX1, K_lds, r32, hi, S.qr, ACT(t));                                             \
        finishSM(PY0, PY1, alY, l_reg, pa0, pa1, pa2, pa3); SBAR();                                                           \
        if ((t) + 1 < NT) { if constexpr (F32) { VMW(); SWRITE_KF(SB); SBAR(); SLOAD_F((const float*)Vh, KBASE((t) + 1)); }  \
                            else { SLOAD_H(Kh, Vh, KBASE((t) + 1)); } SBAR(); }                                               \
        pv_tile<VB, SK>(o, vb0, pa0, pa1, pa2, pa3, ACT((t) - 1)); MASKT(PX0, PX1, (t)); partialSM(PX0, PX1, m_reg, mnX, alX);                                        \
        __syncthreads();                                                                                                      \
        if ((t) + 1 < NT) { VMW(); if constexpr (F32) { SWRITE_VF(SB); SBAR(); if ((t) + 2 < NT) SLOAD_F((const float*)Kh, KBASE((t) + 2)); } \
                            else { SWRITE_H(SB); } }                                                                          \
        RESC(alX); __syncthreads(); } while (0)
    for (int t = 1; t + 1 < NT; t += 2) {
        HALF_STEP(pB0, pB1, mnB, alB, pA0, pA1, alA, t, 1, 0, 0);
        HALF_STEP(pA0, pA1, mnA, alA, pB0, pB1, alB, t + 1, 0, 1, 1);
    }
    const bool even = (NT & 1) == 0;
    if (even) { SBAR(); qkt<1, SK>(pB0, pB1, K_lds, r32, hi, S.qr, ACT(NT - 1)); SBAR(); }
#define QROW(e) (nxt.Q + (size_t)(wid * QBLK + r32) * D + ((e) >> 1) * 16 + hi * 8 + ((e) & 1) * 4)
    if constexpr (F32) { SLOAD_F((const float*)nxt.K, kbn); SBAR();
#pragma unroll
        for (int e = 0; e < 8; ++e) S.tq[e] = *(const f32x4*)QROW(e); }
    else { SLOAD_H(nxt.K, nxt.V, kbn); SBAR();
#pragma unroll
        for (int d0 = 0; d0 < 8; ++d0) S.qr[d0] = load8<TIn>(nxt.Q + (size_t)(wid * QBLK + r32) * D + d0 * 16 + hi * 8); }
    SBAR();
    finishSM(pA0, pA1, alA, l_reg, pa0, pa1, pa2, pa3); SBAR();
    if constexpr (F32) {
#pragma unroll
        for (int e = 8; e < 16; ++e) S.tq[e] = *(const f32x4*)QROW(e); SBAR(); }
#undef QROW
    pv_tile<0, SK>(o, vb0, pa0, pa1, pa2, pa3, ACT(even ? NT - 2 : NT - 1));
    if (even) { MASKT(pB0, pB1, NT - 1); partialSM(pB0, pB1, m_reg, mnB, alB); __syncthreads(); RESC(alB);
        finishSM(pB0, pB1, alB, l_reg, pa0, pa1, pa2, pa3); SBAR(); pv_tile<1, SK>(o, vb0, pa0, pa1, pa2, pa3, ACT(NT - 1)); }
    SBAR(); SEAM_K0();
    if (hi == 0) { li_l[r32] = l_reg; ((float*)(lse_base + (((const char*)cur.O - og_base) >> 6)))[wid * QBLK + r32] = m_reg * SCALE + __logf(l_reg); } asm volatile("s_waitcnt lgkmcnt(0)" ::: "memory");
    float rli[16];
#pragma unroll
    for (int r = 0; r < 16; ++r) rli[r] = __builtin_amdgcn_rcpf(li_l[crow(r, hi)]);
    TOut* Ow = cur.O + (size_t)(wid * QBLK) * D;
    unsigned short* ostg = (unsigned short*)(lds + O_STAGE_OFF) + wid * (QBLK * D);
#pragma unroll
    for (int r = 0; r < 16; ++r) { const int orow = crow(r, hi);
#pragma unroll
        for (int d0 = 0; d0 < 4; ++d0) { const float v = o[d0][r] * rli[r];
            if constexpr (same_t<TOut, float>::v) { Ow[(size_t)orow * D + d0 * 32 + r32] = v; }
            else { ostg[orow * D + d0 * 32 + r32] = (unsigned short)cvtpk(v, v); } } }
    if constexpr (!same_t<TOut, float>::v) {
#pragma unroll
        for (int i = 0; i < 8; ++i) { const int row = i * 4 + (lane >> 4), ch = lane & 15; const u32x4 w = *(const u32x4*)(ostg + row * D + ch * 8); *(u32x4*)(Ow + (size_t)row * D + ch * 8) = w; } }
    if constexpr (F32) {
#pragma unroll
        for (int d0 = 0; d0 < 8; ++d0) S.qr[d0] = pack8(S.tq[2 * d0], S.tq[2 * d0 + 1]); }
    __syncthreads();
#undef RESC
#undef KBASE
#undef ACT
#undef MASKT
#undef SEAM_K0
#undef HALF_STEP
}
#undef ROW
#undef VMW
#undef VMWN
#undef SLOAD_H
#undef SWRITE_HK
#undef SWRITE_HV
#undef SWRITE_H
#undef SLOAD_F
#undef SWRITE_KF
#undef SWRITE_VF


}
namespace att2 {
typedef short bf16x8 __attribute__((ext_vector_type(8)));
typedef short s16x4 __attribute__((ext_vector_type(4)));
typedef float f32x4 __attribute__((ext_vector_type(4)));
typedef unsigned u32x2 __attribute__((ext_vector_type(2)));
#define A2_LAS __attribute__((address_space(3)))
constexpr int SLOT_BYTES = 128 * 256, K_OFF = 0, V_OFF = 2 * SLOT_BYTES;
constexpr float SCALE = 0.08838834764831845f, C2 = 1.4426950408889634f * SCALE;
__device__ __forceinline__ unsigned off_b(unsigned row, unsigned ch) { return 256u * row + 16u * (ch ^ (((row & 3u) << 2) | ((row >> 2) & 3u))); }
struct Item { size_t e; int g, blk; };
__device__ __forceinline__ Item decode(int I) {
    const int g = I >> 11, rem = I & 2047, lb = 6 - 2 * g, chain = rem >> lb, blk = rem & ((1 << lb) - 1), Lg = SEQ >> (2 * g);
    Item it; it.e = (size_t)chain * Lg * HEAD_DIM + (size_t)blk * 128 * HEAD_DIM; it.g = g; it.blk = blk; return it;
}
constexpr size_t SUB = (size_t)M_TOK * D_MODEL;
#define A2_Q(it) (qkvc + (size_t)((it).g * 3 + 0) * SUB + (it).e)
#define A2_K(it) (qkvc + (size_t)((it).g * 3 + 1) * SUB + (it).e)
#define A2_V(it) (qkvc + (size_t)((it).g * 3 + 2) * SUB + (it).e)
__device__ __forceinline__ void ld_block(const unsigned short* blk, int tid, bf16x8 (&r)[4]) {
#pragma unroll
    for (int i = 0; i < 4; ++i) { const int piece = 512 * i + tid; r[i] = *(const bf16x8*)(blk + (size_t)(piece >> 4) * HEAD_DIM + (piece & 15) * 8); }
}
__device__ __forceinline__ void st_block(A2_LAS unsigned char* slot, int tid, const bf16x8 (&r)[4]) {
#pragma unroll
    for (int i = 0; i < 4; ++i) { const int piece = 512 * i + tid; *(A2_LAS bf16x8*)(slot + off_b((unsigned)(piece >> 4), (unsigned)(piece & 15))) = r[i]; }
}
__device__ __forceinline__ unsigned cvtpk(float lo, float hi) { unsigned r; asm volatile("v_cvt_pk_bf16_f32 %0, %1, %2" : "=v"(r) : "v"(lo), "v"(hi)); return r; }
__device__ __forceinline__ float xmax16(float v) { const auto r = __builtin_amdgcn_permlane16_swap(__float_as_uint(v), __float_as_uint(v), false, false); return fmaxf(__uint_as_float(r[0]), __uint_as_float(r[1])); }
__device__ __forceinline__ float xmax32(float v) { const auto r = __builtin_amdgcn_permlane32_swap(__float_as_uint(v), __float_as_uint(v), false, false); return fmaxf(__uint_as_float(r[0]), __uint_as_float(r[1])); }
__device__ __forceinline__ float xadd16(float v) { const auto r = __builtin_amdgcn_permlane16_swap(__float_as_uint(v), __float_as_uint(v), false, false); return __uint_as_float(r[0]) + __uint_as_float(r[1]); }
__device__ __forceinline__ float xadd32(float v) { const auto r = __builtin_amdgcn_permlane32_swap(__float_as_uint(v), __float_as_uint(v), false, false); return __uint_as_float(r[0]) + __uint_as_float(r[1]); }
#define A2_WAITV(n) asm volatile("s_waitcnt vmcnt(" #n ")" ::: "memory")
#define A2_BAR() do { asm volatile("s_waitcnt lgkmcnt(0)" ::: "memory"); __builtin_amdgcn_s_barrier(); asm volatile("" ::: "memory"); } while (0)

__device__ __forceinline__ void attn_phase(A2_LAS unsigned char* lds, const unsigned short* qkvc, unsigned short* og, float* lse, int I0, int I1) {
    int tid = threadIdx.x; asm volatile("" : "+v"(tid));
    const int wid = __builtin_amdgcn_readfirstlane(tid >> 6), lane = tid & 63, li = lane & 15, g = lane >> 4;
    if (I0 >= I1) return;
    Item cur = decode(I0);
    bf16x8 kr[4], vr[4], qf[4], qn[4];
    { ld_block(A2_K(cur), tid, kr); ld_block(A2_V(cur), tid, vr); st_block(lds + K_OFF, tid, kr); st_block(lds + V_OFF, tid, vr);
      if (cur.blk > 0) { ld_block(A2_K(cur) - 128 * HEAD_DIM, tid, kr); ld_block(A2_V(cur) - 128 * HEAD_DIM, tid, vr); }
      else {
#pragma unroll
          for (int i = 0; i < 4; ++i) { kr[i] = (bf16x8){0, 0, 0, 0, 0, 0, 0, 0}; vr[i] = kr[i]; } }
      st_block(lds + K_OFF + SLOT_BYTES, tid, kr); st_block(lds + V_OFF + SLOT_BYTES, tid, vr);
#pragma unroll
      for (int s = 0; s < 4; ++s) qf[s] = *(const bf16x8*)(A2_Q(cur) + (size_t)(16 * wid + li) * HEAD_DIM + 32 * s + 8 * g); }
    Item nxt = (I0 + 1 < I1) ? decode(I0 + 1) : cur;
    ld_block(A2_K(nxt), tid, kr); ld_block(A2_V(nxt), tid, vr);
#pragma unroll
    for (int s = 0; s < 4; ++s) qn[s] = *(const bf16x8*)(A2_Q(nxt) + (size_t)(16 * wid + li) * HEAD_DIM + 32 * s + 8 * g);
    for (int I = I0, n = 0; I < I1; ++I, ++n) {
        const int cs = n & 1;
        const bool more = I + 1 < I1; const Item nn = (I + 2 < I1) ? decode(I + 2) : nxt;
        A2_BAR();
        f32x4 st[9];
#ifndef A2_QK_RPT
#define A2_QK_RPT 1
#endif
        for (int qrep = 0; qrep < A2_QK_RPT; ++qrep)
#pragma unroll
        for (int t = 0; t < 9; ++t) { const int T = wid + t; const unsigned prow = (unsigned)((((T >> 3) ^ cs ^ 1) << 7) + ((16 * T + li) & 127));
            const unsigned k0 = 256u * prow + ((((unsigned)g) ^ (((prow & 3u) << 2) | ((prow >> 2) & 3u))) << 4);
            f32x4 acc = {0.f, 0.f, 0.f, 0.f};
#pragma unroll
            for (int s = 0; s < 4; ++s) { const bf16x8 kf = *(const A2_LAS bf16x8*)(lds + K_OFF + (k0 ^ ((unsigned)s << 6))); acc = __builtin_amdgcn_mfma_f32_16x16x32_bf16(kf, qf[s], acc, 0, 0, 0); }
            st[t] = acc; }
#pragma unroll
        for (int r = 0; r < 4; ++r) { st[0][r] = (4 * g + r >= li) ? st[0][r] : -__builtin_inff(); st[8][r] = (4 * g + r <= li) ? st[8][r] : -__builtin_inff(); }
        if (cur.blk == 0) {
#pragma unroll
            for (int t = 0; t < 9; ++t) { const float lim = (wid + t < 8) ? -__builtin_inff() : __builtin_inff();
                st[t] = __builtin_elementwise_min(st[t], (f32x4){lim, lim, lim, lim}); } }
        float mx = -1e30f;
#pragma unroll
        for (int t = 0; t < 9; ++t) mx = fmaxf(mx, fmaxf(fmaxf(st[t][0], st[t][1]), fmaxf(st[t][2], st[t][3])));
        mx = xmax32(xmax16(mx));
        float lsum = 0.f; const float mb = -mx * C2;
        f32x4 ls4 = {0.f, 0.f, 0.f, 0.f};
#pragma unroll
        for (int t = 0; t < 9; ++t) { const f32x4 a = st[t] * C2 + mb;
            st[t] = (f32x4){__builtin_amdgcn_exp2f(a[0]), __builtin_amdgcn_exp2f(a[1]), __builtin_amdgcn_exp2f(a[2]), __builtin_amdgcn_exp2f(a[3])}; ls4 += st[t]; }
        lsum = (ls4[0] + ls4[1]) + (ls4[2] + ls4[3]);
        lsum = xadd32(xadd16(lsum));
        bf16x8 pf[5];
#pragma unroll
        for (int ks = 0; ks < 5; ++ks) { const unsigned a0 = cvtpk(st[2 * ks][0], st[2 * ks][1]), a1 = cvtpk(st[2 * ks][2], st[2 * ks][3]), b0 = ks < 4 ? cvtpk(st[ks < 4 ? 2 * ks + 1 : 0][0], st[ks < 4 ? 2 * ks + 1 : 0][1]) : 0u, b1 = ks < 4 ? cvtpk(st[ks < 4 ? 2 * ks + 1 : 0][2], st[ks < 4 ? 2 * ks + 1 : 0][3]) : 0u;
            const unsigned __attribute__((ext_vector_type(4))) w = {a0, a1, b0, b1}; pf[ks] = __builtin_bit_cast(bf16x8, w); }
        f32x4 o[8];
#pragma unroll
        for (int c = 0; c < 8; ++c) o[c] = (f32x4){0.f, 0.f, 0.f, 0.f};
        const unsigned vbase = (unsigned)(uintptr_t)(lds + V_OFF);
#pragma unroll
        for (int ks = 0; ks < 5; ++ks) {
            unsigned v0a[2];
#pragma unroll
            for (int t2 = 0; t2 < (ks < 4 ? 2 : 1); ++t2) { const int T = wid + 2 * ks + t2; const unsigned row = (unsigned)((((T >> 3) ^ cs ^ 1) << 7) + ((16 * T + 4 * g + (li >> 2)) & 127));
                v0a[t2] = vbase + 256u * row + ((((unsigned)(li & 3) >> 1) ^ (((row & 3u) << 2) | ((row >> 2) & 3u))) << 4) + 8u * (unsigned)(li & 1); }
            s16x4 va[8], vb[8];
#pragma unroll
            for (int c = 0; c < 8; ++c) {
                asm volatile("ds_read_b64_tr_b16 %0, %1" : "=v"(va[c]) : "v"(v0a[0] ^ ((unsigned)c << 5)) : "memory");
                if (ks < 4) asm volatile("ds_read_b64_tr_b16 %0, %1" : "=v"(vb[c]) : "v"(v0a[1] ^ ((unsigned)c << 5)) : "memory"); else vb[c] = (s16x4){0, 0, 0, 0}; }
            asm volatile("s_waitcnt lgkmcnt(0)" : "+v"(va[0]), "+v"(va[1]), "+v"(va[2]), "+v"(va[3]), "+v"(va[4]), "+v"(va[5]), "+v"(va[6]), "+v"(va[7]), "+v"(vb[0]), "+v"(vb[1]), "+v"(vb[2]), "+v"(vb[3]), "+v"(vb[4]), "+v"(vb[5]), "+v"(vb[6]), "+v"(vb[7]) :: "memory");
#pragma unroll
            for (int c = 0; c < 8; ++c) { const bf16x8 vf = {va[c][0], va[c][1], va[c][2], va[c][3], vb[c][0], vb[c][1], vb[c][2], vb[c][3]};
                o[c] = __builtin_amdgcn_mfma_f32_16x16x32_bf16(vf, pf[ks], o[c], 0, 0, 0); }
        }
        A2_BAR();
        st_block(lds + K_OFF + (cs ^ 1) * SLOT_BYTES, tid, kr); ld_block(A2_K(nn), tid, kr);
        st_block(lds + V_OFF + (cs ^ 1) * SLOT_BYTES, tid, vr); ld_block(A2_V(nn), tid, vr);
#pragma unroll
        for (int s = 0; s < 4; ++s) { qf[s] = qn[s]; qn[s] = *(const bf16x8*)(A2_Q(nn) + (size_t)(16 * wid + li) * HEAD_DIM + 32 * s + 8 * g); }
        const float inv = __builtin_amdgcn_rcpf(lsum);
        unsigned short* orow = og + (size_t)cur.g * SUB + cur.e + (size_t)(16 * wid + li) * HEAD_DIM + 4 * g;
#pragma unroll
        for (int c = 0; c < 8; ++c) { const f32x4 ov = o[c] * inv; u32x2 w; w.x = cvtpk(ov[0], ov[1]); w.y = cvtpk(ov[2], ov[3]); *(u32x2*)(orow + 16 * c) = w; }
        if (g == 0) lse[(size_t)cur.g * ((size_t)M_TOK * NHEAD) + (cur.e >> 7) + 16 * wid + li] = mx * SCALE + __logf(lsum);
        (void)more; cur = nxt; nxt = nn;
    }
    A2_BAR();
}
#undef A2_WAITV
#undef A2_BAR
#undef A2_LAS
#undef A2_Q
#undef A2_K
#undef A2_V
}
constexpr int NWAVES = 8;
#ifndef MK_PER_PHASE
#define MK_PER_PHASE 0
#endif
constexpr int PH_PER_PAIR = 14, NPHASES = 2 + 2 * PH_PER_PAIR;

constexpr size_t MiB = 1u << 20;
constexpr size_t WS_CTL = 0, CTL_ZERO_BYTES = 1 * MiB;
constexpr size_t WS_MODP = 1 * MiB;
constexpr size_t WS_MODR = 4 * MiB;
constexpr size_t WS_RS = 5 * MiB;
constexpr size_t WS_EIDX = 7 * MiB, WS_GATE = 7 * MiB + 256 * 1024, WS_SLOTOF = 7 * MiB + 512 * 1024, WS_STOK = 8 * MiB;
constexpr size_t WS_LSE = 9 * MiB;
constexpr size_t WS_ROPE = 12 * MiB;
constexpr size_t WS_WQKV = 16 * MiB, WS_WO = 52 * MiB, WS_WGU = 56 * MiB, WS_WDN = 78 * MiB, WS_WPOOL = 89 * MiB, WS_WMGU = 90 * MiB, WS_WMDN = 314 * MiB;
constexpr size_t WS_XB = 432 * MiB;
constexpr size_t WS_H = 560 * MiB;
constexpr size_t WS_BIG = 624 * MiB;
constexpr size_t WS_QKVC = WS_BIG, WS_OG = WS_BIG + 576 * MiB;
constexpr size_t WS_ACT = WS_BIG;
constexpr size_t WS_Y = WS_BIG + 480 * MiB;
constexpr size_t WS_END = WS_BIG + 768 * MiB;
constexpr int MAX_TILES = 2 * M_TOK / 256 + N_EXP, MAX_SLOTS = MAX_TILES * 256;
static_assert(WS_ACT + (size_t)MAX_SLOTS * D_FFE * 2 <= WS_Y && WS_Y + (size_t)MAX_SLOTS * D_MODEL * 2 <= WS_END && WS_STOK + (size_t)MAX_SLOTS * 4 <= WS_LSE, "d_ws map");
constexpr int CW_BAR = 4096;
constexpr int CW_CMAXO = 90112;
constexpr int CW_CMAX = 65536;
constexpr int CW_CNT = 8192, CW_CUR = 12288;

constexpr int RING_OFF = 0, RING_BYTES = 131072;
constexpr int TAB_OFF = RING_BYTES;
constexpr int MISC_OFF = TAB_OFF + 8192 + 16384;
constexpr int LDS_BYTES = 159744;
static_assert(MISC_OFF + 128 <= LDS_BYTES && LDS_BYTES <= 163840 && 69632 + 65536 <= MISC_OFF, "LDS map (the attention phase stages its O tile at [69632, 135168))");

#define GAS __attribute__((address_space(1)))
#define LAS __attribute__((address_space(3)))
typedef unsigned short bf16;
typedef unsigned v4u __attribute__((ext_vector_type(4)));
typedef unsigned v2u __attribute__((ext_vector_type(2)));
typedef int v2i __attribute__((ext_vector_type(2)));
typedef float f32x4 __attribute__((ext_vector_type(4)));
typedef float f32x2 __attribute__((ext_vector_type(2)));
#define LDS_WAIT() asm volatile("s_waitcnt lgkmcnt(0)" ::: "memory")
#define VM_WAIT() asm volatile("s_waitcnt vmcnt(0)" ::: "memory")
__device__ __forceinline__ unsigned pk2(float lo, float hi) { return pg8::cvt_pk_bf16(lo, hi); }
__device__ __forceinline__ float bflo(unsigned w) { return __uint_as_float(w << 16); }
__device__ __forceinline__ float bfhi(unsigned w) { return __uint_as_float(w & 0xffff0000u); }
#define MK_DPP(v, ctrl) __uint_as_float((unsigned)__builtin_amdgcn_update_dpp(0, (int)__float_as_uint(v), (ctrl), 0xf, 0xf, true))
__device__ __forceinline__ float wave_sum(float v) {
    v += MK_DPP(v, 0xB1); v += MK_DPP(v, 0x4E); v += MK_DPP(v, 0x141); v += MK_DPP(v, 0x140);
    { const auto r = __builtin_amdgcn_permlane16_swap(__float_as_uint(v), __float_as_uint(v), false, false); v = __uint_as_float(r[0]) + __uint_as_float(r[1]); }
    { const auto r = __builtin_amdgcn_permlane32_swap(__float_as_uint(v), __float_as_uint(v), false, false); v = __uint_as_float(r[0]) + __uint_as_float(r[1]); }
    return v;
}
__device__ __forceinline__ float wave_max(float v) {
    v = fmaxf(v, MK_DPP(v, 0xB1)); v = fmaxf(v, MK_DPP(v, 0x4E)); v = fmaxf(v, MK_DPP(v, 0x141)); v = fmaxf(v, MK_DPP(v, 0x140));
    { const auto r = __builtin_amdgcn_permlane16_swap(__float_as_uint(v), __float_as_uint(v), false, false); v = fmaxf(__uint_as_float(r[0]), __uint_as_float(r[1])); }
    { const auto r = __builtin_amdgcn_permlane32_swap(__float_as_uint(v), __float_as_uint(v), false, false); v = fmaxf(__uint_as_float(r[0]), __uint_as_float(r[1])); }
    return v;
}
__device__ __forceinline__ int rdlane_i(int v, int l) { return __builtin_amdgcn_readlane(v, l); }
__device__ __forceinline__ float rdlane_f(float v, int l) { return __uint_as_float((unsigned)__builtin_amdgcn_readlane((int)__float_as_uint(v), l)); }

#define XB_TMO      128
#define XB_XCNT(j)  (256  + 64 * (j))
#define XB_XSUB(j)  (1280 + 64 * (j))
#define XB_XGEN(j)  (2304 + 64 * (j))
#define XB_TOP      3328
#define XB_TOPGEN   3392
#define XCD_BAR_WORDS 3456
#define XB_SPIN_CAP (1u << 18)

__device__ __forceinline__ unsigned xb_ld(unsigned* p)              { return __hip_atomic_load(p, __ATOMIC_RELAXED, __HIP_MEMORY_SCOPE_AGENT); }
__device__ __forceinline__ unsigned xb_add(unsigned* p, unsigned v) { return __hip_atomic_fetch_add(p, v, __ATOMIC_RELAXED, __HIP_MEMORY_SCOPE_AGENT); }
__device__ __forceinline__ unsigned xb_xcc_id() { return (unsigned)__builtin_amdgcn_s_getreg((3 << 11) | 20) & 0xFu; }
#define XB_SPIN(cond, bar) do { unsigned _sp = 0; while (cond) { __builtin_amdgcn_s_sleep(1); \
    if ((++_sp & 255u) == 0u) { if (xb_ld(&(bar)[XB_TMO])) break; if (_sp > XB_SPIN_CAP) { atomicAdd(&(bar)[XB_TMO], 1u); break; } } } } while (0)

struct XcdBarrier {
    unsigned* bar; unsigned x;
    volatile LAS unsigned* st;
};

__device__ __forceinline__ XcdBarrier xcd_barrier_post(unsigned* bar, volatile LAS unsigned* st) {
    XcdBarrier b; b.bar = bar; b.x = xb_xcc_id(); b.st = st;
    if (threadIdx.x == 0) (void)xb_add(&bar[XB_XCNT(b.x)], 1u);
    return b;
}
__device__ __forceinline__ void xcd_barrier_complete(unsigned* bar, unsigned x, unsigned& nloc, unsigned& nx) {
    const unsigned G = gridDim.x * gridDim.y * gridDim.z;
    unsigned sum, cnt, mine, sp = 0u;
    for (;;) {
        sum = 0u; cnt = 0u; mine = 0u;
#pragma unroll
        for (unsigned j = 0; j < 16; ++j) { const unsigned c = xb_ld(&bar[XB_XCNT(j)]); sum += c; cnt += (c > 0u) ? 1u : 0u; mine = (j == x) ? c : mine; }
        if (sum == G) break;
        __builtin_amdgcn_s_sleep(1);
        if ((++sp & 255u) == 0u) { if (xb_ld(&bar[XB_TMO])) break; if (sp > XB_SPIN_CAP) { atomicAdd(&bar[XB_TMO], 1u); break; } }
    }
    nloc = mine > 0u ? mine : 1u; nx = cnt > 0u ? cnt : 1u;
}

template <class F> __device__ __forceinline__ void xcd_barrier(const XcdBarrier& b, F work) {
    asm volatile("s_waitcnt vmcnt(0)" ::: "memory");
    __syncthreads();
    if (threadIdx.x >= 64) work();
    if (threadIdx.x == 0) {
        unsigned* bar = b.bar;
        __builtin_amdgcn_s_waitcnt(0);
        unsigned nloc = b.st[0], nx = b.st[1];
        if (nloc == 0u) { xcd_barrier_complete(bar, b.x, nloc, nx); b.st[0] = nloc; b.st[1] = nx; }
        const unsigned old = xb_add(&bar[XB_XSUB(b.x)], 1u);
        const unsigned gen = old / nloc;
        if (old + 1u == (gen + 1u) * nloc) {
            __builtin_amdgcn_fence(__ATOMIC_RELEASE, "agent");
            asm volatile("s_waitcnt vmcnt(0)" ::: "memory");
            const unsigned og = xb_add(&bar[XB_TOP], 1u);
            const unsigned tg = og / nx;
            if (og + 1u == (tg + 1u) * nx) xb_add(&bar[XB_TOPGEN], 1u);
            else XB_SPIN(xb_ld(&bar[XB_TOPGEN]) == tg, bar);
            __builtin_amdgcn_fence(__ATOMIC_ACQUIRE, "agent");
            xb_add(&bar[XB_XGEN(b.x)], 1u);
            asm volatile("s_waitcnt vmcnt(0)" ::: "memory");
        } else {
            XB_SPIN(xb_ld(&bar[XB_XGEN(b.x)]) == gen, bar);
            __builtin_amdgcn_fence(__ATOMIC_ACQUIRE, "agent");
            asm volatile("s_waitcnt vmcnt(0)" ::: "memory");
        }
    }
    __syncthreads();
}
__device__ __forceinline__ void xcd_barrier(const XcdBarrier& b) { xcd_barrier(b, [] {}); }
using pg8::mod4; using pg8::mod4p;
__device__ __forceinline__ int gu_row(int n0, int F) { return n0 < F ? (n0 >> 7) * 256 + (n0 & 127) : ((n0 - F) >> 7) * 256 + 128 + ((n0 - F) & 127); }
struct TrItem { const float* W; bf16* WT; int N, Kd; };
__device__ __forceinline__ void tr_load(const TrItem& t, int lane, f32x4 (&r)[8]) {
    const float* p = t.W + (size_t)(lane >> 3) * t.N + 4 * (lane & 7);
#pragma unroll
    for (int i = 0; i < 8; ++i) r[i] = *(const GAS f32x4*)(p + (size_t)(8 * i) * t.N);
}
__device__ __forceinline__ void tr_store(const TrItem& t, int lane, const f32x4 (&r)[8], LAS float* scr) {
    LAS float* w = scr + (lane >> 3) * 33 + 4 * (lane & 7);
#pragma unroll
    for (int i = 0; i < 8; ++i) { LAS float* q = w + (8 * i) * 33; q[0] = r[i].x; q[1] = r[i].y; q[2] = r[i].z; q[3] = r[i].w; }
    LDS_WAIT(); asm volatile("" ::: "memory");
    const int c = lane & 7;
#pragma unroll
    for (int j = 0; j < 4; ++j) { const int n = (lane >> 3) + 8 * j; const LAS float* s = scr + (8 * c) * 33 + n;
        v4u o; o.x = pk2(s[0 * 33], s[1 * 33]); o.y = pk2(s[2 * 33], s[3 * 33]); o.z = pk2(s[4 * 33], s[5 * 33]); o.w = pk2(s[6 * 33], s[7 * 33]);
        *(GAS v4u*)(t.WT + (size_t)n * t.Kd + 8 * c) = o; }
    LDS_WAIT(); asm volatile("" ::: "memory");
}
struct TrItem8 { const float* W; unsigned char* WT; int N, Kd, f6; };
__device__ __forceinline__ void tr8_load(const TrItem8& t, int lane, f32x4 (&r)[8]) {
    const float* p = t.W + (size_t)(lane >> 2) * t.N + 4 * (lane & 3);
#pragma unroll
    for (int i = 0; i < 8; ++i) r[i] = *(const GAS f32x4*)(p + (size_t)(16 * i) * t.N);
}
typedef float v16f __attribute__((ext_vector_type(16)));
typedef unsigned v6u __attribute__((ext_vector_type(6)));
__device__ __forceinline__ unsigned f6_scale_byte(float am) { return (__float_as_uint(am * (1.0f / 7.5f)) + 0x7FFFFFu) >> 23; }
__device__ __forceinline__ float f6_inv(unsigned sb) { return __uint_as_float((254u - sb) << 23); }
__device__ __forceinline__ void tr6_store(const TrItem8& t, int lane, const f32x4 (&r)[8], LAS float* scr) {
    LAS float* w = scr + (lane >> 2) * 17 + 4 * (lane & 3);
#pragma unroll
    for (int i = 0; i < 8; ++i) { LAS float* q = w + (16 * i) * 17 + 8 * (i >> 1); q[0] = r[i].x; q[1] = r[i].y; q[2] = r[i].z; q[3] = r[i].w; }
    LDS_WAIT(); asm volatile("" ::: "memory");
    const int n = lane >> 2, fq = lane & 3; const LAS float* s = scr + (32 * fq) * 17 + 8 * fq + n;
    v16f s0, s1; float am = 0.f;
#pragma unroll
    for (int i = 0; i < 16; ++i) { const float a = s[i * 17], b = s[(16 + i) * 17]; s0[i] = a; s1[i] = b; am = fmaxf(am, fmaxf(fabsf(a), fabsf(b))); }
    const unsigned sb = f6_scale_byte(am); const float f = f6_inv(sb);
    s0 *= f; s1 *= f;
    const v6u c = __builtin_amdgcn_cvt_scalef32_2xpk16_fp6_f32(s0, s1, 1.0f);
    LAS unsigned char* stg = (LAS unsigned char*)scr + 10240;
    *(LAS v4u*)(stg + n * 144 + 16 * fq) = (v4u){c[0], c[1], c[2], c[3]}; *(LAS v4u*)(stg + n * 144 + 64 + 16 * fq) = (v4u){c[4], c[5], 0u, sb};
    LDS_WAIT(); asm volatile("" ::: "memory");
#pragma unroll
    for (int j = 0; j < 2; ++j) { const int row = (lane >> 3) + 8 * j, ch = lane & 7; *(GAS v4u*)(t.WT + (size_t)row * t.Kd + 16 * ch) = *(const LAS v4u*)(stg + row * 144 + 16 * ch); }
    LDS_WAIT(); asm volatile("" ::: "memory");
}
__device__ __forceinline__ void tr8_store(const TrItem8& t, int lane, const f32x4 (&r)[8], LAS float* scr) {
    LAS float* w = scr + (lane >> 2) * 17 + 4 * (lane & 3);
#pragma unroll
    for (int i = 0; i < 8; ++i) { LAS float* q = w + (16 * i) * 17; q[0] = r[i].x; q[1] = r[i].y; q[2] = r[i].z; q[3] = r[i].w; }
    LDS_WAIT(); asm volatile("" ::: "memory");
    const int c = lane & 7;
#pragma unroll
    for (int j = 0; j < 2; ++j) { const int n = (lane >> 3) + 8 * j; const LAS float* s = scr + (16 * c) * 17 + n; v4u o;
#pragma unroll
        for (int q = 0; q < 4; ++q) o[q] = pg8::cvt4_fp8(64.0f * s[(4 * q) * 17], 64.0f * s[(4 * q + 1) * 17], 64.0f * s[(4 * q + 2) * 17], 64.0f * s[(4 * q + 3) * 17]);
        *(GAS v4u*)(t.WT + (size_t)n * t.Kd + 16 * c) = o; }
    LDS_WAIT(); asm volatile("" ::: "memory");
}
struct ProIn { const float *c, *ada_w, *pool_w, *wqkv, *wo, *wgu, *wdn, *mgu, *mdn; const int* pos; };
#ifndef MOE_FP8
#define MOE_FP8 1
#endif
#ifndef QKV_FP8
#define QKV_FP8 1
#endif
#ifndef QKV_FP6
#define QKV_FP6 1
#endif
#ifndef MGU_FP6
#define MGU_FP6 0
#endif
#ifndef FFN_GU_FP8
#define FFN_GU_FP8 0
#endif
#ifndef FFN_GU_I8
#define FFN_GU_I8 1
#endif
#ifndef WO_I8
#define WO_I8 1
#endif
#ifndef FFN_DN_FP8
#define FFN_DN_FP8 1
#endif
constexpr int TI_QKV = QKV_FP8 ? 0 : 2 * 16 * 288, TI_WO = WO_I8 ? 0 : 2 * 16 * 32, TI_GU = (FFN_GU_FP8 || FFN_GU_I8) ? 0 : 2 * 16 * 176, TI_DN = FFN_DN_FP8 ? 0 : 2 * 44 * 32, TI_POOL = 8 * 4 * 8, TI_MGU = MOE_FP8 ? 0 : 16 * 16 * 224, TI_MDN = MOE_FP8 ? 0 : 16 * 56 * 32;
constexpr int TI_ALL = TI_QKV + TI_WO + TI_GU + TI_DN + TI_POOL + TI_MGU + TI_MDN;
constexpr int T8_MGU = MOE_FP8 ? 16 * 8 * 448 : 0, T8_MDN = MOE_FP8 ? 16 * 28 * 64 : 0, T8_QKV = QKV_FP8 ? 2 * 8 * 576 : 0, T8_GU = (FFN_GU_FP8 && !FFN_GU_I8) ? 2 * 8 * 352 : 0, T8_DN = FFN_DN_FP8 ? 2 * 22 * 64 : 0;
constexpr int T8_ALL = T8_MGU + T8_MDN + T8_QKV + T8_GU + T8_DN;
constexpr size_t MGU8_BYTES = (size_t)2 * D_FFE * D_MODEL * (MOE_FP8 ? 1 : 2), MDN8_BYTES = (size_t)D_MODEL * D_FFE * (MOE_FP8 ? 1 : 2);
constexpr size_t WO8_BYTES = (size_t)D_MODEL * D_MODEL * (WO_I8 ? 1 : 2);
constexpr size_t QKV8_BYTES = (size_t)QKV_W * D_MODEL * (QKV_FP8 ? 1 : 2);
constexpr size_t GU8_BYTES = (size_t)2 * D_FF * D_MODEL * ((FFN_GU_FP8 || FFN_GU_I8) ? 1 : 2), DN8_BYTES = (size_t)D_MODEL * D_FF * (FFN_DN_FP8 ? 1 : 2);
__device__ __forceinline__ TrItem8 tr8_decode(const ProIn& I, unsigned char* ws, int it) {
    TrItem8 t;
    if (it < T8_MGU) { const int je = it / (8 * 448), r = it % (8 * 448), kb = r / 448, nb = r % 448, k0 = 128 * kb, n0 = 16 * nb;
        t.f6 = MGU_FP6; t.W = I.mgu + (size_t)je * 1024 * 2 * D_FFE + (size_t)k0 * (2 * D_FFE) + n0; t.WT = ws + WS_WMGU + (size_t)je * MGU8_BYTES + (size_t)gu_row(n0, D_FFE) * D_MODEL + k0; t.N = 2 * D_FFE; t.Kd = D_MODEL; }
    else { it -= T8_MGU;
    if (it < T8_MDN) { const int je = it / (28 * 64), r = it % (28 * 64), kb = r / 64, nb = r % 64, k0 = 128 * kb, n0 = 16 * nb;
        t.f6 = 0; t.W = I.mdn + (size_t)je * D_FFE * 1024 + (size_t)k0 * 1024 + n0; t.WT = ws + WS_WMDN + (size_t)je * MDN8_BYTES + (size_t)n0 * D_FFE + k0; t.N = 1024; t.Kd = D_FFE; }
    else { it -= T8_MDN;
    if (it < T8_QKV) { const int j = it / (8 * 576), r = it % (8 * 576), kb = r / 576, nb = r % 576, k0 = 128 * kb, n0 = 16 * nb;
        t.f6 = QKV_FP6; t.W = I.wqkv + (size_t)j * 1024 * QKV_W + (size_t)k0 * QKV_W + n0; t.WT = ws + WS_WQKV + (size_t)j * QKV8_BYTES + (size_t)n0 * D_MODEL + k0; t.N = QKV_W; t.Kd = D_MODEL; }
    else { it -= T8_QKV;
    if (it < T8_GU) { const int j = it / (8 * 352), r = it % (8 * 352), kb = r / 352, nb = r % 352, k0 = 128 * kb, n0 = 16 * nb;
        t.f6 = 0; t.W = I.wgu + (size_t)j * 1024 * 2 * D_FF + (size_t)k0 * (2 * D_FF) + n0; t.WT = ws + WS_WGU + (size_t)j * GU8_BYTES + (size_t)gu_row(n0, D_FF) * D_MODEL + k0; t.N = 2 * D_FF; t.Kd = D_MODEL; }
    else { t.f6 = 0; it -= T8_GU; const int j = it / (22 * 64), r = it % (22 * 64), kb = r / 64, nb = r % 64, k0 = 128 * kb, n0 = 16 * nb;
        t.W = I.wdn + (size_t)j * D_FF * 1024 + (size_t)k0 * 1024 + n0; t.WT = ws + WS_WDN + (size_t)j * DN8_BYTES + (size_t)n0 * D_FF + k0; t.N = 1024; t.Kd = D_FF; } } } }
    return t;
}
__device__ __forceinline__ TrItem tr_decode(const ProIn& I, unsigned char* ws, int it) {
    const float* W; bf16* WT; int K, N, nblk, r; bool gu = false; int F = 0;
    if (it < TI_QKV) { const int j = it / (16 * 288); r = it % (16 * 288); K = 1024; N = QKV_W; nblk = 288; W = I.wqkv + (size_t)j * 1024 * QKV_W; WT = (bf16*)(ws + WS_WQKV) + (size_t)j * QKV_W * 1024; }
    else { it -= TI_QKV;
    if (it < TI_WO) { const int j = it / 512; r = it % 512; K = 1024; N = 1024; nblk = 32; W = I.wo + (size_t)j * 1024 * 1024; WT = (bf16*)(ws + WS_WO) + (size_t)j * 1024 * 1024; }
    else { it -= TI_WO;
    if (it < TI_GU) { const int j = it / (16 * 176); r = it % (16 * 176); K = 1024; N = 2 * D_FF; nblk = 176; gu = true; F = D_FF; W = I.wgu + (size_t)j * 1024 * 2 * D_FF; WT = (bf16*)(ws + WS_WGU) + (size_t)j * 2 * D_FF * 1024; }
    else { it -= TI_GU;
    if (it < TI_DN) { const int j = it / (44 * 32); r = it % (44 * 32); K = D_FF; N = 1024; nblk = 32; W = I.wdn + (size_t)j * D_FF * 1024; WT = (bf16*)(ws + WS_WDN) + (size_t)j * 1024 * D_FF; }
    else { it -= TI_DN;
    if (it < TI_POOL) { const int jg = it / 32; r = it % 32; K = 256; N = 256; nblk = 8; W = I.pool_w + (size_t)jg * 65536; WT = (bf16*)(ws + WS_WPOOL) + (size_t)jg * 65536; }
    else { it -= TI_POOL;
    if (it < TI_MGU) { const int je = it / (16 * 224); r = it % (16 * 224); K = 1024; N = 2 * D_FFE; nblk = 224; gu = true; F = D_FFE; W = I.mgu + (size_t)je * 1024 * 2 * D_FFE; WT = (bf16*)(ws + WS_WMGU) + (size_t)je * 2 * D_FFE * 1024; }
    else { it -= TI_MGU;
    { const int je = it / (56 * 32); r = it % (56 * 32); K = D_FFE; N = 1024; nblk = 32; W = I.mdn + (size_t)je * D_FFE * 1024; WT = (bf16*)(ws + WS_WMDN) + (size_t)je * 1024 * D_FFE; } } } } } } }
    const int kb = r / nblk, nb = r % nblk, k0 = 64 * kb, n0 = 32 * nb, drow = gu ? gu_row(n0, F) : n0;
    TrItem t; t.W = W + (size_t)k0 * N + n0; t.WT = WT + (size_t)drow * K + k0; t.N = N; t.Kd = K; return t;
}
__device__ __forceinline__ unsigned pack4_i8(float a, float b, float c, float d) {
    const int ia = __float2int_rn(a), ib = __float2int_rn(b), ic = __float2int_rn(c), id = __float2int_rn(d);
    return ((unsigned)ia & 255u) | (((unsigned)ib & 255u) << 8) | (((unsigned)ic & 255u) << 16) | ((unsigned)id << 24);
}
__device__ __forceinline__ void tri8_store(const TrItem8& t, int lane, const f32x4 (&r)[8], LAS float* scr, const float* cm) {
    LAS float* w = scr + (lane >> 2) * 17 + 4 * (lane & 3);
#pragma unroll
    for (int i = 0; i < 8; ++i) { LAS float* q = w + (16 * i) * 17; q[0] = r[i].x; q[1] = r[i].y; q[2] = r[i].z; q[3] = r[i].w; }
    LDS_WAIT(); asm volatile("" ::: "memory");
    const int c = lane & 7;
#pragma unroll
    for (int j = 0; j < 2; ++j) { const int n = (lane >> 3) + 8 * j; const float cmv = cm[n], sc = cmv > 0.f ? 127.0f / cmv : 0.f; const LAS float* s = scr + (16 * c) * 17 + n; v4u o;
#pragma unroll
        for (int q = 0; q < 4; ++q) o[q] = pack4_i8(sc * s[(4 * q) * 17], sc * s[(4 * q + 1) * 17], sc * s[(4 * q + 2) * 17], sc * s[(4 * q + 3) * 17]);
        *(GAS v4u*)(t.WT + (size_t)n * t.Kd + 16 * c) = o; }
    LDS_WAIT(); asm volatile("" ::: "memory");
}
constexpr int TQ_GU = FFN_GU_I8 ? 2 * 8 * 352 : 0, TQ_WO = WO_I8 ? 2 * 8 * 64 : 0;
__device__ __forceinline__ void ffn_gu_quant_phase(int gw, int NGW, int wave, int lane, LAS unsigned char* lds, const float* wgu, unsigned char* ws, const float* cmax, const float* wo, const float* cmaxo) {
    LAS float* scr = (LAS float*)(lds + RING_OFF + wave * 16384);
    for (int it = gw; it < TQ_GU; it += NGW) {
        const int j = it / (8 * 352), r = it % (8 * 352), kb = r / 352, nb = r % 352, k0 = 128 * kb, n0 = 16 * nb;
        TrItem8 t; t.f6 = 0; t.W = wgu + (size_t)j * 1024 * 2 * D_FF + (size_t)k0 * (2 * D_FF) + n0; t.WT = ws + WS_WGU + (size_t)j * GU8_BYTES + (size_t)gu_row(n0, D_FF) * D_MODEL + k0; t.N = 2 * D_FF; t.Kd = D_MODEL;
        f32x4 rr[8]; tr8_load(t, lane, rr); tri8_store(t, lane, rr, scr, cmax + j * 2 * D_FF + n0);
    }
    for (int it = gw; it < TQ_WO; it += NGW) {
        const int j = it / (8 * 64), r = it % (8 * 64), kb = r / 64, nb = r % 64, k0 = 128 * kb, n0 = 16 * nb;
        TrItem8 t; t.f6 = 0; t.W = wo + (size_t)j * D_MODEL * D_MODEL + (size_t)k0 * D_MODEL + n0; t.WT = ws + WS_WO + (size_t)j * WO8_BYTES + (size_t)n0 * D_MODEL + k0; t.N = D_MODEL; t.Kd = D_MODEL;
        f32x4 rr[8]; tr8_load(t, lane, rr); tri8_store(t, lane, rr, scr, cmaxo + j * D_MODEL + n0);
    }
}
constexpr int T8_MGUH = T8_MGU / 2, T8_MDNH = T8_MDN / 2, T8_QKVH = T8_QKV / 2, T8_DNH = T8_DN / 2, T8_PEREXP = 8 * 448;
constexpr int T8_IDLE_LO = T8_MGUH + 2 * T8_PEREXP, T8_IDLE_N = MOE_FP8 ? 6 * T8_PEREXP : 0;
constexpr int T8_SEAM_A = 11 * 256 * 7;
constexpr int T8_SEAM_B = T8_DNH + T8_QKVH + (MOE_FP8 ? 2 * T8_PEREXP : 0) + T8_MDNH, T8_SEAM_N = T8_SEAM_A + T8_SEAM_B, T8_PRO_N = T8_ALL - T8_IDLE_N - T8_SEAM_N, T8_SEAMS = 27;
static_assert(T8_SEAM_A <= T8_MGUH && T8_SEAM_N <= T8_SEAMS * 256 * 7, "barrier-slack share (written for 256 workgroups; deadlines: part A by barrier 10, dense down by 17, QKV by 19, MoE gate/up by 25, MoE down by 26)");
static_assert(T8_GU == 0 && MOE_FP8 != 0, "t8_map is written for this configuration");
__device__ __forceinline__ int t8_map(int kind, int v) {
    constexpr int oMDN = T8_MGU, oQKV = T8_MGU + T8_MDN, oDN = T8_MGU + T8_MDN + T8_QKV + T8_GU;
    if (kind == 1) return T8_IDLE_LO + v;
    if (kind == 0) { if (v < T8_MGUH - T8_SEAM_A) return T8_SEAM_A + v; v -= T8_MGUH - T8_SEAM_A; if (v < T8_MDNH) return oMDN + v; v -= T8_MDNH; if (v < T8_QKVH) return oQKV + v; v -= T8_QKVH; return oDN + v; }
    if (v < T8_SEAM_A) return v; v -= T8_SEAM_A;
    if (v < T8_DNH) return oDN + T8_DNH + v; v -= T8_DNH; if (v < T8_QKVH) return oQKV + T8_QKVH + v; v -= T8_QKVH; if (v < 2 * T8_PEREXP) return T8_MGUH + v; v -= 2 * T8_PEREXP; return oMDN + T8_MDNH + v;
}
#ifndef PRO_F6_RPT
#define PRO_F6_RPT 1
#endif
template <int KIND> __device__ __forceinline__ void tr8_run(const ProIn& I, unsigned char* ws, LAS float* scr, int lane, int first, int stride) {
    constexpr int N = KIND == 1 ? T8_IDLE_N : T8_PRO_N;
    f32x4 ra[8], rb[8]; TrItem8 ua, ub; int it = first;
    if (it < N) {
        ua = tr8_decode(I, ws, t8_map(KIND, it)); tr8_load(ua, lane, ra);
        for (;;) {
            const int itb = it + stride; ub = tr8_decode(I, ws, t8_map(KIND, itb < N ? itb : it)); tr8_load(ub, lane, rb);
            if (ua.f6) { for (int r6 = 0; r6 < PRO_F6_RPT; ++r6) tr6_store(ua, lane, ra, scr); } else tr8_store(ua, lane, ra, scr);
            if (itb >= N) break;
            const int itc = itb + stride; ua = tr8_decode(I, ws, t8_map(KIND, itc < N ? itc : itb)); tr8_load(ua, lane, ra);
            if (ub.f6) { for (int r6 = 0; r6 < PRO_F6_RPT; ++r6) tr6_store(ub, lane, rb, scr); } else tr8_store(ub, lane, rb, scr);
            if (itc >= N) break;
            it = itc;
        }
    }
}
__device__ __forceinline__ void seam_convert(const ProIn& I, unsigned char* ws, LAS unsigned char* lds, int seam, int vcu, int G, int wave, int lane) {
    const int v = seam * (G * 7) + vcu * 7 + (wave - 1);
    if (seam < T8_SEAMS && v < T8_SEAM_N) { const TrItem8 u = tr8_decode(I, ws, t8_map(2, v)); f32x4 r[8]; tr8_load(u, lane, r); LAS float* scr = (LAS float*)(lds + RING_OFF + wave * 16384);
        if (u.f6) tr6_store(u, lane, r, scr); else tr8_store(u, lane, r, scr); }
}
__device__ __forceinline__ void p0_prologue(const ProIn& I, unsigned char* ws, LAS unsigned char* lds, int gw, int NGW, int wave, int lane) {
    LAS float* scr = (LAS float*)(lds + RING_OFF + wave * 16384);
#ifdef PRO_PRETOUCH
    { float acc_ = 0.f; const size_t n1 = (size_t)16 * 1024 * 2 * D_FFE / 1024, n2 = (size_t)16 * D_FFE * 1024 / 1024, n3 = (size_t)2 * 1024 * QKV_W / 1024, n4 = (size_t)DEPTH * 1024 * 6 * D_MODEL / 1024;
      for (size_t i = (size_t)gw * 64 + lane; i < n1; i += (size_t)NGW * 64) acc_ += I.mgu[i * 1024];
      for (size_t i = (size_t)gw * 64 + lane; i < n2; i += (size_t)NGW * 64) acc_ += I.mdn[i * 1024];
      for (size_t i = (size_t)gw * 64 + lane; i < n3; i += (size_t)NGW * 64) acc_ += I.wqkv[i * 1024];
      for (size_t i = (size_t)gw * 64 + lane; i < n4; i += (size_t)NGW * 64) acc_ += I.ada_w[i * 1024];
      if (acc_ == 1.2345e-30f) scr[0] = acc_; }
#endif
    for (int idx = gw * 64 + lane; idx < M_TOK * 4; idx += NGW * 64) { const int tok = idx >> 2, fg = idx & 3; const float pfv = (float)I.pos[tok]; v4u o;
#pragma unroll
        for (int j = 0; j < 4; ++j) { const float inv = __uint_as_float(fg == 0 ? pg8::ROPE_IFB[j] : fg == 1 ? pg8::ROPE_IFB[4 + j] : fg == 2 ? pg8::ROPE_IFB[8 + j] : pg8::ROPE_IFB[12 + j]); const float th = pfv * inv;
            const float k = rintf(th * 0.15915494309189535f); float r = fmaf(-k, 6.2831854820251465f, th); r = fmaf(-k, -1.7484555e-07f, r); const float x = r * 0.15915494309189535f;
            const pg8::h2_t h = {(__fp16)__builtin_amdgcn_cosf(x), (__fp16)__builtin_amdgcn_sinf(x)}; o[j] = __builtin_bit_cast(unsigned, h); }
        *(GAS v4u*)(ws + WS_ROPE + (size_t)idx * 16) = o; }
#ifndef PRO_RPT_A
#define PRO_RPT_A 1
#endif
#ifndef PRO_RPT_C
#define PRO_RPT_C 1
#endif
    for (int rpa = 0; rpa < PRO_RPT_A; ++rpa)
    for (int it = gw; it < DEPTH * 24 * pg8::MOD_KS; it += NGW) {
        const int layer = it / (24 * pg8::MOD_KS), rem = it % (24 * pg8::MOD_KS), chunk = rem / pg8::MOD_KS, ks = rem % pg8::MOD_KS, kb = ks * 128;
#pragma unroll
        for (int q = 0; q < 8; ++q) { const int idx = lane + 64 * q, b = idx >> 7, k = idx & 127; const float cv = I.c[b * D_MODEL + kb + k]; scr[idx] = cv / (1.0f + __expf(-cv)); }
        LDS_WAIT(); asm volatile("" ::: "memory");
        const float* wp = I.ada_w + ((size_t)layer * D_MODEL + kb) * (6 * D_MODEL) + chunk * 256 + 4 * lane;
        f32x4 a0 = {0.f, 0.f, 0.f, 0.f}, a1 = a0, a2 = a0, a3 = a0;
#pragma nounroll
        for (int k = 0; k < 128; k += 16) {
            f32x4 w[16];
#pragma unroll
            for (int j = 0; j < 16; ++j) w[j] = *(const GAS f32x4*)(wp + (size_t)(k + j) * (6 * D_MODEL));
#pragma unroll
            for (int g4 = 0; g4 < 4; ++g4) {
                const f32x4 c0 = *(const LAS f32x4*)(scr + k + 4 * g4), c1 = *(const LAS f32x4*)(scr + 128 + k + 4 * g4), c2 = *(const LAS f32x4*)(scr + 256 + k + 4 * g4), c3 = *(const LAS f32x4*)(scr + 384 + k + 4 * g4);
                const f32x4 w0 = w[4 * g4], w1 = w[4 * g4 + 1], w2 = w[4 * g4 + 2], w3 = w[4 * g4 + 3];
                a0 += w0 * c0.x + w1 * c0.y + w2 * c0.z + w3 * c0.w; a1 += w0 * c1.x + w1 * c1.y + w2 * c1.z + w3 * c1.w;
                a2 += w0 * c2.x + w1 * c2.y + w2 * c2.z + w3 * c2.w; a3 += w0 * c3.x + w1 * c3.y + w2 * c3.z + w3 * c3.w;
            }
        }
        float* mp = (float*)(ws + WS_MODP) + (size_t)ks * pg8::MOD_SZ + (size_t)(layer * BATCH) * (6 * D_MODEL) + chunk * 256 + 4 * lane;
        *(f32x4*)(mp) = a0; *(f32x4*)(mp + 6 * D_MODEL) = a1; *(f32x4*)(mp + 12 * D_MODEL) = a2; *(f32x4*)(mp + 18 * D_MODEL) = a3;
        LDS_WAIT(); asm volatile("" ::: "memory");
    }
    if (FFN_GU_I8) for (int it = gw; it < 2 * 22 * 8; it += NGW) {
        const int j = it / 176, rem = it % 176, chunk = rem >> 3, ks = rem & 7;
        const float* wp = I.wgu + ((size_t)j * D_MODEL + 128 * ks) * (2 * D_FF) + chunk * 256 + 4 * lane;
        f32x4 mx = {0.f, 0.f, 0.f, 0.f};
#pragma nounroll
        for (int k = 0; k < 128; k += 16) {
            f32x4 w[16];
#pragma unroll
            for (int q = 0; q < 16; ++q) w[q] = *(const GAS f32x4*)(wp + (size_t)(k + q) * (2 * D_FF));
#pragma unroll
            for (int q = 0; q < 16; ++q) mx = __builtin_elementwise_max(mx, __builtin_elementwise_abs(w[q]));
        }
        unsigned* cb = (unsigned*)(ws + WS_CTL) + CW_CMAX + j * 2 * D_FF + chunk * 256 + 4 * lane;
#pragma unroll
        for (int q = 0; q < 4; ++q) atomicMax(cb + q, __float_as_uint(mx[q]));
    }
    if (WO_I8) for (int it = gw; it < 2 * 4 * 8; it += NGW) {
        const int j = it / 32, rem = it % 32, chunk = rem >> 3, ks = rem & 7;
        const float* wp = I.wo + ((size_t)j * D_MODEL + 128 * ks) * D_MODEL + chunk * 256 + 4 * lane;
        f32x4 mx = {0.f, 0.f, 0.f, 0.f};
#pragma nounroll
        for (int k = 0; k < 128; k += 16) {
            f32x4 w[16];
#pragma unroll
            for (int q = 0; q < 16; ++q) w[q] = *(const GAS f32x4*)(wp + (size_t)(k + q) * D_MODEL);
#pragma unroll
            for (int q = 0; q < 16; ++q) mx = __builtin_elementwise_max(mx, __builtin_elementwise_abs(w[q]));
        }
        unsigned* cb = (unsigned*)(ws + WS_CTL) + CW_CMAXO + j * D_MODEL + chunk * 256 + 4 * lane;
#pragma unroll
        for (int q = 0; q < 4; ++q) atomicMax(cb + q, __float_as_uint(mx[q]));
    }
    for (int rpc = 0; rpc < PRO_RPT_C; ++rpc) {
        f32x4 ra[8], rb[8]; TrItem ta, tb;
        int it = gw;
        if (it < TI_ALL) {
            ta = tr_decode(I, ws, it); tr_load(ta, lane, ra);
            for (;;) {
                const int itb = it + NGW; tb = tr_decode(I, ws, itb < TI_ALL ? itb : it); tr_load(tb, lane, rb);
                tr_store(ta, lane, ra, scr);
                if (itb >= TI_ALL) break;
                const int itc = itb + NGW; ta = tr_decode(I, ws, itc < TI_ALL ? itc : itb); tr_load(ta, lane, ra);
                tr_store(tb, lane, rb, scr);
                if (itc >= TI_ALL) break;
                it = itc;
            }
        }
        tr8_run<0>(I, ws, scr, lane, gw, NGW);
    }
}

__device__ __forceinline__ void ld_row(const float* p, int lane, f32x4 (&v)[4]) {
#pragma unroll
    for (int j = 0; j < 4; ++j) v[j] = *(const GAS f32x4*)(p + 4 * lane + 256 * j); }
__device__ __forceinline__ void ld_yrow(const bf16* p, int lane, v2u (&y)[4]) {
#pragma unroll
    for (int j = 0; j < 4; ++j) y[j] = *(const GAS v2u*)(p + 4 * lane + 256 * j); }
__device__ __forceinline__ f32x4 y4(v2u a) { return (f32x4){bflo(a.x), bfhi(a.x), bflo(a.y), bfhi(a.y)}; }
__device__ __forceinline__ float row_rstd(const f32x4 (&v)[4]) {
    float s = 0.f;
#pragma unroll
    for (int j = 0; j < 4; ++j) s += (v[j].x * v[j].x + v[j].y * v[j].y) + (v[j].z * v[j].z + v[j].w * v[j].w);
    return __builtin_amdgcn_rsqf(wave_sum(s) * (1.0f / D_MODEL) + NORM_EPS);
}
__device__ __forceinline__ void st_row_bf16(bf16* p, int lane, const f32x4 (&h)[4]) {
#pragma unroll
    for (int j = 0; j < 4; ++j) { v2u o; o.x = pk2(h[j].x, h[j].y); o.y = pk2(h[j].z, h[j].w); *(GAS v2u*)(p + 4 * lane + 256 * j) = o; } }

template <bool COMBINE>
__device__ __forceinline__ void pool_prep_phase(int gw, int NGW, int wave, int lane, LAS unsigned char* lds, const void* Xprev_  , bf16* Xcur, bf16* P, const float* gain, const float* modp, const float* ada_b, float* modr, int layer,
                                                const bf16* Y, const int* slot_of, const float* gatev) {
    const float* Xprev = (const float*)Xprev_; const bf16* XprevH = (const bf16*)Xprev_;
    if (!COMBINE) {
        for (int i = gw * 64 + lane; i < pg8::MOD_SZ / 4; i += NGW * 64) { const int idx = 4 * i, layer_ = idx / (BATCH * 6 * D_MODEL), col = idx % (6 * D_MODEL);
            f32x4 v = *(const f32x4*)(ada_b + layer_ * (6 * D_MODEL) + col);
#pragma unroll
            for (int ks = 0; ks < pg8::MOD_KS; ++ks) v += *(const f32x4*)(modp + (size_t)ks * pg8::MOD_SZ + idx);
            *(f32x4*)(modr + idx) = v; } }
    LAS v2u* ring = (LAS v2u*)(lds + RING_OFF + wave * 16384) + lane;
    constexpr int PP_ROWS = 32, QEND = 16 + PP_ROWS;
    for (int it = (gw & 1) ? M_TOK : (gw >> 1); it < M_TOK / PP_ROWS; it += NGW >> 1) {
        const int t0 = PP_ROWS * it, b = t0 / SEQ; const bool first = (t0 % SEQ) == 0;
        f32x4 A[4], G2[4];
#pragma unroll
        for (int j = 0; j < 4; ++j) { const int col = 4 * lane + 256 * j; A[j] = *(const f32x4*)(gain + col) * ((COMBINE ? mod4(modr, layer, b, 1, col) : mod4p(modp, ada_b, layer, b, 1, col)) + 1.0f); if (COMBINE) G2[j] = mod4(modr, layer - 1, b, 5, col); }
        v2i sl = {0, 0}; f32x2 gt = {0.f, 0.f};
        if (COMBINE) { const int rr = first ? t0 + (lane & 31) : t0 - 16 + (lane < QEND ? lane : QEND - 1); sl = *(const GAS v2i*)(slot_of + 2 * rr); gt = *(const GAS f32x2*)(gatev + 2 * rr); }
        v2u z2; asm volatile("v_mov_b32 %0, 0\n\tv_mov_b32 %1, 0" : "=v"(z2.x), "=v"(z2.y));
#pragma unroll
        for (int q = 0; q < 30; ++q) ring[q * 64] = z2;
        f32x4 s[4];
#pragma unroll
        for (int q = 0; q < 4; ++q) s[q] = (f32x4){0.f, 0.f, 0.f, 0.f};
        const int q0 = first ? 16 : 0; const int rbase = t0 - 16;
        f32x4 xvA[4], xvB[4]; v2u xhA[4], xhB[4], yaA[4], ybA[4], yaB[4], ybB[4];
        { if (COMBINE) { ld_yrow(XprevH + (size_t)(rbase + q0) * D_MODEL, lane, xhA); ld_yrow(XprevH + (size_t)(rbase + q0 + 1) * D_MODEL, lane, xhB); }
          else { ld_row(Xprev + (size_t)(rbase + q0) * D_MODEL, lane, xvA); ld_row(Xprev + (size_t)(rbase + q0 + 1) * D_MODEL, lane, xvB); }
          if (COMBINE) { ld_yrow(Y + (size_t)rdlane_i(sl.x, 0) * D_MODEL, lane, yaA); ld_yrow(Y + (size_t)rdlane_i(sl.y, 0) * D_MODEL, lane, ybA);
                         ld_yrow(Y + (size_t)rdlane_i(sl.x, 1) * D_MODEL, lane, yaB); ld_yrow(Y + (size_t)rdlane_i(sl.y, 1) * D_MODEL, lane, ybB); } }
#pragma nounroll
        for (int q2 = q0; q2 < QEND; q2 += 2) {
#pragma unroll
          for (int hh = 0; hh < 2; ++hh) {
            const int q = q2 + hh, row = rbase + q, li = q - q0, i = q & 15;
            f32x4 v[4];
#pragma unroll
            for (int j = 0; j < 4; ++j) v[j] = COMBINE ? y4(hh ? xhB[j] : xhA[j]) : (hh ? xvB[j] : xvA[j]);
            if (COMBINE) { const float g0 = rdlane_f(gt.x, li), g1 = rdlane_f(gt.y, li);
#pragma unroll
                for (int j = 0; j < 4; ++j) v[j] += G2[j] * (y4(hh ? yaB[j] : yaA[j]) * g0 + y4(hh ? ybB[j] : ybA[j]) * g1); }
            { const int nq = q + 2 < QEND ? 2 : QEND - 1 - q;
                if (COMBINE) { if (hh) ld_yrow(XprevH + (size_t)(row + nq) * D_MODEL, lane, xhB); else ld_yrow(XprevH + (size_t)(row + nq) * D_MODEL, lane, xhA); }
                else { if (hh) ld_row(Xprev + (size_t)(row + nq) * D_MODEL, lane, xvB); else ld_row(Xprev + (size_t)(row + nq) * D_MODEL, lane, xvA); }
                if (COMBINE) { const int s0 = rdlane_i(sl.x, li + nq), s1 = rdlane_i(sl.y, li + nq);
                    if (hh) { ld_yrow(Y + (size_t)s0 * D_MODEL, lane, yaB); ld_yrow(Y + (size_t)s1 * D_MODEL, lane, ybB); } else { ld_yrow(Y + (size_t)s0 * D_MODEL, lane, yaA); ld_yrow(Y + (size_t)s1 * D_MODEL, lane, ybA); } } }
            if (COMBINE && q >= 16) st_row_bf16(Xcur + (size_t)row * D_MODEL, lane, v);
            const float rstd = row_rstd(v);
#pragma unroll
            for (int j = 0; j < 4; ++j) { v[j] *= rstd;
                constexpr int W_[4] = {2, 4, 8, 16}, B_[4] = {0, 2, 6, 14};
                const int slot = B_[j] + (i & (W_[j] - 1));
                v2u nw; nw.x = pk2(v[j].x, v[j].y); nw.y = pk2(v[j].z, v[j].w);
                const v2u od = ring[slot * 64]; ring[slot * 64] = nw;
                s[j] += y4(nw) - y4(od); }
            if (q >= 16) {
                const int n1 = q - 15;
                const float i0 = first ? 1.0f / (float)(n1 < 2 ? n1 : 2) : 0.5f, i1 = first ? 1.0f / (float)(n1 < 4 ? n1 : 4) : 0.25f;
                const float i2 = first ? 1.0f / (float)(n1 < 8 ? n1 : 8) : 0.125f, i3 = first ? 1.0f / (float)(n1 < 16 ? n1 : 16) : 0.0625f;
                f32x4 h[4]; h[0] = (s[0] * i0 - v[0]) * A[0]; h[1] = (s[1] * i1 - v[1]) * A[1]; h[2] = (s[2] * i2 - v[2]) * A[2]; h[3] = (s[3] * i3 - v[3]) * A[3];
                st_row_bf16(P + (size_t)row * D_MODEL, lane, h);
            }
          }
        }
        LDS_WAIT(); asm volatile("" ::: "memory");
    }
}

template <bool ROUTE, int OUT  >
__device__ __forceinline__ void norm_phase(int gw, int NGW, int lane, const bf16* X, bf16* H, float* rs, const float* gain, const float* modr, int layer, int part_sh,
                                           const LAS float* wr_t  , const float* rb, int* eidx, float* gatev, unsigned* cnt, LAS float* sc6 = nullptr  ) {
    int mycnt = 0;
    for (int it = gw; it < M_TOK / 16; it += NGW) {
        const int t0 = 16 * it, b = t0 / SEQ;
        f32x4 A[4], Bv[4];
#pragma unroll
        for (int j = 0; j < 4; ++j) { const int col = 4 * lane + 256 * j; A[j] = *(const f32x4*)(gain + col) * (mod4(modr, layer, b, part_sh + 1, col) + 1.0f); Bv[j] = mod4(modr, layer, b, part_sh, col); }
        v2u xa[4], xb[4]; ld_yrow(X + (size_t)t0 * D_MODEL, lane, xa); ld_yrow(X + (size_t)(t0 + 1) * D_MODEL, lane, xb);
#pragma nounroll
        for (int i2 = 0; i2 < 16; i2 += 2) {
#pragma unroll
          for (int hh = 0; hh < 2; ++hh) {
            const int i = i2 + hh, row = t0 + i; f32x4 v[4];
            if (hh == 0) {
#pragma unroll
                for (int j = 0; j < 4; ++j) v[j] = y4(xa[j]);
                ld_yrow(X + (size_t)(t0 + (i + 2 < 16 ? i + 2 : 15)) * D_MODEL, lane, xa); }
            else {
#pragma unroll
                for (int j = 0; j < 4; ++j) v[j] = y4(xb[j]);
                ld_yrow(X + (size_t)(t0 + (i + 2 < 16 ? i + 2 : 15)) * D_MODEL, lane, xb); }
            const float rstd = row_rstd(v);
#pragma unroll
            for (int j = 0; j < 4; ++j) v[j] = v[j] * rstd * A[j] + Bv[j];
            if (OUT == 2) {
                float am = 0.f;
#pragma unroll
                for (int j = 0; j < 4; ++j) am = fmaxf(am, fmaxf(fmaxf(fabsf(v[j].x), fabsf(v[j].y)), fmaxf(fabsf(v[j].z), fabsf(v[j].w))));
                am = wave_max(am);
                const float sc = am > 0.f ? 127.0f / am : 0.f;
#pragma unroll
                for (int j = 0; j < 4; ++j) *(GAS unsigned*)((unsigned char*)H + (size_t)row * D_MODEL + 4 * lane + 256 * j) = pack4_i8(v[j].x * sc, v[j].y * sc, v[j].z * sc, v[j].w * sc);
                if (lane == 0) rs[row] = am * (1.0f / 127.0f); }
            else if (OUT == 3) {
#pragma unroll
                for (int j = 0; j < 4; ++j) *(LAS f32x4*)(sc6 + 4 * lane + 4 * (lane >> 2) + 320 * j) = v[j];
                f32x4 m4[4];
#pragma unroll
                for (int t = 0; t < 4; ++t) m4[t] = *(const LAS f32x4*)(sc6 + 20 * lane + 4 * t);
                float am = 0.f;
#pragma unroll
                for (int t = 0; t < 4; ++t) am = fmaxf(am, fmaxf(fmaxf(fabsf(m4[t].x), fabsf(m4[t].y)), fmaxf(fabsf(m4[t].z), fabsf(m4[t].w))));
                am = fmaxf(am, MK_DPP(am, 0xB1));
                const unsigned sb = f6_scale_byte(am); const float f = f6_inv(sb);
                v16f mine, oth;
#pragma unroll
                for (int t = 0; t < 4; ++t) { mine[4 * t] = m4[t].x * f; mine[4 * t + 1] = m4[t].y * f; mine[4 * t + 2] = m4[t].z * f; mine[4 * t + 3] = m4[t].w * f; }
#pragma unroll
                for (int i = 0; i < 16; ++i) oth[i] = MK_DPP(mine[i], 0xB1);
                const v6u c = __builtin_amdgcn_cvt_scalef32_2xpk16_fp6_f32(mine, oth, 1.0f);
                const unsigned c4 = (unsigned)__builtin_amdgcn_update_dpp(0, (int)c[4], 0xA0, 0xf, 0xf, true), c5 = (unsigned)__builtin_amdgcn_update_dpp(0, (int)c[5], 0xA0, 0xf, 0xf, true);
                const bool odd = (lane & 1) != 0; const int p = lane >> 1;
                v4u o; o.x = odd ? c4 : c[0]; o.y = odd ? c5 : c[1]; o.z = odd ? 0u : c[2]; o.w = odd ? sb : c[3];
                *(GAS v4u*)((unsigned char*)H + (size_t)row * D_MODEL + 128 * (p >> 2) + 16 * (p & 3) + (odd ? 64 : 0)) = o; }
            else if (OUT == 1) {
#pragma unroll
                for (int j = 0; j < 4; ++j) *(GAS unsigned*)((unsigned char*)H + (size_t)row * D_MODEL + 4 * lane + 256 * j) = pg8::cvt4_fp8(v[j].x, v[j].y, v[j].z, v[j].w); }
            else st_row_bf16(H + (size_t)row * D_MODEL, lane, v);
            if (ROUTE) {
                float lg[8];
#pragma unroll
                for (int e = 0; e < 8; ++e) { float p = 0.f;
#pragma unroll
                    for (int j = 0; j < 4; ++j) { const f32x4 w = *(const LAS f32x4*)(wr_t + e * D_MODEL + 4 * lane + 256 * j); p += (v[j].x * w.x + v[j].y * w.y) + (v[j].z * w.z + v[j].w * w.w); }
                    lg[e] = wave_sum(p) + rb[e]; }
                int e1 = 0; float v1 = lg[0];
#pragma unroll
                for (int e = 1; e < 8; ++e) if (lg[e] > v1) { v1 = lg[e]; e1 = e; }
                int e2 = -1; float v2 = -__builtin_inff();
#pragma unroll
                for (int e = 0; e < 8; ++e) if (e != e1 && lg[e] > v2) { v2 = lg[e]; e2 = e; }
                const float ex = __expf(v2 - v1), g1 = 1.0f / (1.0f + ex), g2 = ex * g1;
                if (lane == 0) { *(GAS v2i*)(eidx + 2 * row) = (v2i){e1, e2}; *(GAS f32x2*)(gatev + 2 * row) = (f32x2){g1, g2}; }
                mycnt += (lane == e1 || lane == e2) ? 1 : 0;
            }
          }
        }
    }
    if (ROUTE) { if (lane < 8 && mycnt > 0) atomicAdd(cnt + lane * 64, (unsigned)mycnt); }
}

__device__ __forceinline__ void slot_phase(int gw, int NGW, int lane, const int* eidx, const unsigned* cnt, unsigned* cur, int* stok, int* slot_of) {
    int base[8]; { int acc = 0;
#pragma unroll
        for (int e = 0; e < 8; ++e) { base[e] = acc * 256; acc += ((int)__hip_atomic_load(cnt + e * 64, __ATOMIC_RELAXED, __HIP_MEMORY_SCOPE_AGENT) + 255) >> 8; } }
    for (int it = gw; it < M_TOK / 32; it += NGW) {
        const int ent = 64 * it + lane;
        const int e = eidx[ent]; int slot = 0;
#pragma unroll
        for (int x = 0; x < 8; ++x) {
            const unsigned long long mask = __ballot(e == x);
            if (mask) { const int n = __popcll(mask), leader = __ffsll((long long)mask) - 1; unsigned st = 0;
                if (lane == leader) st = atomicAdd(cur + x * 64, (unsigned)n);
                st = (unsigned)rdlane_i((int)st, leader);
                if (e == x) slot = base[x] + (int)st + __popcll(mask & ((1ull << lane) - 1ull)); }
        }
        stok[slot] = ent >> 1; slot_of[ent] = slot;
    }
}

template <bool OUT_I8>
__device__ __forceinline__ void merge_phase(int gw, int NGW, int lane, const bf16* OG, const float* LSE, bf16* AO, float* rs) {
    for (int it = gw; it < M_TOK / 16; it += NGW) {
#pragma unroll 2
        for (int i = 0; i < 16; ++i) {
            const int m = 16 * it + i, b = m / SEQ, p = m % SEQ;
            float res[2][8];
#pragma unroll
            for (int seg = 0; seg < 2; ++seg) {
                const int col = 512 * seg + 8 * lane, h = col >> 7, e0 = col & 127;
                v4u o[3]; float ls[3];
#pragma unroll
                for (int g = 0; g < 3; ++g) { const int sh = 2 * g, Lg = SEQ >> sh, j = p >> sh, r = p & ((1 << sh) - 1); const size_t ci = (size_t)(((b << sh) | r) * NHEAD + h) * Lg + j;
                    o[g] = *(const GAS v4u*)(OG + (size_t)g * ((size_t)M_TOK * D_MODEL) + ci * HEAD_DIM + e0); ls[g] = LSE[(size_t)g * ((size_t)M_TOK * NHEAD) + ci]; }
                const float mx = fmaxf(ls[0], fmaxf(ls[1], ls[2])); float a0 = __expf(ls[0] - mx), a1 = __expf(ls[1] - mx), a2 = __expf(ls[2] - mx); const float inv = 1.0f / (a0 + a1 + a2); a0 *= inv; a1 *= inv; a2 *= inv;
#pragma unroll
                for (int q = 0; q < 4; ++q) { res[seg][2 * q] = bflo(o[0][q]) * a0 + bflo(o[1][q]) * a1 + bflo(o[2][q]) * a2; res[seg][2 * q + 1] = bfhi(o[0][q]) * a0 + bfhi(o[1][q]) * a1 + bfhi(o[2][q]) * a2; }
            }
            if (OUT_I8) {
                float am = 0.f;
#pragma unroll
                for (int seg = 0; seg < 2; ++seg)
#pragma unroll
                    for (int q = 0; q < 8; ++q) am = fmaxf(am, fabsf(res[seg][q]));
                am = wave_max(am);
                const float sc = am > 0.f ? 127.0f / am : 0.f;
#pragma unroll
                for (int seg = 0; seg < 2; ++seg) { v2u w; w.x = pack4_i8(res[seg][0] * sc, res[seg][1] * sc, res[seg][2] * sc, res[seg][3] * sc); w.y = pack4_i8(res[seg][4] * sc, res[seg][5] * sc, res[seg][6] * sc, res[seg][7] * sc);
                    *(GAS v2u*)((unsigned char*)AO + (size_t)m * D_MODEL + 512 * seg + 8 * lane) = w; }
                if (lane == 0) rs[m] = am * (1.0f / 127.0f);
            } else {
#pragma unroll
                for (int seg = 0; seg < 2; ++seg) { v4u w;
#pragma unroll
                    for (int q = 0; q < 4; ++q) w[q] = pk2(res[seg][2 * q], res[seg][2 * q + 1]);
                    *(GAS v4u*)(AO + (size_t)m * D_MODEL + 512 * seg + 8 * lane) = w; }
            }
        }
    }
}

__device__ __forceinline__ void final_phase(int gw, int NGW, int lane, const bf16* X, float* out, const float* modr, int layer, const bf16* Y, const int* slot_of, const float* gatev) {
    for (int it = gw; it < M_TOK / 16; it += NGW) {
        const int t0 = 16 * it, b = t0 / SEQ;
        f32x4 G2[4];
#pragma unroll
        for (int j = 0; j < 4; ++j) G2[j] = mod4(modr, layer, b, 5, 4 * lane + 256 * j);
        const v2i sl = *(const GAS v2i*)(slot_of + 2 * (t0 + (lane & 15))); const f32x2 gt = *(const GAS f32x2*)(gatev + 2 * (t0 + (lane & 15)));
        v2u xv[4], ya[4], yb[4];
        ld_yrow(X + (size_t)t0 * D_MODEL, lane, xv); ld_yrow(Y + (size_t)rdlane_i(sl.x, 0) * D_MODEL, lane, ya); ld_yrow(Y + (size_t)rdlane_i(sl.y, 0) * D_MODEL, lane, yb);
#pragma unroll
        for (int i = 0; i < 16; ++i) {
            const int row = t0 + i; f32x4 v[4]; const float g0 = rdlane_f(gt.x, i), g1 = rdlane_f(gt.y, i);
#pragma unroll
            for (int j = 0; j < 4; ++j) v[j] = y4(xv[j]) + G2[j] * (y4(ya[j]) * g0 + y4(yb[j]) * g1);
            { const int ni = i < 15 ? i + 1 : i; ld_yrow(X + (size_t)(t0 + ni) * D_MODEL, lane, xv); ld_yrow(Y + (size_t)rdlane_i(sl.x, ni) * D_MODEL, lane, ya); ld_yrow(Y + (size_t)rdlane_i(sl.y, ni) * D_MODEL, lane, yb); }
#pragma unroll
            for (int j = 0; j < 4; ++j) __builtin_nontemporal_store(v[j], (f32x4*)(out + (size_t)row * D_MODEL + 4 * lane + 256 * j));
        }
    }
}
typedef __hip_bfloat16 hbf;
constexpr size_t SUBT = (size_t)M_TOK * D_MODEL;
constexpr int ATT_ITEMS = 3 * (M_TOK * NHEAD / 256);
__device__ __forceinline__ swa::BlockRef<hbf, hbf> attn_ref(int L, const hbf* qkvc, hbf* og) {
    const int g = L >> 10, rem = L & 1023, sh = 2 * g, lq = 5 - sh, chain = rem >> lq, qb = rem & ((1 << lq) - 1), Lg = SEQ >> sh;
    const size_t co = (size_t)chain * Lg * HEAD_DIM, qo = (size_t)qb * 256 * HEAD_DIM;
    swa::BlockRef<hbf, hbf> r;
    r.Q = qkvc + (size_t)(g * 3 + 0) * SUBT + co + qo; r.K = qkvc + (size_t)(g * 3 + 1) * SUBT + co; r.V = qkvc + (size_t)(g * 3 + 2) * SUBT + co;
    r.O = og + (size_t)g * SUBT + co + qo; r.P0 = qb * 256;
    return r;
}

struct Args { const void* in[19]; float* out; unsigned char* ws; int ph_lo, ph_hi, grid, pad; };
typedef const unsigned char __attribute__((address_space(4)))* kptr_t;
__device__ __forceinline__ kptr_t kargs() { kptr_t p = (kptr_t)__builtin_amdgcn_kernarg_segment_ptr(); asm volatile("" : "+s"(p)); return p; }
#define KIN(T, k) ((const T*)*(const void* const __attribute__((address_space(4)))*)(kp + 8 * (k)))
#define KOUT() ((float*)*(void* const __attribute__((address_space(4)))*)(kp + 152))
#define KWS() ((unsigned char*)*(void* const __attribute__((address_space(4)))*)(kp + 160))
static_assert(sizeof(Args) == 184, "Args layout: in[19] at 0, out at 152, ws at 160, ph_lo 168, ph_hi 172, grid 176");
#define KINT(off) (*(const int __attribute__((address_space(4)))*)(kp + (off)))
__device__ __forceinline__ bool ph_in(int k) { const kptr_t kp = kargs(); return KINT(168) <= k && k < KINT(172); }
__global__ void __launch_bounds__(NWAVES * 64, 2) mk_fwd(Args args) {
    extern __shared__ __attribute__((aligned(16))) unsigned char lds_raw[];
    LAS unsigned char* lds = (LAS unsigned char*)lds_raw;
#ifndef CODE_PAD
#define CODE_PAD 0
#endif
#pragma unroll
    for (int pad_ = 0; pad_ < CODE_PAD; ++pad_) asm volatile("s_nop 0");
    for (int u = threadIdx.x; u < (LDS_BYTES - MISC_OFF) / 4; u += NWAVES * 64) ((LAS unsigned*)(lds + MISC_OFF))[u] = 0u;
    __syncthreads();
    if (args.ph_hi - args.ph_lo > 1) (void)xcd_barrier_post((unsigned*)(args.ws + WS_CTL) + CW_BAR, (volatile LAS unsigned*)(lds + MISC_OFF) + 8);
#ifndef DBG_MASK
#define DBG_MASK 0xFFFF
#endif
#define EN(t) (((DBG_MASK) >> (t)) & 1)
#ifndef RPT_MASK
#define RPT_MASK 0
#endif
#define PHASE(t, k) for (int rep_ = 0, nrep_ = (EN(t) && IN(k)) ? 1 + (((RPT_MASK) >> (t)) & 1) : 0; rep_ < nrep_; ++rep_)
#define IN(k) ph_in(k)
#define SEAM(k) do { if (IN(k) && IN((k) + 1)) { const kptr_t kp = kargs(); XcdBarrier bar_; bar_.bar = (unsigned*)(KWS() + WS_CTL) + CW_BAR; bar_.x = xb_xcc_id(); bar_.st = (volatile LAS unsigned*)(lds + MISC_OFF) + 8; \
        const int sk_ = (k); xcd_barrier(bar_, [&] { if (sk_ < T8_SEAMS) { int tid_ = threadIdx.x; asm volatile("" : "+v"(tid_)); const int G_ = KINT(176), bx_ = blockIdx.x, vcu_ = (G_ % 8 == 0) ? (bx_ % 8) * (G_ / 8) + bx_ / 8 : bx_; \
            ProIn I; I.c = KIN(float, 1); I.ada_w = KIN(float, 5); I.pool_w = KIN(float, 7); I.wqkv = KIN(float, 9); I.wo = KIN(float, 10); I.wgu = KIN(float, 13); I.wdn = KIN(float, 14); I.mgu = KIN(float, 17); I.mdn = KIN(float, 18); I.pos = KIN(int, 2); \
            seam_convert(I, KWS(), lds, sk_, vcu_, G_, __builtin_amdgcn_readfirstlane(tid_ >> 6), tid_ & 63); } }); } } while (0)
#define PH_SETUP() const kptr_t kp = kargs(); unsigned char* ws = KWS(); int tid = threadIdx.x; asm volatile("" : "+v"(tid)); const int lane = tid & 63, wave = __builtin_amdgcn_readfirstlane(tid >> 6); \
    const int G = KINT(176), bx = blockIdx.x, vcu = (G % 8 == 0) ? (bx % 8) * (G / 8) + bx / 8 : bx, gw = vcu * NWAVES + wave, NGW = G * NWAVES; (void)tid; (void)lane; (void)vcu; (void)gw; (void)NGW; (void)ws
#ifndef STAG_Q
#define STAG_Q 0
#endif
#define STAG(v) ((unsigned)(((v) & 3) * STAG_Q))
#define MODP() ((const float*)(ws + WS_MODP))
#define MODR() ((float*)(ws + WS_MODR))
#define ADAB() KIN(float, 6)
#define XCUR() ((bf16*)(ws + WS_XB) + (size_t)lp * ((size_t)M_TOK * D_MODEL))
#define CNT() ((unsigned*)(ws + WS_CTL) + CW_CNT + lp * 8 * 64)

    PHASE(0, 0) { PH_SETUP(); ProIn I; I.c = KIN(float, 1); I.ada_w = KIN(float, 5); I.pool_w = KIN(float, 7); I.wqkv = KIN(float, 9); I.wo = KIN(float, 10);
        I.wgu = KIN(float, 13); I.wdn = KIN(float, 14); I.mgu = KIN(float, 17); I.mdn = KIN(float, 18); I.pos = KIN(int, 2);
        p0_prologue(I, ws, lds, gw, NGW, wave, lane); }
    SEAM(0);
    for (int lp = 0; lp < 2; ++lp) {
        const int pb = 1 + PH_PER_PAIR * lp;
        PHASE(1, pb + 0) { PH_SETUP(); bf16* H = (bf16*)(ws + WS_H);
            if (lp == 0 && (FFN_GU_I8 || WO_I8)) ffn_gu_quant_phase(gw, NGW, wave, lane, lds, KIN(float, 13), ws, (const float*)((const unsigned*)(ws + WS_CTL) + CW_CMAX), KIN(float, 10), (const float*)((const unsigned*)(ws + WS_CTL) + CW_CMAXO));
            if (lp == 0) pool_prep_phase<false>(gw, NGW, wave, lane, lds, KIN(float, 0), nullptr, H, KIN(float, 3), MODP(), ADAB(), MODR(), 0, nullptr, nullptr, nullptr);
            else pool_prep_phase<true>(gw, NGW, wave, lane, lds, (const bf16*)(ws + WS_XB), XCUR(), H, KIN(float, 3) + 2 * D_MODEL, nullptr, nullptr, MODR(), 2, (const bf16*)(ws + WS_Y), (const int*)(ws + WS_SLOTOF), (const float*)(ws + WS_GATE)); }
        SEAM(pb + 0);
        PHASE(2, pb + 1) { PH_SETUP();
            pg8::SchedPlain S; S.init(ws + WS_H, (const bf16*)(ws + WS_WPOOL) + (size_t)lp * D_MODEL * 256, M_TOK, D_MODEL, 256, D_MODEL, 512, G, bx);
            if (lp == 0) { pg8::EpiResid<false> E{KIN(float, 0), XCUR(), MODR(), KIN(float, 8) + lp * D_MODEL, 2 * lp, 2, 1.0f, (LAS float*)(lds + TAB_OFF + 8192)};
                pg8::gemm_phase<pg8::EpiResid<false>, pg8::SchedPlain, true>(lds + RING_OFF, 256, S, E); }
            else { pg8::EpiResid<true> E{XCUR(), XCUR(), MODR(), KIN(float, 8) + lp * D_MODEL, 2 * lp, 2, 1.0f, (LAS float*)(lds + TAB_OFF + 8192)};
                pg8::gemm_phase<pg8::EpiResid<true>, pg8::SchedPlain, true>(lds + RING_OFF, 256, S, E); } }
        SEAM(pb + 1);
        PHASE(3, pb + 2) { PH_SETUP();
            norm_phase<false, FFN_GU_I8 ? 2 : (FFN_GU_FP8 ? 1 : 0)>(gw, NGW, lane, XCUR(), (bf16*)(ws + WS_H), (float*)(ws + WS_RS), KIN(float, 4) + 2 * lp * D_MODEL, MODR(), 2 * lp, 3, nullptr, nullptr, nullptr, nullptr, nullptr); }
        SEAM(pb + 2);
        PHASE(4, pb + 3) { PH_SETUP();
            constexpr int KU = (FFN_GU_FP8 || FFN_GU_I8) ? D_MODEL / 2 : D_MODEL;
            pg8::SchedPlain S; S.init(ws + WS_H, ws + WS_WGU + (size_t)lp * GU8_BYTES, M_TOK, 2 * D_FF, KU, KU, 0, G, bx);
            if constexpr (FFN_GU_I8 != 0) { pg8::EpiSwigluI8<FFN_DN_FP8 != 0> E{(void*)(ws + WS_ACT), D_FF, (const float*)(ws + WS_RS), (const float*)((const unsigned*)(ws + WS_CTL) + CW_CMAX) + lp * 2 * D_FF, D_FF, (LAS float*)(lds + TAB_OFF + 8192)};
                pg8::gemm_phase<pg8::EpiSwigluI8<FFN_DN_FP8 != 0>, pg8::SchedPlain, true, 2>(lds + RING_OFF, KU, S, E); }
            else { pg8::EpiSwigluT<FFN_DN_FP8 != 0> E{(void*)(ws + WS_ACT), D_FF, FFN_GU_FP8 ? 0.015625f : 1.0f};
                pg8::gemm_phase<pg8::EpiSwigluT<FFN_DN_FP8 != 0>, pg8::SchedPlain, true, FFN_GU_FP8 ? 1 : 0>(lds + RING_OFF, KU, S, E); } }
        SEAM(pb + 3);
        PHASE(5, pb + 4) { PH_SETUP();
            constexpr int KU = FFN_DN_FP8 ? D_FF / 2 : D_FF;
            pg8::SchedPlain S; S.init(ws + WS_ACT, ws + WS_WDN + (size_t)lp * DN8_BYTES, M_TOK, D_MODEL, KU, KU, 0, G, bx);
            bf16* Xc = XCUR(); pg8::EpiResid<true> E{Xc, Xc, MODR(), nullptr, 2 * lp, 5, FFN_DN_FP8 ? 0.015625f : 1.0f, (LAS float*)(lds + TAB_OFF + 8192)};
            pg8::gemm_phase<pg8::EpiResid<true>, pg8::SchedPlain, true, FFN_DN_FP8 != 0>(lds + RING_OFF, KU, S, E); }
        SEAM(pb + 4);
        PHASE(6, pb + 5) { PH_SETUP();
            norm_phase<false, QKV_FP8 ? (QKV_FP6 ? 3 : 1) : 0>(gw, NGW, lane, XCUR(), (bf16*)(ws + WS_H), nullptr, KIN(float, 3) + (2 * lp + 1) * D_MODEL, MODR(), 2 * lp + 1, 0, nullptr, nullptr, nullptr, nullptr, nullptr, (LAS float*)(lds + RING_OFF + 65536 + wave * 8192)); }
        SEAM(pb + 5);
        PHASE(7, pb + 6) { PH_SETUP();
            constexpr int KU = QKV_FP8 ? D_MODEL / 2 : D_MODEL;
            pg8::SchedPlain S; S.init(ws + WS_H, ws + WS_WQKV + (size_t)lp * QKV8_BYTES, M_TOK, QKV_W, KU, KU, 0, G, bx);
            LAS float* gt_ = (LAS float*)(lds + MISC_OFF + 1024);
            for (int u = tid; u < 2 * 3 * HEAD_DIM; u += NWAVES * 64) gt_[u] = (u < 3 * HEAD_DIM) ? (KIN(float, 11) + lp * 3 * HEAD_DIM)[u] : (KIN(float, 12) + lp * 3 * HEAD_DIM)[u - 3 * HEAD_DIM];
            __syncthreads();
            pg8::EpiQKV E{(bf16*)(ws + WS_QKVC), KIN(float, 11) + lp * 3 * HEAD_DIM, KIN(float, 12) + lp * 3 * HEAD_DIM, KIN(int, 2), (LAS float*)(lds + TAB_OFF), (QKV_FP8 && !QKV_FP6) ? 0.015625f : 1.0f, (const unsigned*)(ws + WS_ROPE), gt_, (LAS unsigned*)(lds + TAB_OFF + 8192)};
            pg8::gemm_phase<pg8::EpiQKV, pg8::SchedPlain, true, QKV_FP8 ? (QKV_FP6 ? 3 : 1) : 0>(lds + RING_OFF, KU, S, E); }
        SEAM(pb + 6);
        PHASE(8, pb + 7) { PH_SETUP();
#ifndef ATT2
#define ATT2 1
#endif
#if ATT2
            { const int per = (6144 + G - 1) / G, I0 = vcu * per, I1 = (I0 + per < 6144) ? I0 + per : 6144;
              att2::attn_phase(lds, (const unsigned short*)(ws + WS_QKVC), (unsigned short*)(ws + WS_OG), (float*)(ws + WS_LSE), I0, I1); }
#else
            const hbf* qkvc = (const hbf*)(ws + WS_QKVC); hbf* og = (hbf*)(ws + WS_OG); float* lse = (float*)(ws + WS_LSE);
            int L = vcu;
            if (L < ATT_ITEMS) {
                swa::BlockRef<hbf, hbf> cb = attn_ref(L, qkvc, og); swa::Seam<hbf> S;
                swa::causal_swa_prime<hbf, hbf>(cb, 129, (char*)lds_raw, S);
                for (;;) {
                    const bool more = L + G < ATT_ITEMS;
                    const swa::BlockRef<hbf, hbf> nb = more ? attn_ref(L + G, qkvc, og) : cb;
                    swa::causal_swa_block<hbf, hbf>(cb, nb, SEQ >> (2 * (L >> 10)), 129, (char*)lds_raw, S, (const char*)og, (char*)lse);
                    if (!more) break;
                    cb = nb; L += G;
                }
            }
#endif
        }
        SEAM(pb + 7);
        PHASE(9, pb + 8) { PH_SETUP(); merge_phase<WO_I8 != 0>(gw, NGW, lane, (const bf16*)(ws + WS_OG), (const float*)(ws + WS_LSE), (bf16*)(ws + WS_H), (float*)(ws + WS_RS)); }
        SEAM(pb + 8);
        PHASE(10, pb + 9) { PH_SETUP();
            constexpr int KU = WO_I8 ? D_MODEL / 2 : D_MODEL;
            pg8::SchedPlain S; S.init(ws + WS_H, ws + WS_WO + (size_t)lp * WO8_BYTES, M_TOK, D_MODEL, KU, KU, 0, G, bx);
            bf16* Xc = XCUR();
            if constexpr (WO_I8 != 0) { pg8::EpiResidI8 E{Xc, Xc, MODR(), (const float*)(ws + WS_RS), (const float*)((const unsigned*)(ws + WS_CTL) + CW_CMAXO) + lp * D_MODEL, 2 * lp + 1, 2, (LAS float*)(lds + TAB_OFF + 8192)};
                pg8::gemm_phase<pg8::EpiResidI8, pg8::SchedPlain, true, 2>(lds + RING_OFF, KU, S, E); }
            else { pg8::EpiResid<true> E{Xc, Xc, MODR(), nullptr, 2 * lp + 1, 2, 1.0f, (LAS float*)(lds + TAB_OFF + 8192)};
                pg8::gemm_phase<pg8::EpiResid<true>, pg8::SchedPlain, true>(lds + RING_OFF, KU, S, E); } }
        SEAM(pb + 9);
        PHASE(11, pb + 10) { PH_SETUP();
            LAS float* wr_t = (LAS float*)(lds + RING_OFF); const float* router_w = KIN(float, 15); int* stok = (int*)(ws + WS_STOK);
            for (int idx = tid; idx < D_MODEL * N_EXP; idx += NWAVES * 64) wr_t[(idx & 7) * D_MODEL + (idx >> 3)] = router_w[(size_t)lp * D_MODEL * N_EXP + idx];
            for (int i = gw * 64 + lane; i < MAX_SLOTS; i += NGW * 64) stok[i] = 0;
            __syncthreads();
            norm_phase<true, MOE_FP8 ? (MGU_FP6 ? 3 : 1) : 0>(gw, NGW, lane, XCUR(), (bf16*)(ws + WS_H), nullptr, KIN(float, 4) + (2 * lp + 1) * D_MODEL, MODR(), 2 * lp + 1, 3, wr_t, KIN(float, 16) + lp * N_EXP, (int*)(ws + WS_EIDX), (float*)(ws + WS_GATE), CNT(), (LAS float*)(lds + RING_OFF + 65536 + wave * 8192));
        }
        SEAM(pb + 10);
        PHASE(12, pb + 11) { PH_SETUP();
            slot_phase(gw, NGW, lane, (const int*)(ws + WS_EIDX), CNT(), (unsigned*)(ws + WS_CTL) + CW_CUR + lp * 8 * 64, (int*)(ws + WS_STOK), (int*)(ws + WS_SLOTOF)); }
        SEAM(pb + 11);
        PHASE(13, pb + 12) { PH_SETUP(); const unsigned* cnt = CNT();
            pg8::SchedMoE<true> S; { int acc = 0;
#pragma unroll
                for (int e = 0; e < 8; ++e) { S.tb[e] = acc; acc += ((int)__hip_atomic_load(cnt + e * 64, __ATOMIC_RELAXED, __HIP_MEMORY_SCOPE_AGENT) + 255) >> 8; } S.tb[8] = acc; }
            constexpr int KU = MOE_FP8 ? D_MODEL / 2 : D_MODEL;
            S.init_order(S.tb[8], 2 * D_FFE / 256, G, bx); S.A = (const char*)(ws + WS_H); S.B = (const char*)(ws + WS_WMGU) + (size_t)lp * N_EXP * MGU8_BYTES; S.lda = KU;
            S.b_exp = MGU8_BYTES; S.b_tile = (size_t)256 * KU * 2; S.tok = (const int*)(ws + WS_STOK); S.tls = (LAS unsigned*)(lds + TAB_OFF);
            pg8::EpiSwigluT<MOE_FP8 != 0> E{(void*)(ws + WS_ACT), D_FFE, (MOE_FP8 && !MGU_FP6) ? 0.015625f : 1.0f};
            pg8::gemm_phase<pg8::EpiSwigluT<MOE_FP8 != 0>, pg8::SchedMoE<true>, true, MOE_FP8 ? (MGU_FP6 ? 3 : 1) : 0>(lds + RING_OFF, KU, S, E, STAG(vcu)); }
        SEAM(pb + 12);
        PHASE(14, pb + 13) { PH_SETUP(); const unsigned* cnt = CNT();
            pg8::SchedMoE<false> S; { int acc = 0;
#pragma unroll
                for (int e = 0; e < 8; ++e) { S.tb[e] = acc; acc += ((int)__hip_atomic_load(cnt + e * 64, __ATOMIC_RELAXED, __HIP_MEMORY_SCOPE_AGENT) + 255) >> 8; } S.tb[8] = acc; }
            constexpr int KU = MOE_FP8 ? D_FFE / 2 : D_FFE;
            S.init_order(S.tb[8], D_MODEL / 256, G, bx); S.A = (const char*)(ws + WS_ACT); S.B = (const char*)(ws + WS_WMDN) + (size_t)lp * N_EXP * MDN8_BYTES; S.lda = KU;
            S.b_exp = MDN8_BYTES; S.b_tile = (size_t)256 * KU * 2; S.tok = nullptr; S.tls = nullptr;
            pg8::EpiBf16 E{(bf16*)(ws + WS_Y), D_MODEL, MOE_FP8 ? 0.015625f : 1.0f};
            pg8::gemm_phase<pg8::EpiBf16, pg8::SchedMoE<false>, true, MOE_FP8 != 0>(lds + RING_OFF, KU, S, E);
            if (lp == 0 && T8_IDLE_N > 0) { const int total = S.tb[8] * (D_MODEL / 256), rem = total % G, nidle = rem ? G - rem : G, rank = rem ? bx - rem : bx;
                if (rank >= 0) { ProIn I; I.c = KIN(float, 1); I.ada_w = KIN(float, 5); I.pool_w = KIN(float, 7); I.wqkv = KIN(float, 9); I.wo = KIN(float, 10); I.wgu = KIN(float, 13); I.wdn = KIN(float, 14); I.mgu = KIN(float, 17); I.mdn = KIN(float, 18); I.pos = KIN(int, 2);
                    tr8_run<1>(I, ws, (LAS float*)(lds + RING_OFF + wave * 16384), lane, rank * NWAVES + wave, nidle * NWAVES); } } }
        SEAM(pb + 13);
    }
    PHASE(15, NPHASES - 1) { PH_SETUP();
        final_phase(gw, NGW, lane, (const bf16*)(ws + WS_XB) + (size_t)M_TOK * D_MODEL, KOUT(), MODR(), DEPTH - 1, (const bf16*)(ws + WS_Y), (const int*)(ws + WS_SLOTOF), (const float*)(ws + WS_GATE)); }
#ifdef EXTRA_BARRIERS
    if (IN(0) && IN(1)) for (int eb = 0; eb < EXTRA_BARRIERS; ++eb) { const kptr_t kp = kargs(); XcdBarrier bar_; bar_.bar = (unsigned*)(KWS() + WS_CTL) + CW_BAR; bar_.x = xb_xcc_id(); bar_.st = (volatile LAS unsigned*)(lds + MISC_OFF) + 8; xcd_barrier(bar_); }
#endif
#undef IN
#undef SEAM
#undef EN
#undef PHASE
#undef MODP
#undef STAG
#undef MODR
#undef ADAB
#undef XCUR
#undef CNT
#undef PH_SETUP
}

extern "C" void kernel_launch(void* const* d_in, const int* in_sizes, int n_in, void* d_out, int out_size, void* d_ws, size_t ws_size, hipStream_t stream) {
    static int grid = 0;
    if (grid == 0) {
        if (n_in != 19 || in_sizes[0] != M_TOK * D_MODEL || out_size != M_TOK * D_MODEL || ws_size < WS_END) { fprintf(stderr, "kernel_launch: unexpected shapes (n_in %d, in0 %d, out %d, ws %zu < %zu); nothing launched\n", n_in, n_in > 0 ? in_sizes[0] : -1, out_size, ws_size, (size_t)WS_END); grid = -1; return; }
        int dev = 0, cus = 0, per_cu = 0;
        if (hipGetDevice(&dev) != hipSuccess || hipDeviceGetAttribute(&cus, hipDeviceAttributeMultiprocessorCount, dev) != hipSuccess) { fprintf(stderr, "kernel_launch: device query failed\n"); grid = -1; return; }
        if (hipFuncSetAttribute((const void*)mk_fwd, hipFuncAttributeMaxDynamicSharedMemorySize, LDS_BYTES) != hipSuccess) { fprintf(stderr, "kernel_launch: hipFuncSetAttribute failed\n"); grid = -1; return; }
        if (hipOccupancyMaxActiveBlocksPerMultiprocessor(&per_cu, (const void*)mk_fwd, NWAVES * 64, LDS_BYTES) != hipSuccess || per_cu < 1) fprintf(stderr, "kernel_launch: note: occupancy query reports %d workgroups per CU\n", per_cu);
        (void)hipGetLastError();
        grid = cus;
    }
    if (grid < 0) return;
    if (hipMemsetAsync((char*)d_ws + WS_CTL, 0, CTL_ZERO_BYTES, stream) != hipSuccess) { fprintf(stderr, "kernel_launch: hipMemsetAsync failed\n"); return; }
    Args a{};
    for (int i = 0; i < 19; ++i) a.in[i] = d_in[i];
    a.out = (float*)d_out; a.ws = (unsigned char*)d_ws; a.grid = grid; a.pad = 0;
#if MK_PER_PHASE
    for (int k = 0; k < NPHASES; ++k) { a.ph_lo = k; a.ph_hi = k + 1; hipLaunchKernelGGL(mk_fwd, dim3(grid), dim3(NWAVES * 64), LDS_BYTES, stream, a); }
#else
    a.ph_lo = 0; a.ph_hi = NPHASES; hipLaunchKernelGGL(mk_fwd, dim3(grid), dim3(NWAVES * 64), LDS_BYTES, stream, a);
#endif
    const hipError_t le = hipPeekAtLastError();
    if (le != hipSuccess) fprintf(stderr, "kernel_launch: launch failed: %s\n", hipGetErrorName(le));
}
```
